# Optimizing an MI355X kernel written in HIP

```python
import jax, jax.numpy as jnp
from jax import lax
import numpy as np

D_MODEL = 1024
BATCH = 8
SEQ = 2048
DEPTH = 1

MEM_LEN = 256

GDN_DK = 128
GDN_DV = 128
GDN_HEADS = D_MODEL // GDN_DV
GDN_CONV = 4
GDN_CHUNK = 64

NSA_DH = 128
NSA_HEADS = D_MODEL // NSA_DH
NSA_KV_HEADS = 2
CMP_BLOCK = 32
CMP_STRIDE = 16
CMP_HIDDEN = 256
SEL_BLOCK = 64
SEL_TOPK = 8
WINDOW = 256
NSA_QBLOCK = 64
ROPE_THETA = 10000.0

XA_HEADS = 4
XA_DH = D_MODEL // XA_HEADS

N_GROUPS = 4
EXPERTS_PER_GROUP = 8
N_EXPERTS = N_GROUPS * EXPERTS_PER_GROUP
TOPK_IN_GROUP = 2
D_FF_EXPERT = D_MODEL // 4

DN_ALPHA = (2.0 * DEPTH) ** 0.25
DN_BETA = (8.0 * DEPTH) ** -0.25
LN_EPS = 1e-5
RMS_EPS = 1e-6

IN_SPLITS = (
    GDN_HEADS * GDN_DK,
    GDN_HEADS * GDN_DK,
    GDN_HEADS * GDN_DV,
    GDN_HEADS * GDN_DV,
    GDN_HEADS,
    GDN_HEADS,
    NSA_HEADS * NSA_DH,
    NSA_KV_HEADS * NSA_DH,
    NSA_KV_HEADS * NSA_DH,
    NSA_KV_HEADS * NSA_DH,
    NSA_KV_HEADS * NSA_DH,
    NSA_KV_HEADS * NSA_DH,
    NSA_KV_HEADS * NSA_DH,
    NSA_HEADS * 3,
    2 * D_MODEL,
)
IN_WIDTH = sum(IN_SPLITS)

kernel_name = "hybrid_gdn_nsa_memxattn_hmoe_deepnorm"


def layer_norm(x, g, b):
    xf = x.astype(jnp.float32)
    mu = jnp.mean(xf, -1, keepdims=True)
    var = jnp.mean(jnp.square(xf - mu), -1, keepdims=True)
    return ((xf - mu) * lax.rsqrt(var + LN_EPS) * g + b).astype(x.dtype)


def rms_norm(x, g):
    xf = x.astype(jnp.float32)
    return xf * lax.rsqrt(jnp.mean(jnp.square(xf), -1, keepdims=True) + RMS_EPS) * g


def l2_normalize(x):
    return x * lax.rsqrt(jnp.sum(jnp.square(x), -1, keepdims=True) + RMS_EPS)


def rope_tables(positions, dim):
    half = dim // 2
    inv_freq = ROPE_THETA ** (-jnp.arange(half, dtype=jnp.float32) / half)
    ang = positions.astype(jnp.float32)[..., None] * inv_freq
    return jnp.cos(ang)[:, :, None, :], jnp.sin(ang)[:, :, None, :]


def apply_rope(x, cos, sin):
    x1, x2 = jnp.split(x.astype(jnp.float32), 2, axis=-1)
    return jnp.concatenate([x1 * cos - x2 * sin, x2 * cos + x1 * sin], -1).astype(x.dtype)


def causal_dwconv(x, w):
    K, C = w.shape
    return lax.conv_general_dilated(x, w[:, None, :].astype(x.dtype), window_strides=(1,),
                                    padding=[(K - 1, 0)], dimension_numbers=('NWC', 'WIO', 'NWC'),
                                    feature_group_count=C)


def masked_softmax(s, mask):
    s = jnp.where(mask, s.astype(jnp.float32), -jnp.inf)
    m = jnp.max(s, axis=-1, keepdims=True)
    m = jnp.where(jnp.isfinite(m), m, 0.0)
    e = jnp.exp(s - m)
    return e / jnp.maximum(jnp.sum(e, axis=-1, keepdims=True), 1e-30)


def gated_deltanet(q, k, v, a_logit, b_logit, z, a_log, dt_bias, norm_w):
    B, S, H, dk = q.shape
    dv = v.shape[-1]
    C = GDN_CHUNK
    N = S // C
    f32 = jnp.float32
    q = l2_normalize(q.astype(f32)) * (dk ** -0.5)
    k = l2_normalize(k.astype(f32))
    v = v.astype(f32)
    beta = jax.nn.sigmoid(b_logit.astype(f32))
    g = -jnp.exp(a_log.astype(f32)) * jax.nn.softplus(a_logit.astype(f32) + dt_bias.astype(f32))

    def chunks(t):
        return t.reshape(B, N, C, H, -1).transpose(0, 3, 1, 2, 4)

    q, k, v = chunks(q), chunks(k), chunks(v)
    beta = beta.reshape(B, N, C, H).transpose(0, 3, 1, 2)
    gc = jnp.cumsum(g.reshape(B, N, C, H).transpose(0, 3, 1, 2), axis=-1)
    diff = gc[..., :, None] - gc[..., None, :]
    causal = jnp.tril(jnp.ones((C, C), dtype=bool))
    strict = jnp.tril(jnp.ones((C, C), dtype=bool), -1)
    decay = jnp.exp(jnp.where(causal, diff, -jnp.inf))
    a_mat = jnp.where(strict, jnp.einsum('bhncd,bhnmd->bhncm', k, k) * decay, 0.0) * beta[..., None]
    lhs = a_mat + jnp.eye(C, dtype=f32)
    rhs = jnp.concatenate([v * beta[..., None], k * (beta * jnp.exp(gc))[..., None]], -1)
    sol = lax.linalg.triangular_solve(lhs, rhs, left_side=True, lower=True, unit_diagonal=True)
    u, w = sol[..., :dv], sol[..., dv:]
    qk = jnp.einsum('bhncd,bhnmd->bhncm', q, k) * decay
    q_dec = q * jnp.exp(gc)[..., None]
    g_last = gc[..., -1]
    k_dec = k * jnp.exp(g_last[..., None] - gc)[..., None]

    def step(state, inp):
        u_c, w_c, qk_c, qd_c, kd_c, gl_c = inp
        v_new = u_c - jnp.einsum('bhcd,bhde->bhce', w_c, state)
        o_c = jnp.einsum('bhcd,bhde->bhce', qd_c, state) + jnp.einsum('bhcm,bhme->bhce', qk_c, v_new)
        state = state * jnp.exp(gl_c)[..., None, None] + jnp.einsum('bhcd,bhce->bhde', kd_c, v_new)
        return state, o_c

    xs = tuple(jnp.moveaxis(t, 2, 0) for t in (u, w, qk, q_dec, k_dec, g_last))
    _, o = lax.scan(step, jnp.zeros((B, H, dk, dv), f32), xs)
    o = o.transpose(1, 0, 3, 2, 4).reshape(B, S, H, dv)
    o = rms_norm(o, norm_w) * jax.nn.silu(z.astype(f32))
    return o.reshape(B, S, H * dv)


def compress_kv(k, v, pe, w1, b1, w2):
    B, S, G, dh = k.shape
    nc = (S - CMP_BLOCK) // CMP_STRIDE + 1
    idx = jnp.arange(nc)[:, None] * CMP_STRIDE + jnp.arange(CMP_BLOCK)[None, :]

    def one(t, j):
        blk = t[:, idx] + pe[j][None, None, :, None, :]
        blk = blk.transpose(0, 1, 3, 2, 4).reshape(B, nc, G, CMP_BLOCK * dh)
        return jax.nn.gelu(blk @ w1[j] + b1[j]) @ w2[j]

    return one(k, 0), one(v, 1)


def block_overlap(nc, nb):
    c0 = jnp.arange(nc) * CMP_STRIDE
    s0 = jnp.arange(nb) * SEL_BLOCK
    ov = jnp.minimum(c0[:, None] + CMP_BLOCK, s0[None, :] + SEL_BLOCK) - jnp.maximum(c0[:, None], s0[None, :])
    return (jnp.maximum(ov, 0) / CMP_BLOCK).astype(jnp.float32)


def nsa_attention(q, kc, vc, ks, vs, kw, vw, gates):
    f32 = jnp.float32
    B, S, H, dh = q.shape
    G = kc.shape[2]
    hpg = H // G
    nc = kc.shape[1]
    nb = S // SEL_BLOCK
    n_sel = min(SEL_TOPK, nb)
    QB = NSA_QBLOCK
    q = q.astype(f32) * (dh ** -0.5)
    kc, vc, gates = kc.astype(f32), vc.astype(f32), gates.astype(f32)
    cmp_end = jnp.arange(nc) * CMP_STRIDE + CMP_BLOCK - 1
    overlap = block_overlap(nc, nb)
    ks_blk = ks.astype(f32).reshape(B, nb, SEL_BLOCK, G, dh).transpose(0, 3, 1, 2, 4)
    vs_blk = vs.astype(f32).reshape(B, nb, SEL_BLOCK, G, dh).transpose(0, 3, 1, 2, 4)
    kw_pad = jnp.pad(kw.astype(f32), ((0, 0), (WINDOW, 0), (0, 0), (0, 0)))
    vw_pad = jnp.pad(vw.astype(f32), ((0, 0), (WINDOW, 0), (0, 0), (0, 0)))
    blk_ids = jnp.arange(nb)
    offs = jnp.arange(SEL_BLOCK)
    gather = jax.vmap(jax.vmap(lambda blocks, ids: blocks[ids]))

    def one_block(i):
        t0 = i * QB
        t = t0 + jnp.arange(QB)
        qb = lax.dynamic_slice_in_dim(q, t0, QB, axis=1).reshape(B, QB, G, hpg, dh)
        gb = lax.dynamic_slice_in_dim(gates, t0, QB, axis=1).reshape(B, QB, G, hpg, 3)
        p_c = masked_softmax(jnp.einsum('bqghd,bngd->bghqn', qb, kc), cmp_end[None, :] <= t[:, None])
        o_c = jnp.einsum('bghqn,bngd->bqghd', p_c, vc)
        imp = jnp.einsum('bghqn,nj->bgqj', p_c, overlap)
        cur = t // SEL_BLOCK
        valid = blk_ids[None, :] * SEL_BLOCK <= t[:, None]
        forced = (blk_ids[None, :] == 0) | (blk_ids[None, :] == cur[:, None]) | (blk_ids[None, :] == cur[:, None] - 1)
        imp = jnp.where(forced, jnp.inf, jnp.where(valid, imp, -jnp.inf))
        _, sel = lax.top_k(imp, n_sel)
        flat = sel.reshape(B, G, QB * n_sel)
        k_sel = gather(ks_blk, flat).reshape(B, G, QB, n_sel * SEL_BLOCK, dh)
        v_sel = gather(vs_blk, flat).reshape(B, G, QB, n_sel * SEL_BLOCK, dh)
        kpos = (sel[..., None] * SEL_BLOCK + offs).reshape(B, G, QB, n_sel * SEL_BLOCK)
        p_s = masked_softmax(jnp.einsum('bqghd,bgqkd->bghqk', qb, k_sel), (kpos <= t[:, None])[:, :, None])
        o_s = jnp.einsum('bghqk,bgqkd->bqghd', p_s, v_sel)
        k_w = lax.dynamic_slice_in_dim(kw_pad, t0, QB + WINDOW, axis=1)
        v_w = lax.dynamic_slice_in_dim(vw_pad, t0, QB + WINDOW, axis=1)
        wpos = t0 - WINDOW + jnp.arange(QB + WINDOW)
        rel = t[:, None] - wpos[None, :]
        wmask = (rel >= 0) & (rel < WINDOW) & (wpos[None, :] >= 0)
        p_w = masked_softmax(jnp.einsum('bqghd,bkgd->bghqk', qb, k_w), wmask)
        o_w = jnp.einsum('bghqk,bkgd->bqghd', p_w, v_w)
        o = gb[..., 0:1] * o_c + gb[..., 1:2] * o_s + gb[..., 2:3] * o_w
        return o.reshape(B, QB, H * dh)

    out = lax.map(one_block, jnp.arange(S // QB))
    return out.transpose(1, 0, 2, 3).reshape(B, S, H * dh)


def token_mixer(h, cos, sin, w_in, conv_w, a_log, dt_bias, norm_w, cmp_pe, cmp_w1, cmp_b1, cmp_w2, w_out):
    B, S, _ = h.shape
    proj = h @ w_in
    points = np.cumsum(IN_SPLITS)[:-1].tolist()
    (g_q, g_k, g_v, g_z, g_b, g_a, n_q, c_k, c_v, s_k, s_v, w_k, w_v, n_g, m_g) = jnp.split(proj, points, axis=-1)
    qkv = jax.nn.silu(causal_dwconv(jnp.concatenate([g_q, g_k, g_v], -1), conv_w))
    qkw = GDN_HEADS * GDN_DK
    y_a = gated_deltanet(qkv[..., :qkw].reshape(B, S, GDN_HEADS, GDN_DK),
                         qkv[..., qkw:2 * qkw].reshape(B, S, GDN_HEADS, GDN_DK),
                         qkv[..., 2 * qkw:].reshape(B, S, GDN_HEADS, GDN_DV),
                         g_a, g_b, g_z.reshape(B, S, GDN_HEADS, GDN_DV), a_log, dt_bias, norm_w)
    def kvh(t):
        return t.reshape(B, S, NSA_KV_HEADS, NSA_DH)
    q = apply_rope(n_q.reshape(B, S, NSA_HEADS, NSA_DH), cos, sin)
    k_cmp, v_cmp = compress_kv(apply_rope(kvh(c_k), cos, sin), kvh(c_v), cmp_pe, cmp_w1, cmp_b1, cmp_w2)
    y_b = nsa_attention(q, k_cmp, v_cmp, apply_rope(kvh(s_k), cos, sin), kvh(s_v),
                        apply_rope(kvh(w_k), cos, sin), kvh(w_v),
                        jax.nn.sigmoid(n_g.reshape(B, S, NSA_HEADS, 3)))
    gate = jax.nn.sigmoid(m_g)
    merged = gate[..., :D_MODEL] * y_a.astype(h.dtype) + gate[..., D_MODEL:] * y_b.astype(h.dtype)
    return merged @ w_out


def memory_xattn(h, mem, wq, wkv, wo):
    B, S, _ = h.shape
    M = mem.shape[1]
    q = (h @ wq).reshape(B, S, XA_HEADS, XA_DH)
    kv = mem @ wkv
    k = kv[..., :D_MODEL].reshape(B, M, XA_HEADS, XA_DH)
    v = kv[..., D_MODEL:].reshape(B, M, XA_HEADS, XA_DH)
    s = jnp.einsum('bshd,bmhd->bhsm', q, k).astype(jnp.float32) * (XA_DH ** -0.5)
    p = jax.nn.softmax(s, axis=-1).astype(v.dtype)
    o = jnp.einsum('bhsm,bmhd->bshd', p, v).reshape(B, S, XA_HEADS * XA_DH)
    return o @ wo


def hier_moe(h, w_group, b_group, w_expert, b_expert, w_gate, w_up, w_down):
    B, S, D = h.shape
    xf = h.reshape(B * S, D)
    n = xf.shape[0]
    p_group = jax.nn.softmax((xf @ w_group).astype(jnp.float32) + b_group, axis=-1)
    p_top, g_idx = lax.top_k(p_group, 1)
    g_onehot = jax.nn.one_hot(g_idx[:, 0], N_GROUPS, dtype=jnp.float32)
    e_logits = ((xf @ w_expert).astype(jnp.float32) + b_expert).reshape(n, N_GROUPS, EXPERTS_PER_GROUP)
    e_logits = jnp.einsum('ng,nge->ne', g_onehot, e_logits)
    e_top, e_idx = lax.top_k(jax.nn.softmax(e_logits, axis=-1), TOPK_IN_GROUP)
    wts = p_top * e_top / jnp.sum(e_top, -1, keepdims=True)
    expert_id = g_idx * EXPERTS_PER_GROUP + e_idx
    combine = jnp.einsum('nk,nke->ne', wts, jax.nn.one_hot(expert_id, N_EXPERTS, dtype=jnp.float32))
    out = jnp.zeros((n, D), jnp.float32)
    for grp in range(N_GROUPS):
        sl = slice(grp * EXPERTS_PER_GROUP, (grp + 1) * EXPERTS_PER_GROUP)
        hg = jax.nn.silu(jnp.einsum('nd,edf->nef', xf, w_gate[sl])) * jnp.einsum('nd,edf->nef', xf, w_up[sl])
        out = out + jnp.einsum('nef,efd->nd', hg * combine[:, sl, None].astype(hg.dtype), w_down[sl])
    return out.astype(h.dtype).reshape(B, S, D)


def setup_inputs(seed: int = 0) -> dict:
    key = jax.random.key(seed)
    ks = jax.random.split(key, 32)
    f32 = jnp.float32
    L = DEPTH

    def nrm(i, shape, scale):
        return jax.random.normal(ks[i], shape, f32) * scale

    x = nrm(0, (BATCH, SEQ, D_MODEL), 1.0)
    mem = nrm(1, (BATCH, MEM_LEN, D_MODEL), 1.0)
    positions = (jnp.arange(SEQ, dtype=jnp.int32)[None, :]
                 + jax.random.randint(ks[2], (BATCH, 1), 0, 1024, dtype=jnp.int32))
    w_in = nrm(3, (L, D_MODEL, IN_WIDTH), D_MODEL ** -0.5)
    gdn_conv_w = nrm(4, (L, GDN_CONV, 2 * GDN_HEADS * GDN_DK + GDN_HEADS * GDN_DV), GDN_CONV ** -0.5)
    gdn_a_log = jnp.log(jax.random.uniform(ks[5], (L, GDN_HEADS), f32, 1.0, 16.0))
    dt = jnp.exp(jax.random.uniform(ks[6], (L, GDN_HEADS), f32, jnp.log(1e-3), jnp.log(1e-1)))
    gdn_dt_bias = dt + jnp.log(-jnp.expm1(-dt))
    gdn_norm_w = 1.0 + nrm(7, (L, GDN_DV), 0.02)
    cmp_pe = nrm(8, (L, 2, CMP_BLOCK, NSA_DH), 0.02)
    cmp_w1 = nrm(9, (L, 2, CMP_BLOCK * NSA_DH, CMP_HIDDEN), (CMP_BLOCK * NSA_DH) ** -0.5)
    cmp_b1 = nrm(10, (L, 2, CMP_HIDDEN), 0.02)
    cmp_w2 = nrm(11, (L, 2, CMP_HIDDEN, NSA_DH), CMP_HIDDEN ** -0.5)
    w_out = nrm(12, (L, D_MODEL, D_MODEL), D_MODEL ** -0.5 * DN_BETA)
    ln1_g = 1.0 + nrm(13, (L, D_MODEL), 0.02)
    ln1_b = nrm(14, (L, D_MODEL), 0.02)
    xa_wq = nrm(15, (L, D_MODEL, XA_HEADS * XA_DH), D_MODEL ** -0.5)
    xa_wkv = nrm(16, (L, D_MODEL, 2 * XA_HEADS * XA_DH), D_MODEL ** -0.5)
    xa_wo = nrm(17, (L, XA_HEADS * XA_DH, D_MODEL), D_MODEL ** -0.5 * DN_BETA)
    ln2_g = 1.0 + nrm(18, (L, D_MODEL), 0.02)
    ln2_b = nrm(19, (L, D_MODEL), 0.02)
    moe_w_group = nrm(20, (L, D_MODEL, N_GROUPS), D_MODEL ** -0.5)
    moe_b_group = nrm(21, (L, N_GROUPS), 0.01)
    moe_w_expert = nrm(22, (L, D_MODEL, N_EXPERTS), D_MODEL ** -0.5)
    moe_b_expert = nrm(23, (L, N_EXPERTS), 0.01)
    moe_w_gate = nrm(24, (L, N_EXPERTS, D_MODEL, D_FF_EXPERT), D_MODEL ** -0.5)
    moe_w_up = nrm(25, (L, N_EXPERTS, D_MODEL, D_FF_EXPERT), D_MODEL ** -0.5)
    moe_w_down = nrm(26, (L, N_EXPERTS, D_FF_EXPERT, D_MODEL), D_FF_EXPERT ** -0.5 * DN_BETA)
    ln3_g = 1.0 + nrm(27, (L, D_MODEL), 0.02)
    ln3_b = nrm(28, (L, D_MODEL), 0.02)
    return {"x": x, "mem": mem, "positions": positions, "w_in": w_in, "gdn_conv_w": gdn_conv_w,
            "gdn_a_log": gdn_a_log, "gdn_dt_bias": gdn_dt_bias, "gdn_norm_w": gdn_norm_w,
            "cmp_pe": cmp_pe, "cmp_w1": cmp_w1, "cmp_b1": cmp_b1, "cmp_w2": cmp_w2, "w_out": w_out,
            "ln1_g": ln1_g, "ln1_b": ln1_b, "xa_wq": xa_wq, "xa_wkv": xa_wkv, "xa_wo": xa_wo,
            "ln2_g": ln2_g, "ln2_b": ln2_b, "moe_w_group": moe_w_group, "moe_b_group": moe_b_group,
            "moe_w_expert": moe_w_expert, "moe_b_expert": moe_b_expert, "moe_w_gate": moe_w_gate,
            "moe_w_up": moe_w_up, "moe_w_down": moe_w_down, "ln3_g": ln3_g, "ln3_b": ln3_b}


def reference(x, mem, positions, w_in, gdn_conv_w, gdn_a_log, gdn_dt_bias, gdn_norm_w,
              cmp_pe, cmp_w1, cmp_b1, cmp_w2, w_out, ln1_g, ln1_b, xa_wq, xa_wkv, xa_wo,
              ln2_g, ln2_b, moe_w_group, moe_b_group, moe_w_expert, moe_b_expert,
              moe_w_gate, moe_w_up, moe_w_down, ln3_g, ln3_b):
    cos, sin = rope_tables(positions, NSA_DH)
    h = x
    for l in range(DEPTH):
        mix = token_mixer(h, cos, sin, w_in[l], gdn_conv_w[l], gdn_a_log[l], gdn_dt_bias[l], gdn_norm_w[l],
                          cmp_pe[l], cmp_w1[l], cmp_b1[l], cmp_w2[l], w_out[l])
        h = layer_norm(DN_ALPHA * h + mix, ln1_g[l], ln1_b[l])
        h = layer_norm(DN_ALPHA * h + memory_xattn(h, mem, xa_wq[l], xa_wkv[l], xa_wo[l]), ln2_g[l], ln2_b[l])
        ffn = hier_moe(h, moe_w_group[l], moe_b_group[l], moe_w_expert[l], moe_b_expert[l],
                       moe_w_gate[l], moe_w_up[l], moe_w_down[l])
        h = layer_norm(DN_ALPHA * h + ffn, ln3_g[l], ln3_b[l])
    return h
```

```cpp
#include <hip/hip_runtime.h>
#include <cstdio>
#include <cstdint>

#define LAS __attribute__((address_space(3)))
typedef unsigned short bf16_t;
typedef short bf16x8 __attribute__((ext_vector_type(8)));
typedef short s16x4 __attribute__((ext_vector_type(4)));
typedef float f32x2 __attribute__((ext_vector_type(2)));
typedef float f32x4 __attribute__((ext_vector_type(4)));
typedef float f32x16 __attribute__((ext_vector_type(16)));
typedef unsigned u32x2 __attribute__((ext_vector_type(2)));
typedef unsigned u32x4 __attribute__((ext_vector_type(4)));
typedef __bf16 bf16x2_t __attribute__((ext_vector_type(2)));

__device__ __forceinline__ unsigned cvtpk(float lo, float hi) { f32x2 v = {lo, hi}; bf16x2_t b = __builtin_convertvector(v, bf16x2_t); return __builtin_bit_cast(unsigned, b); }
__device__ __forceinline__ float bflo(unsigned u) { return __uint_as_float(u << 16); }
__device__ __forceinline__ float bfhi(unsigned u) { return __uint_as_float(u & 0xffff0000u); }
__device__ __forceinline__ float bf2f(bf16_t h) { return __uint_as_float(((unsigned)h) << 16); }
__device__ __forceinline__ bf16_t f2bf(float f) { return (bf16_t)(cvtpk(f, 0.f) & 0xffffu); }
__device__ __forceinline__ float sigmoidf_(float x) { return 1.f / (1.f + __expf(-x)); }
__device__ __forceinline__ float siluf_(float x) { return x / (1.f + __expf(-x)); }
__device__ __forceinline__ float wave_sum(float v) {
#pragma unroll
    for (int o = 1; o < 64; o <<= 1) v += __shfl_xor(v, o);
    return v;
}
#define LDS_WAIT() asm volatile("s_waitcnt lgkmcnt(0)" ::: "memory")
#define RAW_BAR() do { asm volatile("s_waitcnt lgkmcnt(0)" ::: "memory"); __builtin_amdgcn_s_barrier(); asm volatile("" ::: "memory"); } while (0)

namespace pg8 {
constexpr int BM = 256, BK = 64, HALF = 128, HTB = HALF * BK * 2, STAGE_BYTES = 8 * HTB, NXCD = 8, WGM = 8;
__host__ __device__ __forceinline__ int lds_byte(int r, int c) { const int st = (r >> 4) * 2 + (c >> 5), rr = r & 15, cc = c & 31, ob = rr * 64 + cc * 2; return st * 1024 + (ob ^ (((ob >> 9) & 1) << 5)); }
__host__ __device__ __forceinline__ void stage_rc(int b, int& R, int& C) { const int st = b / 1024, sb = b % 1024, swz = sb ^ (((sb >> 9) & 1) << 5); R = (st >> 1) * 16 + swz / 64; C = (st & 1) * 32 + (swz % 64) / 2; }
__host__ __device__ __forceinline__ int perm32(int rho) { const int n = rho >> 4, i = rho & 15; return 8 * (i >> 2) + 4 * n + (i & 3); }

struct Unit { int pm, pn, g; };

struct StaticOrder {
    int nM, nN, nwg, G, c;
    __device__ void init(int M, int N, int G_, int c_) { nM = M / BM; nN = N / BM; nwg = nM * nN; G = G_; c = c_; }
    __device__ bool next(int i, Unit& u) const {
        if (c < 0) return false;
        const long L = (long)i * G + c; if (L >= nwg) return false;
        int wgid = (int)L; { const int q = nwg / NXCD, r = nwg % NXCD, xcd = wgid % NXCD, off = wgid / NXCD; wgid = (xcd < r ? xcd * (q + 1) : r * (q + 1) + (xcd - r) * q) + off; }
        const int nig = WGM * nN, gid = wgid / nig, fm = gid * WGM, gsz = (nM - fm) < WGM ? (nM - fm) : WGM;
        u.pm = fm + ((wgid % nig) % gsz); u.pn = (wgid % nig) / gsz; u.g = 0; return true;
    }
};
struct GroupOrder {
    int nM, nN, ng, G, c;
    __device__ void init(int ng_, int nM_, int nN_, int G_, int c_) { ng = ng_; nM = nM_; nN = nN_; G = G_; c = c_; }
    __device__ bool next(int i, Unit& u) const {
        if (c < 0) return false;
        const long L = (long)i * G + c; if (L >= (long)ng * nM * nN) return false;
        const int per = nM * nN; u.g = (int)(L / per); const int r = (int)(L % per); u.pm = r / nN; u.pn = r % nN; return true;
    }
};

template <class Prob, class Epi, class Sched>
__device__ __forceinline__ void gemm_phase(LAS unsigned char* lds, const Prob& P, const Sched& S, const Epi& E) {
    const int tid = threadIdx.x, wid = __builtin_amdgcn_readfirstlane(tid >> 6), lane = tid & 63, wr = wid >> 2, wc = wid & 3, fr = lane & 15, fq = lane >> 4;
    const int nt = P.K / BK;
    int Rp[2], Cp[2];
    unsigned voffB[2];
#pragma unroll
    for (int i = 0; i < 2; ++i) { stage_rc(tid * 16 + i * 8192, Rp[i], Cp[i]); const int Rb = Epi::PERM ? ((Rp[i] & ~31) + perm32(Rp[i] & 31)) : Rp[i]; voffB[i] = (unsigned)(Rb * P.ldb + Cp[i] * 2); }
    const size_t kstep = (size_t)(BK * 2);
    const size_t hstepB = (size_t)HALF * P.ldb;
    const unsigned ldsw = (unsigned)wid * 1024u;
    const int aoff = lds_byte(wr * 64 + fr, fq * 8), boff = lds_byte(wc * 32 + fr, fq * 8);
#define PG8_SA(b, h) (((b) * 2 + (h)) * HTB)
#define PG8_SB(b, h) ((4 + (b) * 2 + (h)) * HTB)
#define PG8_STAGEB(bufoff, gbase) do { _Pragma("unroll") for (int _i = 0; _i < 2; ++_i) \
        __builtin_amdgcn_global_load_lds((const unsigned*)((const char*)(gbase) + voffB[_i]), (LAS unsigned*)(lds + (bufoff) + ldsw + _i * 8192), 16, 0, 0); } while (0)
#define PG8_STAGEA(bufoff, gbase, v0, v1) do { \
        __builtin_amdgcn_global_load_lds((const unsigned*)((const char*)(gbase) + (v0)), (LAS unsigned*)(lds + (bufoff) + ldsw), 16, 0, 0); \
        __builtin_amdgcn_global_load_lds((const unsigned*)((const char*)(gbase) + (v1)), (LAS unsigned*)(lds + (bufoff) + ldsw + 8192), 16, 0, 0); } while (0)
#define PG8_LDA(dst, b, h) do { _Pragma("unroll") for (int m = 0; m < 4; ++m) _Pragma("unroll") for (int k = 0; k < 2; ++k) dst[m][k] = *(const LAS bf16x8*)(lds + PG8_SA(b, h) + aoff + m * 2048 + k * 1024); } while (0)
#define PG8_LDB(dst, b, h) do { _Pragma("unroll") for (int n = 0; n < 2; ++n) _Pragma("unroll") for (int k = 0; k < 2; ++k) dst[n][k] = *(const LAS bf16x8*)(lds + PG8_SB(b, h) + boff + n * 2048 + k * 1024); } while (0)
#define PG8_MMA(ai, bj, At, Bt) do { __builtin_amdgcn_s_setprio(1); _Pragma("unroll") for (int m = 0; m < 4; ++m) _Pragma("unroll") for (int n = 0; n < 2; ++n) _Pragma("unroll") for (int k = 0; k < 2; ++k) \
        acc[ai][bj][m][n] = __builtin_amdgcn_mfma_f32_16x16x32_bf16(Bt[n][k], At[m][k], acc[ai][bj][m][n], 0, 0, 0); __builtin_amdgcn_s_setprio(0); } while (0)
#define PG8_WAIT_V(n) asm volatile("s_waitcnt vmcnt(" #n ")" ::: "memory")
#define PG8_WAIT_L(n) asm volatile("s_waitcnt lgkmcnt(" #n ")" ::: "memory")
#define PG8_BAR __builtin_amdgcn_s_barrier()
#define PG8_SCHED __builtin_amdgcn_sched_barrier(0)
    Unit cur, nxt; int ui = 0;
    if (!S.next(0, cur)) return;
    f32x4 acc[2][2][4][2];
#pragma unroll
    for (int a = 0; a < 2; ++a)
#pragma unroll
        for (int b = 0; b < 2; ++b)
#pragma unroll
            for (int m = 0; m < 4; ++m)
#pragma unroll
                for (int n = 0; n < 2; ++n) acc[a][b][m][n] = (f32x4){0.f, 0.f, 0.f, 0.f};
    bf16x8 At[4][2], B0[2][2], B1[2][2];
    const char* cA = P.a_base(cur); const char* cB = P.b_base(cur);
    unsigned vc00, vc01, vc10, vc11, vn00, vn01, vn10, vn11;
    vc00 = P.a_rowoff(cur, Rp[0]) + Cp[0] * 2; vc01 = P.a_rowoff(cur, Rp[1]) + Cp[1] * 2;
    vc10 = P.a_rowoff(cur, HALF + Rp[0]) + Cp[0] * 2; vc11 = P.a_rowoff(cur, HALF + Rp[1]) + Cp[1] * 2;
    {
        PG8_STAGEB(PG8_SB(0, 0), cB); PG8_STAGEB(PG8_SB(0, 1), cB + hstepB); PG8_STAGEA(PG8_SA(0, 0), cA + P.a_koff(0), vc00, vc01); PG8_STAGEA(PG8_SA(0, 1), cA + P.a_koff(0), vc10, vc11);
        if (wr == 1) PG8_BAR;
        PG8_WAIT_V(2); PG8_BAR;
        PG8_STAGEB(PG8_SB(1, 0), cB + kstep); PG8_STAGEA(PG8_SA(1, 0), cA + P.a_koff(1), vc00, vc01); PG8_STAGEB(PG8_SB(1, 1), cB + hstepB + kstep);
        PG8_WAIT_V(6); PG8_BAR;
    }
    for (;;) {
        const bool has_next = S.next(ui + 1, nxt);
        const char* nA = has_next ? P.a_base(nxt) : cA; const char* nB = has_next ? P.b_base(nxt) : cB;
        if (has_next) {
            vn00 = P.a_rowoff(nxt, Rp[0]) + Cp[0] * 2; vn01 = P.a_rowoff(nxt, Rp[1]) + Cp[1] * 2;
            vn10 = P.a_rowoff(nxt, HALF + Rp[0]) + Cp[0] * 2; vn11 = P.a_rowoff(nxt, HALF + Rp[1]) + Cp[1] * 2;
        } else { vn00 = vc00; vn01 = vc01; vn10 = vc10; vn11 = vc11; }
        for (int t = 0; t < nt; t += 2) {
            const bool last = (t == nt - 2);
            const char* a1 = cA + P.a_koff(t + 1);
            const char* a2 = last ? nA + P.a_koff(0) : cA + P.a_koff(t + 2);
            const char* a3 = last ? nA + P.a_koff(1) : cA + P.a_koff(t + 3);
            const char* b2 = last ? nB : cB + (size_t)(t + 2) * kstep; const char* b3 = b2 + kstep;
            const unsigned w00 = last ? vn00 : vc00, w01 = last ? vn01 : vc01, w10 = last ? vn10 : vc10, w11 = last ? vn11 : vc11;
            PG8_LDB(B0, 0, 0); PG8_LDB(B1, 0, 1); PG8_SCHED; PG8_LDA(At, 0, 0); PG8_STAGEA(PG8_SA(1, 1), a1, vc10, vc11);
            PG8_WAIT_V(8); PG8_WAIT_L(0); PG8_BAR; PG8_MMA(0, 0, At, B0); PG8_MMA(0, 1, At, B1); PG8_BAR; PG8_SCHED;
            PG8_LDA(At, 0, 1); PG8_STAGEB(PG8_SB(0, 0), b2); PG8_STAGEB(PG8_SB(0, 1), b2 + hstepB); PG8_STAGEA(PG8_SA(0, 0), a2, w00, w01);
            PG8_WAIT_V(8); PG8_WAIT_L(0); PG8_BAR; PG8_MMA(1, 0, At, B0); PG8_MMA(1, 1, At, B1); PG8_BAR; PG8_SCHED;
            PG8_LDB(B0, 1, 0); PG8_LDB(B1, 1, 1); PG8_SCHED; PG8_LDA(At, 1, 0); PG8_STAGEA(PG8_SA(0, 1), a2, w10, w11);
            PG8_WAIT_V(8); PG8_WAIT_L(0); PG8_BAR; PG8_MMA(0, 0, At, B0); PG8_MMA(0, 1, At, B1); PG8_BAR; PG8_SCHED;
            PG8_LDA(At, 1, 1); PG8_STAGEB(PG8_SB(1, 0), b3); PG8_STAGEB(PG8_SB(1, 1), b3 + hstepB); PG8_STAGEA(PG8_SA(1, 0), a3, w00, w01);
            PG8_WAIT_V(8); PG8_WAIT_L(0); PG8_BAR; PG8_MMA(1, 0, At, B0); PG8_MMA(1, 1, At, B1); PG8_BAR; PG8_SCHED;
        }
        if (wr == 0) PG8_BAR;
        E(acc, cur, wr, wc, fr, fq, lds + STAGE_BYTES, wid, lane);
        if (!has_next) break;
#pragma unroll
        for (int a = 0; a < 2; ++a)
#pragma unroll
            for (int b = 0; b < 2; ++b)
#pragma unroll
                for (int m = 0; m < 4; ++m)
#pragma unroll
                    for (int n = 0; n < 2; ++n) acc[a][b][m][n] = (f32x4){0.f, 0.f, 0.f, 0.f};
        cur = nxt; cA = nA; cB = nB; vc00 = vn00; vc01 = vn01; vc10 = vn10; vc11 = vn11; ++ui;
        if (wr == 1) PG8_BAR;
    }
    PG8_WAIT_V(0);
    PG8_BAR;
#undef PG8_SA
#undef PG8_SB
#undef PG8_STAGEA
#undef PG8_STAGEB
#undef PG8_LDA
#undef PG8_LDB
#undef PG8_MMA
#undef PG8_WAIT_V
#undef PG8_WAIT_L
#undef PG8_BAR
#undef PG8_SCHED
}

__device__ __forceinline__ void store_tile_bf16(const f32x4 (&acc)[2][2][4][2], bf16_t* tile_base, size_t ld, int wr, int wc, int fr, int fq, float sc) {
#pragma unroll
    for (int ai = 0; ai < 2; ++ai)
#pragma unroll
        for (int m = 0; m < 4; ++m) { bf16_t* rowp = tile_base + (size_t)(ai * HALF + wr * 64 + m * 16 + fr) * ld + wc * 32 + 8 * fq;
#pragma unroll
            for (int bj = 0; bj < 2; ++bj) { const f32x4 v0 = acc[ai][bj][m][0] * sc, v1 = acc[ai][bj][m][1] * sc; u32x4 w; w.x = cvtpk(v0[0], v0[1]); w.y = cvtpk(v0[2], v0[3]); w.z = cvtpk(v1[0], v1[1]); w.w = cvtpk(v1[2], v1[3]);
                *(u32x4*)(rowp + bj * HALF) = w; } }
}
}
constexpr int NTOK = 16384, DM = 1024, SEQ = 2048, NB = 8, INW = 8744;
constexpr int NWAVES = 8, NTHREADS = 512;
constexpr float DN_ALPHA = 1.189207115002721f;
constexpr float LN_EPS = 1e-5f, RMS_EPS = 1e-6f;
constexpr size_t MiB = 1u << 20;
constexpr size_t WS_CTL = 0;
constexpr size_t WS_AB = 1 * MiB;
constexpr size_t WS_NGATE = 2 * MiB;
constexpr size_t WS_WSMALL = 3 * MiB + 512 * 1024;
constexpr size_t WS_WR = WS_WSMALL + 40 * 4096;
constexpr size_t WS_BIASP = WS_WR + 36 * 4096;
constexpr size_t WS_CMPK = 4 * MiB;
constexpr size_t WS_CMPV = 4 * MiB + 512 * 1024;
constexpr size_t WS_HID = 5 * MiB;
constexpr size_t WS_TOKE = 7 * MiB;
constexpr size_t WS_TOKS = WS_TOKE + 128 * 1024;
constexpr size_t WS_TOKW = WS_TOKS + 128 * 1024;
constexpr size_t WS_POSTK = WS_TOKW + 128 * 1024;
constexpr size_t WS_POSW = WS_POSTK + 192 * 1024;
constexpr size_t WS_TILEE = WS_POSW + 192 * 1024;
constexpr int MAXPOS = 40960, MAXTILES = 160;
constexpr size_t WS_KX = 8 * MiB;
constexpr size_t WS_VT = 12 * MiB;
constexpr size_t WS_W1T = 16 * MiB;
constexpr size_t WS_W2T = 29 * MiB;
constexpr size_t WS_WC1T = 33 * MiB;
constexpr size_t WS_WC2T = 37 * MiB;
constexpr size_t WS_WOT = 37 * MiB + 512 * 1024;
constexpr size_t WS_WQT = WS_WOT + 2 * MiB;
constexpr size_t WS_WKVT = WS_WQT + 2 * MiB;
constexpr size_t WS_WXOT = WS_WKVT + 4 * MiB;
constexpr size_t WS_GQ = 48 * MiB, WS_GK = 80 * MiB, WS_GV = 112 * MiB, WS_Z = 144 * MiB;
constexpr size_t WS_KV = 176 * MiB;
constexpr size_t WS_FREE = 224 * MiB;
constexpr size_t WS_PART = 224 * MiB;
constexpr size_t WS_H = 48 * MiB;
constexpr size_t WS_HB = 112 * MiB;
constexpr size_t WS_WGUT = 176 * MiB;
constexpr size_t WS_WDT = 208 * MiB;
constexpr size_t WS_HG = 144 * MiB;
constexpr size_t WS_Y0 = 8 * MiB;
constexpr size_t WS_Y1 = 224 * MiB;
constexpr size_t WS_END = 256 * MiB;
constexpr size_t DO_XB = 0, DO_NQ = 32 * MiB;
constexpr int CW_QUEUE = 64;
constexpr int CW_CNT = 128;
constexpr int CW_BAR = 1024;

constexpr int LDS_BYTES = 152 * 1024;
constexpr int LDS_SCR = pg8::STAGE_BYTES;

struct Params {
    const float* in[29];
    const int* positions;
    float* out;
    unsigned char* ws;
    int ph_lo, ph_hi;
};

struct Ctx { int tid, lane, wave, gw, ngw; LAS unsigned char* lds; };

__device__ __forceinline__ void transpose_seg(const Ctx& C, const float* W, int K, int Nsrc, int col0, int cnt, bf16_t* WT, int drow0, int ldd) {
    LAS float* scr = (LAS float*)(C.lds + C.wave * 16384);
    const int nblk = cnt / 32, nitems = (K / 64) * nblk, lane = C.lane;
    for (int item = C.gw; item < nitems; item += C.ngw) {
        const int kb = item / nblk, nb = item % nblk, k0 = 64 * kb, n0 = col0 + 32 * nb;
#pragma unroll 8
        for (int i = 0; i < 32; ++i) { const int kk = 2 * i + (lane >> 5); scr[kk * 33 + (lane & 31)] = W[(size_t)(k0 + kk) * Nsrc + n0 + (lane & 31)]; }
        LDS_WAIT(); asm volatile("" ::: "memory");
        const int c = lane & 7;
#pragma unroll
        for (int j = 0; j < 4; ++j) { const int n = (lane >> 3) + 8 * j; const LAS float* s = scr + (8 * c) * 33 + n;
            u32x4 o; o.x = cvtpk(s[0 * 33], s[1 * 33]); o.y = cvtpk(s[2 * 33], s[3 * 33]); o.z = cvtpk(s[4 * 33], s[5 * 33]); o.w = cvtpk(s[6 * 33], s[7 * 33]);
            *(u32x4*)(WT + (size_t)(drow0 + 32 * nb + n) * ldd + k0 + 8 * c) = o; }
        LDS_WAIT(); asm volatile("" ::: "memory");
    }
}
__device__ __forceinline__ void cvt_rows(const Ctx& C, const float* src, bf16_t* dst, size_t n) {
    const size_t nv = n / 8;
    for (size_t i = (size_t)C.gw * 64 + C.lane; i < nv; i += (size_t)C.ngw * 64) {
        const f32x4 a = *(const f32x4*)(src + i * 8), b = *(const f32x4*)(src + i * 8 + 4);
        u32x4 o; o.x = cvtpk(a[0], a[1]); o.y = cvtpk(a[2], a[3]); o.z = cvtpk(b[0], b[1]); o.w = cvtpk(b[2], b[3]);
        *(u32x4*)(dst + i * 8) = o;
    }
}
__device__ __forceinline__ void extract_cols_f32(const Ctx& C, const float* W, int K, int Nsrc, int col0, int cnt, float* WT, int drow0) {
    const int total = K * cnt;
    for (int i = C.gw * 64 + C.lane; i < total; i += C.ngw * 64) { const int k = i / cnt, j = i % cnt; WT[(size_t)(drow0 + j) * K + k] = W[(size_t)k * Nsrc + col0 + j]; }
}
struct ProbDense {
    const char* A; const char* Bt; int lda, ldb, K; int gdiv; size_t as1, as2, bs1, bs2;
    __device__ __forceinline__ const char* a_base(const pg8::Unit& u) const { return A + (size_t)(u.g / gdiv) * as1 + (size_t)(u.g % gdiv) * as2 + (size_t)u.pm * 256 * lda; }
    __device__ __forceinline__ unsigned a_rowoff(const pg8::Unit&, int r) const { return (unsigned)(r * lda); }
    __device__ __forceinline__ size_t a_koff(int t) const { return (size_t)t * 128; }
    __device__ __forceinline__ const char* b_base(const pg8::Unit& u) const { return Bt + (size_t)(u.g / gdiv) * bs1 + (size_t)(u.g % gdiv) * bs2 + (size_t)u.pn * 256 * ldb; }
};
__device__ __forceinline__ ProbDense mk_dense(const void* A, const void* Bt, int lda_el, int ldb_el, int K) { ProbDense p; p.A = (const char*)A; p.Bt = (const char*)Bt; p.lda = lda_el * 2; p.ldb = ldb_el * 2; p.K = K; p.gdiv = 1; p.as1 = p.as2 = p.bs1 = p.bs2 = 0; return p; }

struct ProbCompress {
    const char* KV; const char* W; int ldb, K;
    __device__ __forceinline__ const char* a_base(const pg8::Unit& u) const { return KV + (size_t)(u.g >> 3) * 8 * MiB + (size_t)(u.g & 7) * 4 * 512; }
    __device__ __forceinline__ unsigned a_rowoff(const pg8::Unit& u, int r) const { const int R = u.pm * 256 + r, b = R >> 8, g = (R >> 7) & 1; int n = R & 127; n = n > 126 ? 126 : n; return (unsigned)(((b * 2048 + 16 * n) * 256 + g * 128) * 2); }
    __device__ __forceinline__ size_t a_koff(int t) const { return (size_t)(t >> 1) * 512 + (size_t)(t & 1) * 128; }
    __device__ __forceinline__ const char* b_base(const pg8::Unit& u) const { return W + (size_t)(u.g >> 3) * 256 * 4096 * 2 + (size_t)(u.g & 7) * 512 * 2; }
};
struct ProbGather {
    const char* A; const int* postk; const char* W; int lda, ldb, K; size_t bstride;
    __device__ __forceinline__ const char* a_base(const pg8::Unit&) const { return A; }
    __device__ __forceinline__ unsigned a_rowoff(const pg8::Unit& u, int r) const { int t = postk[u.pm * 256 + r]; t = t < 0 ? 0 : (t >> 1); return (unsigned)(t * lda); }
    __device__ __forceinline__ size_t a_koff(int t) const { return (size_t)t * 128; }
    __device__ __forceinline__ const char* b_base(const pg8::Unit& u) const { return W + (size_t)u.g * bstride + (size_t)u.pn * 256 * ldb; }
};
struct ProbExpertDense {
    const char* A; const char* W; int lda, ldb, K; size_t bstride;
    __device__ __forceinline__ const char* a_base(const pg8::Unit& u) const { return A + (size_t)u.pm * 256 * lda; }
    __device__ __forceinline__ unsigned a_rowoff(const pg8::Unit&, int r) const { return (unsigned)(r * lda); }
    __device__ __forceinline__ size_t a_koff(int t) const { return (size_t)t * 128; }
    __device__ __forceinline__ const char* b_base(const pg8::Unit& u) const { return W + (size_t)u.g * bstride + (size_t)u.pn * 256 * ldb; }
};
struct MoeOrder {
    const LAS int* tileE; int nN, G, c;
    __device__ bool next(int i, pg8::Unit& u) const {
        const int L = i * G + c, tt = L / nN; if (tt >= tileE[255]) return false;
        u.pm = tt; u.pn = L % nN; u.g = tileE[tt]; return true;
    }
};

#define EPI_ARGS f32x4 (&acc)[2][2][4][2], const pg8::Unit& u, int wr, int wc, int fr, int fq, LAS unsigned char* scr, int wid, int lane
struct EpiProj1 { static constexpr bool PERM = true; unsigned char* ws; unsigned char* dout;
    __device__ __forceinline__ void operator()(EPI_ARGS) const {
        bf16_t* base; size_t ld; int col0;
        if (u.pn < 16) { base = (bf16_t*)(ws + WS_GQ + (size_t)(u.pn >> 2) * 32 * MiB); ld = 1024; col0 = (u.pn & 3) * 256; }
        else if (u.pn < 20) { base = (bf16_t*)(dout + DO_NQ); ld = 1024; col0 = (u.pn - 16) * 256; }
        else { base = (bf16_t*)(ws + WS_KV + (size_t)(u.pn - 20) * 8 * MiB); ld = 256; col0 = 0; }
        pg8::store_tile_bf16(acc, base + (size_t)u.pm * 256 * ld + col0, ld, wr, wc, fr, fq, 1.f);
    } };
struct EpiStoreBf16 { static constexpr bool PERM = true; bf16_t* O; size_t ld; int gdiv; size_t s1, s2; float sc;
    __device__ __forceinline__ void operator()(EPI_ARGS) const {
        pg8::store_tile_bf16(acc, O + (size_t)(u.g / gdiv) * s1 + (size_t)(u.g % gdiv) * s2 + (size_t)u.pm * 256 * ld + (size_t)u.pn * 256, ld, wr, wc, fr, fq, sc);
    } };
struct EpiKvx { static constexpr bool PERM = true; bf16_t* Kx; bf16_t* Vt;
    __device__ __forceinline__ void operator()(EPI_ARGS) const {
        if (u.pn < 4) { pg8::store_tile_bf16(acc, Kx + (size_t)u.pm * 256 * 1024 + u.pn * 256, 1024, wr, wc, fr, fq, 1.f); return; }
        bf16_t* vb = Vt + (size_t)(u.pm * 4 + (u.pn - 4)) * 65536;
#pragma unroll
        for (int ai = 0; ai < 2; ++ai)
#pragma unroll
            for (int m = 0; m < 4; ++m) { const int mrow = ai * 128 + wr * 64 + m * 16 + fr;
#pragma unroll
                for (int bj = 0; bj < 2; ++bj)
#pragma unroll
                    for (int n = 0; n < 2; ++n)
#pragma unroll
                        for (int j = 0; j < 4; ++j) { const int d = bj * 128 + wc * 32 + 8 * fq + 4 * n + j; vb[(size_t)d * 256 + mrow] = f2bf(acc[ai][bj][m][n][j]); } }
    } };
struct EpiPart { static constexpr bool PERM = false; float* part;
    __device__ __forceinline__ void operator()(EPI_ARGS) const {
        float* base = part + ((size_t)((u.g & 7) * 2 + (u.g >> 3)) * 2048 + (size_t)u.pm * 256) * 256;
#pragma unroll
        for (int ai = 0; ai < 2; ++ai)
#pragma unroll
            for (int m = 0; m < 4; ++m) { float* rowp = base + (size_t)(ai * 128 + wr * 64 + m * 16 + fr) * 256 + wc * 32 + 4 * fq;
#pragma unroll
                for (int bj = 0; bj < 2; ++bj)
#pragma unroll
                    for (int n = 0; n < 2; ++n) *(f32x4*)(rowp + bj * 128 + n * 16) = acc[ai][bj][m][n]; }
    } };
struct EpiCmp2 { static constexpr bool PERM = true; bf16_t* out;
    __device__ __forceinline__ void operator()(EPI_ARGS) const {
        bf16_t* base = out + (size_t)u.g * (2048 * 128) + (size_t)u.pm * 256 * 128;
#pragma unroll
        for (int ai = 0; ai < 2; ++ai)
#pragma unroll
            for (int m = 0; m < 4; ++m) { bf16_t* rowp = base + (size_t)(ai * 128 + wr * 64 + m * 16 + fr) * 128 + wc * 32 + 8 * fq;
                const f32x4 v0 = acc[ai][0][m][0], v1 = acc[ai][0][m][1]; u32x4 w; w.x = cvtpk(v0[0], v0[1]); w.y = cvtpk(v0[2], v0[3]); w.z = cvtpk(v1[0], v1[1]); w.w = cvtpk(v1[2], v1[3]);
                *(u32x4*)rowp = w; }
    } };
struct EpiMerge { static constexpr bool PERM = true; const bf16_t* ya; const bf16_t* yb; bf16_t* merged; const float* ss;
    __device__ __forceinline__ void operator()(EPI_ARGS) const {
#pragma unroll
        for (int ai = 0; ai < 2; ++ai)
#pragma unroll
            for (int m = 0; m < 4; ++m) { const size_t off = (size_t)(u.pm * 256 + ai * 128 + wr * 64 + m * 16 + fr) * 1024 + u.pn * 128 + wc * 32 + 8 * fq;
                const u32x4 a = *(const u32x4*)(ya + off), b = *(const u32x4*)(yb + off); u32x4 w;
                const f32x2 sq = *(const f32x2*)(ss + (size_t)(u.pm * 256 + ai * 128 + wr * 64 + m * 16 + fr) * 16 + u.pn * 2); const float rstd = rsqrtf((sq[0] + sq[1]) * (1.f / 128.f) + RMS_EPS);
#pragma unroll
                for (int q = 0; q < 4; ++q) { const int n = q >> 1, j = (q & 1) * 2;
                    const float lo = sigmoidf_(acc[ai][0][m][n][j]) * (bflo(a[q]) * rstd) + sigmoidf_(acc[ai][1][m][n][j]) * bflo(b[q]);
                    const float hi = sigmoidf_(acc[ai][0][m][n][j + 1]) * (bfhi(a[q]) * rstd) + sigmoidf_(acc[ai][1][m][n][j + 1]) * bfhi(b[q]);
                    w[q] = cvtpk(lo, hi); }
                *(u32x4*)(merged + off) = w; }
    } };
struct EpiResF32 { static constexpr bool PERM = false; const float* res; float* out; float alpha;
    __device__ __forceinline__ void operator()(EPI_ARGS) const {
#pragma unroll
        for (int ai = 0; ai < 2; ++ai)
#pragma unroll
            for (int m = 0; m < 4; ++m) { const size_t off = (size_t)(u.pm * 256 + ai * 128 + wr * 64 + m * 16 + fr) * 1024 + u.pn * 256 + wc * 32 + 4 * fq;
#pragma unroll
                for (int bj = 0; bj < 2; ++bj)
#pragma unroll
                    for (int n = 0; n < 2; ++n) { const f32x4 r = *(const f32x4*)(res + off + bj * 128 + n * 16); *(f32x4*)(out + off + bj * 128 + n * 16) = r * alpha + acc[ai][bj][m][n]; } }
    } };
struct EpiSoftmax { static constexpr bool PERM = true; bf16_t* Pm;
    __device__ __forceinline__ void operator()(EPI_ARGS) const {
        LAS float* X = (LAS float*)scr;
        LAS float* Y = X + 1024;
#pragma unroll
        for (int ai = 0; ai < 2; ++ai)
#pragma unroll
            for (int m = 0; m < 4; ++m) { float v = -3.0e38f;
#pragma unroll
                for (int bj = 0; bj < 2; ++bj)
#pragma unroll
                    for (int n = 0; n < 2; ++n)
#pragma unroll
                        for (int j = 0; j < 4; ++j) v = fmaxf(v, acc[ai][bj][m][n][j]);
                v = fmaxf(v, __shfl_xor(v, 16)); v = fmaxf(v, __shfl_xor(v, 32));
                if (fq == 0) X[(ai * 128 + wr * 64 + m * 16 + fr) * 4 + wc] = v; }
        RAW_BAR();
#pragma unroll
        for (int ai = 0; ai < 2; ++ai)
#pragma unroll
            for (int m = 0; m < 4; ++m) { const int row = ai * 128 + wr * 64 + m * 16 + fr; const f32x4 t = *(const LAS f32x4*)(X + row * 4);
                const float mm = fmaxf(fmaxf(t[0], t[1]), fmaxf(t[2], t[3])); float s = 0.f;
#pragma unroll
                for (int bj = 0; bj < 2; ++bj)
#pragma unroll
                    for (int n = 0; n < 2; ++n) { f32x4 x = acc[ai][bj][m][n];
#pragma unroll
                        for (int j = 0; j < 4; ++j) { x[j] = __expf(x[j] - mm); s += x[j]; }
                        acc[ai][bj][m][n] = x; }
                s += __shfl_xor(s, 16); s += __shfl_xor(s, 32);
                if (fq == 0) Y[row * 4 + wc] = s; }
        RAW_BAR();
        bf16_t* base = Pm + ((size_t)u.g * 2048 + (size_t)u.pm * 256) * 256;
#pragma unroll
        for (int ai = 0; ai < 2; ++ai)
#pragma unroll
            for (int m = 0; m < 4; ++m) { const int row = ai * 128 + wr * 64 + m * 16 + fr; const f32x4 t = *(const LAS f32x4*)(Y + row * 4);
                const float inv = 1.f / ((t[0] + t[1]) + (t[2] + t[3])); bf16_t* rowp = base + (size_t)row * 256 + wc * 32 + 8 * fq;
#pragma unroll
                for (int bj = 0; bj < 2; ++bj) { const f32x4 v0 = acc[ai][bj][m][0] * inv, v1 = acc[ai][bj][m][1] * inv; u32x4 w; w.x = cvtpk(v0[0], v0[1]); w.y = cvtpk(v0[2], v0[3]); w.z = cvtpk(v1[0], v1[1]); w.w = cvtpk(v1[2], v1[3]);
                    *(u32x4*)(rowp + bj * 128) = w; } }
    } };
struct EpiGateUp { static constexpr bool PERM = true; bf16_t* hg;
    __device__ __forceinline__ void operator()(EPI_ARGS) const {
#pragma unroll
        for (int ai = 0; ai < 2; ++ai)
#pragma unroll
            for (int m = 0; m < 4; ++m) { bf16_t* p = hg + (size_t)(u.pm * 256 + ai * 128 + wr * 64 + m * 16 + fr) * 256 + u.pn * 128 + wc * 32 + 8 * fq; u32x4 w;
#pragma unroll
                for (int q = 0; q < 4; ++q) { const int n = q >> 1, j = (q & 1) * 2;
                    w[q] = cvtpk(siluf_(acc[ai][0][m][n][j]) * acc[ai][1][m][n][j], siluf_(acc[ai][0][m][n][j + 1]) * acc[ai][1][m][n][j + 1]); }
                *(u32x4*)p = w; }
    } };
struct EpiDown { static constexpr bool PERM = true; const int* postk; const float* posw; bf16_t* Y0; bf16_t* Y1;
    __device__ __forceinline__ void operator()(EPI_ARGS) const {
#pragma unroll
        for (int ai = 0; ai < 2; ++ai)
#pragma unroll
            for (int m = 0; m < 4; ++m) { const int pos = u.pm * 256 + ai * 128 + wr * 64 + m * 16 + fr; const int tk = postk[pos]; const float w = posw[pos];
                if (tk >= 0) { bf16_t* rowp = ((tk & 1) ? Y1 : Y0) + (size_t)(tk >> 1) * 1024 + u.pn * 256 + wc * 32 + 8 * fq;
#pragma unroll
                    for (int bj = 0; bj < 2; ++bj) { const f32x4 v0 = acc[ai][bj][m][0] * w, v1 = acc[ai][bj][m][1] * w; u32x4 o; o.x = cvtpk(v0[0], v0[1]); o.y = cvtpk(v0[2], v0[3]); o.z = cvtpk(v1[0], v1[1]); o.w = cvtpk(v1[2], v1[3]);
                        *(u32x4*)(rowp + bj * 128) = o; } } }
    } };
__device__ const float INV_FREQ[64] = {
1.000000000e+00f, 8.659643531e-01f, 7.498942614e-01f, 6.493816376e-01f, 5.623413324e-01f, 4.869675338e-01f, 4.216965139e-01f, 3.651741147e-01f, 3.162277639e-01f, 2.738419771e-01f, 2.371373773e-01f, 2.053525001e-01f, 1.778279394e-01f, 1.539926529e-01f, 1.333521307e-01f, 1.154782027e-01f, 1.000000015e-01f, 8.659642935e-02f, 7.498941571e-02f, 6.493816525e-02f, 5.623413250e-02f, 4.869675264e-02f, 4.216965288e-02f, 3.651741147e-02f, 3.162277490e-02f, 2.738419734e-02f, 2.371373773e-02f, 2.053525113e-02f, 1.778279431e-02f, 1.539926510e-02f, 1.333521493e-02f, 1.154782064e-02f, 9.999999776e-03f, 8.659643121e-03f, 7.498941850e-03f, 6.493816152e-03f, 5.623413250e-03f, 4.869675264e-03f, 4.216964822e-03f, 3.651741194e-03f, 3.162277630e-03f, 2.738419687e-03f, 2.371373586e-03f, 2.053524833e-03f, 1.778279431e-03f, 1.539926510e-03f, 1.333521446e-03f, 1.154781901e-03f, 1.000000047e-03f, 8.659643354e-04f, 7.498942432e-04f, 6.493816618e-04f, 5.623413017e-04f, 4.869675322e-04f, 4.216965172e-04f, 3.651741426e-04f, 3.162277571e-04f, 2.738419571e-04f, 2.371373703e-04f, 2.053525095e-04f, 1.778279402e-04f, 1.539926452e-04f, 1.333521504e-04f, 1.154782003e-04f
};
constexpr double TWO_PI_D = 6.283185307179586476925287, INV_2PI_D = 0.159154943091895335768884;

__device__ __forceinline__ void seg_rot(const Ctx& C, int& rot, const float* W, int K, int Nsrc, int col0, int cnt, bf16_t* WT, int drow0, int ldd) {
    Ctx D = C; D.gw = (C.gw + C.ngw - (rot % C.ngw)) % C.ngw;
    transpose_seg(D, W, K, Nsrc, col0, cnt, WT, drow0, ldd);
    rot += (K / 64) * (cnt / 32);
}

__device__ __forceinline__ void phase0(const Params& p, const Ctx& C) {
    unsigned char* ws = p.ws; int rot = 0;
    const float* w_in = p.in[3];
    bf16_t* W1T = (bf16_t*)(ws + WS_W1T); bf16_t* W2T = (bf16_t*)(ws + WS_W2T);
    seg_rot(C, rot, w_in, 1024, INW, 0, 4096, W1T, 0, 1024);
    seg_rot(C, rot, w_in, 1024, INW, 4112, 2560, W1T, 4096, 1024);
    for (int pn = 0; pn < 8; ++pn) { seg_rot(C, rot, w_in, 1024, INW, 6696 + 128 * pn, 128, W2T, 256 * pn, 1024); seg_rot(C, rot, w_in, 1024, INW, 7720 + 128 * pn, 128, W2T, 256 * pn + 128, 1024); }
    for (int j = 0; j < 2; ++j) seg_rot(C, rot, p.in[9] + (size_t)j * 4096 * 256, 4096, 256, 0, 256, (bf16_t*)(ws + WS_WC1T) + (size_t)j * 256 * 4096, 0, 4096);
    for (int j = 0; j < 2; ++j) seg_rot(C, rot, p.in[11] + (size_t)j * 256 * 128, 256, 128, 0, 128, (bf16_t*)(ws + WS_WC2T) + (size_t)j * 65536, 0, 256);
    seg_rot(C, rot, p.in[12], 1024, 1024, 0, 1024, (bf16_t*)(ws + WS_WOT), 0, 1024);
    seg_rot(C, rot, p.in[15], 1024, 1024, 0, 1024, (bf16_t*)(ws + WS_WQT), 0, 1024);
    seg_rot(C, rot, p.in[16], 1024, 2048, 0, 2048, (bf16_t*)(ws + WS_WKVT), 0, 1024);
    seg_rot(C, rot, p.in[17], 1024, 1024, 0, 1024, (bf16_t*)(ws + WS_WXOT), 0, 1024);
    { const int gt = C.gw * 64 + C.lane, ngt = C.ngw * 64;
      for (int i = gt; i < 2 * 128 * 256 / 8; i += ngt) { const int j = i / (128 * 32), r = i % (128 * 32); *(u32x4*)((bf16_t*)(ws + WS_WC2T) + (size_t)j * 65536 + 128 * 256 + r * 8) = (u32x4){0u, 0u, 0u, 0u}; }
      int* postk = (int*)(ws + WS_POSTK); for (int i = gt; i < MAXPOS; i += ngt) postk[i] = -1; }
    cvt_rows(C, p.in[0], (bf16_t*)((unsigned char*)p.out + DO_XB), (size_t)NTOK * DM);
    cvt_rows(C, p.in[1], (bf16_t*)(ws + WS_FREE), (size_t)2048 * DM);
    extract_cols_f32(C, w_in, 1024, INW, 4096, 16, (float*)(ws + WS_WSMALL), 0);
    extract_cols_f32(C, w_in, 1024, INW, 6672, 24, (float*)(ws + WS_WSMALL), 16);
    extract_cols_f32(C, p.in[20], 1024, 4, 0, 4, (float*)(ws + WS_WR), 0);
    extract_cols_f32(C, p.in[22], 1024, 32, 0, 32, (float*)(ws + WS_WR), 4);
    if (blockIdx.x < 32 && C.tid < 256) { const int j = blockIdx.x >> 4, kc = blockIdx.x & 15, n = C.tid; const float* pe = p.in[8] + (size_t)j * 4096 + kc * 256; const float* w1 = p.in[9] + ((size_t)j * 4096 + kc * 256) * 256 + n;
        float s = 0.f;
#pragma unroll 8
        for (int k = 0; k < 256; ++k) s += pe[k] * w1[(size_t)k * 256];
        ((float*)(ws + WS_BIASP))[(j * 16 + kc) * 256 + n] = s; }
}

__device__ __forceinline__ void phase_moe_weights(const Params& p, const Ctx& C) {
    int rot = 0;
    for (int e = 0; e < 32; ++e) {
        bf16_t* gu = (bf16_t*)(p.ws + WS_WGUT) + (size_t)e * 512 * 1024;
        const float* wg = p.in[24] + (size_t)e * 1024 * 256; const float* wu = p.in[25] + (size_t)e * 1024 * 256;
        for (int pn = 0; pn < 2; ++pn) { seg_rot(C, rot, wg, 1024, 256, 128 * pn, 128, gu, 256 * pn, 1024); seg_rot(C, rot, wu, 1024, 256, 128 * pn, 128, gu, 256 * pn + 128, 1024); }
        seg_rot(C, rot, p.in[26] + (size_t)e * 256 * 1024, 256, 1024, 0, 1024, (bf16_t*)(p.ws + WS_WDT) + (size_t)e * 1024 * 256, 0, 256);
    }
}

__device__ __forceinline__ void rope_pair(bf16_t* ptr, int lane, float c, float s) {
    const float x1 = bf2f(ptr[lane]), x2 = bf2f(ptr[64 + lane]);
    ptr[lane] = f2bf(x1 * c - x2 * s); ptr[64 + lane] = f2bf(x2 * c + x1 * s);
}
__device__ __forceinline__ void phase2(const Params& p, const Ctx& C) {
    unsigned char* ws = p.ws; const int lane = C.lane;
    const float* Wsm = (const float*)(ws + WS_WSMALL);
    const float invf = INV_FREQ[lane];
    const float a_log = (lane >= 8 && lane < 16) ? p.in[5][lane - 8] : 0.f, dtb = (lane >= 8 && lane < 16) ? p.in[6][lane - 8] : 0.f;
    for (int m = C.gw; m < NTOK; m += C.ngw) {
        const int pos = p.positions[m];
        const float ang = (float)pos * invf; const double a = (double)ang; const double kk = __builtin_rint(a * INV_2PI_D); const float r = (float)(a - kk * TWO_PI_D);
        const float c = __cosf(r), s = __sinf(r);
        bf16_t* nq = (bf16_t*)((unsigned char*)p.out + DO_NQ) + (size_t)m * 1024;
#pragma unroll
        for (int h = 0; h < 8; ++h) rope_pair(nq + h * 128, lane, c, s);
#pragma unroll
        for (int sgi = 0; sgi < 3; ++sgi) { bf16_t* kp = (bf16_t*)(ws + WS_KV + (size_t)(2 * sgi) * 8 * MiB) + (size_t)m * 256; rope_pair(kp, lane, c, s); rope_pair(kp + 128, lane, c, s); }
        const float* xr = p.in[0] + (size_t)m * 1024 + 4 * lane;
        f32x4 xv[4];
#pragma unroll
        for (int j = 0; j < 4; ++j) xv[j] = *(const f32x4*)(xr + 256 * j);
        float mine = 0.f;
        for (int col = 0; col < 40; ++col) { const float* wr_ = Wsm + (size_t)col * 1024 + 4 * lane; float d = 0.f;
#pragma unroll
            for (int j = 0; j < 4; ++j) { const f32x4 w = *(const f32x4*)(wr_ + 256 * j); d += xv[j][0] * w[0] + xv[j][1] * w[1] + xv[j][2] * w[2] + xv[j][3] * w[3]; }
            d = wave_sum(d); if (lane == col) mine = d; }
        if (lane < 40) {
            float o;
            if (lane >= 8 && lane < 16) { const float z = mine + dtb; const float sp = fmaxf(z, 0.f) + log1pf(__expf(-fabsf(z))); o = -__expf(a_log) * sp; }
            else o = 1.f / (1.f + __expf(-mine));
            if (lane < 16) ((float*)(ws + WS_AB))[(size_t)m * 16 + lane] = o; else ((float*)(ws + WS_NGATE))[(size_t)m * 24 + lane - 16] = o;
        }
    }
}

__device__ __forceinline__ void phase4(const Params& p, const Ctx& C) {
    const float* part = (const float*)(p.ws + WS_PART); const float* bp = (const float*)(p.ws + WS_BIASP); bf16_t* hid = (bf16_t*)(p.ws + WS_HID);
    const int total = 2 * 2048 * 256 / 4;
    for (int i = C.gw * 64 + C.lane; i < total; i += C.ngw * 64) {
        const int c4 = i % 64, r = (i / 64) % 2048, j = i / (64 * 2048);
        f32x4 v = *(const f32x4*)(p.in[10] + j * 256 + c4 * 4);
#pragma unroll
        for (int kc = 0; kc < 16; ++kc) v += *(const f32x4*)(bp + (j * 16 + kc) * 256 + c4 * 4);
#pragma unroll
        for (int s = 0; s < 8; ++s) v += *(const f32x4*)(part + ((size_t)(s * 2 + j) * 2048 + r) * 256 + c4 * 4);
        float o[4];
#pragma unroll
        for (int q = 0; q < 4; ++q) { const float x = v[q]; const float t = 0.7978845608028654f * (x + 0.044715f * x * x * x); const float e = __expf(2.f * t); const float th = 1.f - 2.f / (e + 1.f); o[q] = 0.5f * x * (1.f + th); }
        u32x2 w; w.x = cvtpk(o[0], o[1]); w.y = cvtpk(o[2], o[3]);
        *(u32x2*)(hid + ((size_t)j * 2048 + r) * 256 + c4 * 4) = w;
    }
}

__device__ __forceinline__ void ln_row(f32x4 (&v)[4], const float* g, const float* b, int lane) {
    float s = 0.f;
#pragma unroll
    for (int j = 0; j < 4; ++j) s += (v[j][0] + v[j][1]) + (v[j][2] + v[j][3]);
    const float mean = wave_sum(s) * (1.f / 1024.f); float s2 = 0.f;
#pragma unroll
    for (int j = 0; j < 4; ++j) { v[j] = v[j] - mean; s2 += (v[j][0] * v[j][0] + v[j][1] * v[j][1]) + (v[j][2] * v[j][2] + v[j][3] * v[j][3]); }
    const float rstd = 1.f / sqrtf(wave_sum(s2) * (1.f / 1024.f) + LN_EPS);
#pragma unroll
    for (int j = 0; j < 4; ++j) { const f32x4 gg = *(const f32x4*)(g + 4 * lane + 256 * j), bb = *(const f32x4*)(b + 4 * lane + 256 * j); v[j] = v[j] * rstd * gg + bb; }
}
__device__ __forceinline__ void phase_ln1(const Params& p, const Ctx& C) {
    float* H = (float*)(p.ws + WS_H); bf16_t* HB = (bf16_t*)(p.ws + WS_HB); const int lane = C.lane;
    for (int m = C.gw; m < NTOK; m += C.ngw) {
        float* row = H + (size_t)m * 1024 + 4 * lane; f32x4 v[4];
#pragma unroll
        for (int j = 0; j < 4; ++j) v[j] = *(const f32x4*)(row + 256 * j);
        ln_row(v, p.in[13], p.in[14], lane);
#pragma unroll
        for (int j = 0; j < 4; ++j) { *(f32x4*)(row + 256 * j) = v[j]; u32x2 w; w.x = cvtpk(v[j][0], v[j][1]); w.y = cvtpk(v[j][2], v[j][3]); *(u32x2*)(HB + (size_t)m * 1024 + 4 * lane + 256 * j) = w; }
    }
}
__device__ __forceinline__ float dot_row(const f32x4 (&v)[4], const float* w, int lane) {
    float d = 0.f;
#pragma unroll
    for (int j = 0; j < 4; ++j) { const f32x4 x = *(const f32x4*)(w + 4 * lane + 256 * j); d += v[j][0] * x[0] + v[j][1] * x[1] + v[j][2] * x[2] + v[j][3] * x[3]; }
    return wave_sum(d);
}
__device__ __forceinline__ void phase_ln2_router(const Params& p, const Ctx& C) {
    float* H = (float*)(p.ws + WS_H); bf16_t* HB = (bf16_t*)(p.ws + WS_HB); const int lane = C.lane;
    const float* Wr = (const float*)(p.ws + WS_WR); unsigned* cnt = (unsigned*)(p.ws + WS_CTL) + CW_CNT;
    int* toke = (int*)(p.ws + WS_TOKE); int* toks = (int*)(p.ws + WS_TOKS); float* tokw = (float*)(p.ws + WS_TOKW);
    for (int m = C.gw; m < NTOK; m += C.ngw) {
        float* row = H + (size_t)m * 1024 + 4 * lane; f32x4 v[4];
#pragma unroll
        for (int j = 0; j < 4; ++j) v[j] = *(const f32x4*)(row + 256 * j);
        ln_row(v, p.in[18], p.in[19], lane);
#pragma unroll
        for (int j = 0; j < 4; ++j) { *(f32x4*)(row + 256 * j) = v[j] * DN_ALPHA; u32x2 w; w.x = cvtpk(v[j][0], v[j][1]); w.y = cvtpk(v[j][2], v[j][3]); *(u32x2*)(HB + (size_t)m * 1024 + 4 * lane + 256 * j) = w; }
        float gl[4];
#pragma unroll
        for (int gi = 0; gi < 4; ++gi) gl[gi] = dot_row(v, Wr + (size_t)gi * 1024, lane) + p.in[21][gi];
        int gs = 0; float gm = gl[0];
#pragma unroll
        for (int gi = 1; gi < 4; ++gi) if (gl[gi] > gm) { gm = gl[gi]; gs = gi; }
        float gsum = 0.f;
#pragma unroll
        for (int gi = 0; gi < 4; ++gi) gsum += __expf(gl[gi] - gm);
        const float p_top = 1.f / gsum;
        gs = __builtin_amdgcn_readfirstlane(gs);
        float el[8];
#pragma unroll
        for (int e = 0; e < 8; ++e) el[e] = dot_row(v, Wr + (size_t)(4 + gs * 8 + e) * 1024, lane) + p.in[23][gs * 8 + e];
        int e0 = 0; float m0 = el[0];
#pragma unroll
        for (int e = 1; e < 8; ++e) if (el[e] > m0) { m0 = el[e]; e0 = e; }
        int e1 = -1; float m1 = -3.0e38f;
#pragma unroll
        for (int e = 0; e < 8; ++e) if (e != e0 && el[e] > m1) { m1 = el[e]; e1 = e; }
        const float q1 = __expf(m1 - m0); const float w0 = p_top / (1.f + q1), w1 = p_top * q1 / (1.f + q1);
        if (lane == 0) {
            const int id0 = gs * 8 + e0, id1 = gs * 8 + e1;
            const unsigned s0 = atomicAdd(cnt + id0, 1u), s1 = atomicAdd(cnt + id1, 1u);
            toke[2 * m] = id0; toke[2 * m + 1] = id1; toks[2 * m] = (int)s0; toks[2 * m + 1] = (int)s1; tokw[2 * m] = w0; tokw[2 * m + 1] = w1;
        }
    }
}
__device__ __forceinline__ void phase_scatter(const Params& p, const Ctx& C) {
    LAS int* tstart = (LAS int*)(C.lds);
    const unsigned* cnt = (const unsigned*)(p.ws + WS_CTL) + CW_CNT;
    if (C.tid == 0) { int acc = 0; for (int e = 0; e < 32; ++e) { tstart[e] = acc; acc += ((int)__hip_atomic_load(cnt + e, __ATOMIC_RELAXED, __HIP_MEMORY_SCOPE_AGENT) + 255) >> 8; } tstart[32] = acc; }
    __syncthreads();
    const int* toke = (const int*)(p.ws + WS_TOKE); const int* toks = (const int*)(p.ws + WS_TOKS); const float* tokw = (const float*)(p.ws + WS_TOKW);
    int* postk = (int*)(p.ws + WS_POSTK); float* posw = (float*)(p.ws + WS_POSW);
    for (int i = C.gw * 64 + C.lane; i < NTOK * 2; i += C.ngw * 64) { const int pos = tstart[toke[i]] * 256 + toks[i]; postk[pos] = i; posw[pos] = tokw[i]; }
    if (blockIdx.x == 0) { int* tileE = (int*)(p.ws + WS_TILEE);
        for (int e = C.tid; e < 32; e += NTHREADS) for (int t = tstart[e]; t < tstart[e + 1]; ++t) tileE[t] = e;
        if (C.tid == 0) tileE[255] = tstart[32]; }
    __syncthreads();
}
__device__ __forceinline__ void phase_final(const Params& p, const Ctx& C) {
    const float* H = (const float*)(p.ws + WS_H); const bf16_t* Y0 = (const bf16_t*)(p.ws + WS_Y0); const bf16_t* Y1 = (const bf16_t*)(p.ws + WS_Y1); const int lane = C.lane;
    for (int m = C.gw; m < NTOK; m += C.ngw) {
        f32x4 v[4];
#pragma unroll
        for (int j = 0; j < 4; ++j) { const size_t off = (size_t)m * 1024 + 4 * lane + 256 * j; v[j] = *(const f32x4*)(H + off);
            const u32x2 a = *(const u32x2*)(Y0 + off), b = *(const u32x2*)(Y1 + off);
            v[j][0] += bflo(a.x) + bflo(b.x); v[j][1] += bfhi(a.x) + bfhi(b.x); v[j][2] += bflo(a.y) + bflo(b.y); v[j][3] += bfhi(a.y) + bfhi(b.y); }
        ln_row(v, p.in[27], p.in[28], lane);
#pragma unroll
        for (int j = 0; j < 4; ++j) *(f32x4*)(p.out + (size_t)m * 1024 + 4 * lane + 256 * j) = v[j];
    }
}
constexpr int KSTR = 272;
constexpr int NL_KC = 0, NL_VC = 128 * KSTR, NL_KS = 2 * 128 * KSTR, NL_VS = NL_KS + 64 * KSTR, NL_IMP = NL_KS  , NL_SELM = NL_VS + 64 * KSTR  ;
constexpr int NL_END = NL_SELM + 512;
static_assert(4 * 64 * 33 * 4 <= 2 * 64 * KSTR, "imp overlay fits in KS|VS");
constexpr int MIX_ITEM_OFF = 151 * 1024;
constexpr size_t WS_SS = WS_HID;

__device__ __forceinline__ int crow(int r, int hi) { return (r & 3) + 8 * (r >> 2) + 4 * hi; }
__device__ __forceinline__ bf16x8 pack8(const f32x16& v, int s) {
    u32x4 w; w.x = cvtpk(v[8 * s + 0], v[8 * s + 1]); w.y = cvtpk(v[8 * s + 2], v[8 * s + 3]); w.z = cvtpk(v[8 * s + 4], v[8 * s + 5]); w.w = cvtpk(v[8 * s + 6], v[8 * s + 7]);
    return __builtin_bit_cast(bf16x8, w);
}
typedef short v4i16_t __attribute__((ext_vector_type(4)));
__device__ __forceinline__ bf16x8 vfrag(const LAS unsigned char* vbase  ) {
    const v4i16_t lo = __builtin_amdgcn_ds_read_tr16_b64_v4i16((LAS v4i16_t*)vbase);
    const v4i16_t hi = __builtin_amdgcn_ds_read_tr16_b64_v4i16((LAS v4i16_t*)(vbase + 8 * KSTR));
    return (bf16x8){lo[0], lo[1], lo[2], lo[3], hi[0], hi[1], hi[2], hi[3]};
}
template <int ROWS> __device__ __forceinline__ void stage_tile(LAS unsigned char* dst, const bf16_t* src, size_t ldg, int tid) {
#pragma unroll
    for (int i = 0; i < ROWS * 16 / NTHREADS; ++i) { const int idx = tid + NTHREADS * i, row = idx >> 4, ch = idx & 15;
        const u32x4 v = *(const u32x4*)(src + (size_t)row * ldg + ch * 8); *(LAS u32x4*)(dst + row * KSTR + ch * 16) = v; }
}
template <int MODE> __device__ __forceinline__ void attn_tile(const LAS unsigned char* KSb, const LAS unsigned char* VSb, const bf16x8 (&qf)[8], int t, int kpos0, bool selq,
                                                               float& m_run, float& l_run, f32x16 (&os)[4], int lane) {
    const int r32 = lane & 31, hi = lane >> 5;
    f32x16 st[2];
#pragma unroll
    for (int sub = 0; sub < 2; ++sub) { st[sub] = (f32x16){};
#pragma unroll
        for (int s = 0; s < 8; ++s) { const bf16x8 a = *(const LAS bf16x8*)(KSb + (32 * sub + r32) * KSTR + (16 * s + 8 * hi) * 2); st[sub] = __builtin_amdgcn_mfma_f32_32x32x16_bf16(a, qf[s], st[sub], 0, 0, 0); } }
    const float SCALE = 0.08838834764831845f;
    float tmax = -3.0e38f;
#pragma unroll
    for (int sub = 0; sub < 2; ++sub)
#pragma unroll
        for (int r = 0; r < 16; ++r) { const int kpos = kpos0 + 32 * sub + crow(r, hi); const int rel = t - kpos;
            const bool valid = MODE == 0 ? (selq && rel >= 0) : (rel >= 0 && rel < 256);
            const float s = valid ? st[sub][r] * SCALE : -3.0e38f; st[sub][r] = s; tmax = fmaxf(tmax, s); }
    tmax = fmaxf(tmax, __shfl_xor(tmax, 32));
    const float m_new = fmaxf(m_run, tmax);
    const float resc = __expf(m_run - m_new);
    float psum = 0.f;
#pragma unroll
    for (int sub = 0; sub < 2; ++sub)
#pragma unroll
        for (int r = 0; r < 16; ++r) { const float s = st[sub][r]; const float e = (s > -1.0e38f) ? __expf(s - m_new) : 0.f; st[sub][r] = e; psum += e; }
    psum += __shfl_xor(psum, 32);
    l_run = l_run * resc + psum; m_run = m_new;
#pragma unroll
    for (int dt = 0; dt < 4; ++dt) os[dt] = os[dt] * resc;
    const int vlane = ((lane & 15) >> 2) * KSTR + (16 * ((lane >> 4) & 1) + 4 * (lane & 3)) * 2;
#pragma unroll
    for (int sub = 0; sub < 2; ++sub)
#pragma unroll
        for (int s = 0; s < 2; ++s) { const bf16x8 pf = pack8(st[sub], s); const LAS unsigned char* vb = VSb + (32 * sub + 16 * s + 4 * hi) * KSTR + vlane;
#pragma unroll
            for (int dt = 0; dt < 4; ++dt) os[dt] = __builtin_amdgcn_mfma_f32_32x32x16_bf16(vfrag(vb + 64 * dt), pf, os[dt], 0, 0, 0);
            __builtin_amdgcn_sched_barrier(0); }
}

template <bool FIRST> __device__ __forceinline__ void emit_branch(bf16_t* yq, const f32x16 (&o)[4], float f, int hi) {
#pragma unroll
    for (int dt = 0; dt < 4; ++dt)
#pragma unroll
        for (int q4 = 0; q4 < 4; ++q4) { bf16_t* ptr = yq + 32 * dt + 8 * q4 + 4 * hi; float v0 = o[dt][4 * q4] * f, v1 = o[dt][4 * q4 + 1] * f, v2 = o[dt][4 * q4 + 2] * f, v3 = o[dt][4 * q4 + 3] * f;
            if (!FIRST) { const u32x2 old = *(const u32x2*)ptr; v0 += bflo(old.x); v1 += bfhi(old.x); v2 += bflo(old.y); v3 += bfhi(old.y); }
            u32x2 w; w.x = cvtpk(v0, v1); w.y = cvtpk(v2, v3); *(u32x2*)ptr = w; }
}

__device__ __forceinline__ void nsa_item(const Params& p, const Ctx& C, int b, int g, int qb) {
    int tid_ = C.tid, lane_ = C.lane; asm volatile("" : "+v"(tid_), "+v"(lane_));
    const int tid = tid_, lane = lane_, w = C.wave, r32 = lane & 31, hi = lane >> 5;
    const int hh = w >> 1, qh = w & 1, head = g * 4 + hh;
    const int t = qb * 64 + qh * 32 + r32;
    const size_t m = (size_t)b * SEQ + t;
    LAS unsigned char* L = C.lds;
    unsigned char* ws = p.ws;
    const int bg = b * 2 + g;
    stage_tile<128>(L + NL_KC, (const bf16_t*)(ws + WS_CMPK) + (size_t)bg * 128 * 128, 128, tid);
    stage_tile<128>(L + NL_VC, (const bf16_t*)(ws + WS_CMPV) + (size_t)bg * 128 * 128, 128, tid);
    bf16_t* yq = (bf16_t*)((unsigned char*)p.out + DO_NQ) + m * 1024 + head * 128;
    bf16x8 qf[8];
#pragma unroll
    for (int s = 0; s < 8; ++s) qf[s] = *(const bf16x8*)(yq + 16 * s + 8 * hi);
    const float* gates = (const float*)(ws + WS_NGATE) + m * 24 + head * 3;
    const float gc = gates[0], gs_ = gates[1], gw_ = gates[2];
    __syncthreads();
    const float SCALE = 0.08838834764831845f;
    {
        f32x16 sc[4]; f32x16 tot[4];
#pragma unroll
        for (int kt = 0; kt < 4; ++kt) { sc[kt] = (f32x16){};
#pragma unroll
            for (int s = 0; s < 8; ++s) { const bf16x8 a = *(const LAS bf16x8*)(L + NL_KC + (32 * kt + r32) * KSTR + (16 * s + 8 * hi) * 2); sc[kt] = __builtin_amdgcn_mfma_f32_32x32x16_bf16(a, qf[s], sc[kt], 0, 0, 0); } }
        const int nmax = (t >= 31) ? ((t - 31) >> 4) : -1;
        float mx = -3.0e38f;
#pragma unroll
        for (int kt = 0; kt < 4; ++kt)
#pragma unroll
            for (int r = 0; r < 16; ++r) { const int n = 32 * kt + crow(r, hi); const float s = (n <= nmax) ? sc[kt][r] * SCALE : -3.0e38f; sc[kt][r] = s; mx = fmaxf(mx, s); }
        mx = fmaxf(mx, __shfl_xor(mx, 32));
        float sum = 0.f;
#pragma unroll
        for (int kt = 0; kt < 4; ++kt)
#pragma unroll
            for (int r = 0; r < 16; ++r) { const float s = sc[kt][r]; const float e = (s > -1.0e38f) ? __expf(s - mx) : 0.f; sc[kt][r] = e; sum += e; }
        sum += __shfl_xor(sum, 32);
        const float inv = sum > 0.f ? 1.f / sum : 0.f;
#pragma unroll
        for (int kt = 0; kt < 4; ++kt) sc[kt] = sc[kt] * inv;
        LAS float* imp = (LAS float*)(L + NL_IMP) + (hh * 64 + qh * 32 + r32) * 33;
        float prev_carry = 0.f;
#pragma unroll
        for (int kt = 0; kt < 4; ++kt)
#pragma unroll
            for (int q4 = 0; q4 < 4; ++q4) {
                const float p3 = 0.5f * sc[kt][4 * q4 + 3];
                const float mainv = sc[kt][4 * q4] + sc[kt][4 * q4 + 1] + sc[kt][4 * q4 + 2] + p3;
                const float rc = __shfl_xor(p3, 32);
                const float add = hi ? rc : prev_carry;
                imp[8 * kt + 2 * q4 + hi] = mainv + add;
                prev_carry = rc;
            }
#pragma unroll
        for (int dt = 0; dt < 4; ++dt) tot[dt] = (f32x16){};
        const int vlane = ((lane & 15) >> 2) * KSTR + (16 * ((lane >> 4) & 1) + 4 * (lane & 3)) * 2;
#pragma unroll
        for (int kt = 0; kt < 4; ++kt)
#pragma unroll
            for (int s = 0; s < 2; ++s) { const bf16x8 pf = pack8(sc[kt], s); const LAS unsigned char* vb = L + NL_VC + (32 * kt + 16 * s + 4 * hi) * KSTR + vlane;
#pragma unroll
                for (int dt = 0; dt < 4; ++dt) tot[dt] = __builtin_amdgcn_mfma_f32_32x32x16_bf16(vfrag(vb + 64 * dt), pf, tot[dt], 0, 0, 0);
                __builtin_amdgcn_sched_barrier(0); }
        emit_branch<true>(yq, tot, gc, hi);
    }
    __syncthreads();
    LAS unsigned* selm = (LAS unsigned*)(L + NL_SELM);
    if (w == 0) {
        LAS float* I0 = (LAS float*)(L + NL_IMP);
        const int qi = lane, cur = qb;
        for (int j = 1; j + 2 <= cur; ++j) { const float v = (I0[(0 * 64 + qi) * 33 + j] + I0[(1 * 64 + qi) * 33 + j]) + (I0[(2 * 64 + qi) * 33 + j] + I0[(3 * 64 + qi) * 33 + j]); I0[qi * 33 + j] = v; }
        unsigned mask = 1u | (1u << cur) | (cur >= 1 ? (1u << (cur - 1)) : 0u);
        const int nsel = 8 - __popc(mask);
        for (int k = 0; k < nsel; ++k) { int best = -1; float bv = -3.0e38f;
            for (int j = 1; j + 2 <= cur; ++j) { const float v = I0[qi * 33 + j]; if (!((mask >> j) & 1u) && v > bv) { bv = v; best = j; } }
            if (best >= 0) mask |= 1u << best; }
        selm[qi] = mask;
        unsigned un = mask;
#pragma unroll
        for (int o = 1; o < 64; o <<= 1) un |= __shfl_xor(un, o);
        if (lane == 0) selm[64] = un;
    }
    __syncthreads();
    const unsigned mymask = selm[qh * 32 + r32], uni = selm[64];
    const bf16_t* kvb = (const bf16_t*)(ws + WS_KV) + (size_t)b * SEQ * 256 + g * 128;
    {
        float m_run = -3.0e38f, l_run = 0.f; f32x16 os[4];
#pragma unroll
        for (int dt = 0; dt < 4; ++dt) os[dt] = (f32x16){};
        for (int j = 0; j <= qb; ++j) {
            if (!((uni >> j) & 1u)) continue;
            __syncthreads();
            stage_tile<64>(L + NL_KS, kvb + (size_t)2 * 4194304 + (size_t)j * 64 * 256, 256, tid);
            stage_tile<64>(L + NL_VS, kvb + (size_t)3 * 4194304 + (size_t)j * 64 * 256, 256, tid);
            __syncthreads();
            const bool selq = (mymask >> j) & 1u;
            if (__any(selq)) attn_tile<0>(L + NL_KS, L + NL_VS, qf, t, j * 64, selq, m_run, l_run, os, lane);
        }
        const float f = l_run > 0.f ? gs_ / l_run : 0.f;
        emit_branch<false>(yq, os, f, hi);
    }
    {
        float m_run = -3.0e38f, l_run = 0.f; f32x16 os[4];
#pragma unroll
        for (int dt = 0; dt < 4; ++dt) os[dt] = (f32x16){};
        for (int j = (qb >= 4 ? qb - 4 : 0); j <= qb; ++j) {
            __syncthreads();
            stage_tile<64>(L + NL_KS, kvb + (size_t)4 * 4194304 + (size_t)j * 64 * 256, 256, tid);
            stage_tile<64>(L + NL_VS, kvb + (size_t)5 * 4194304 + (size_t)j * 64 * 256, 256, tid);
            __syncthreads();
            attn_tile<1>(L + NL_KS, L + NL_VS, qf, t, j * 64, true, m_run, l_run, os, lane);
        }
        const float f = l_run > 0.f ? gw_ / l_run : 0.f;
        emit_branch<false>(yq, os, f, hi);
    }
    __syncthreads();
}

constexpr int GL_QS = 0, GL_KS = 32768, GL_VS = 65536, GL_AB = 81920;
__device__ __forceinline__ void gdn_item(const Params& p, const Ctx& C, int b, int h, int half) {
    int tid_ = C.tid, lane_ = C.lane; asm volatile("" : "+v"(tid_), "+v"(lane_));
    const int tid = tid_, lane = lane_, w = C.wave;
    LAS unsigned char* L = C.lds; unsigned char* ws = p.ws;
    LAS float* QS = (LAS float*)(L + GL_QS); LAS float* KS = (LAS float*)(L + GL_KS); LAS float* VS = (LAS float*)(L + GL_VS); LAS float* AB = (LAS float*)(L + GL_AB);
    const int oct = tid % 40, tr = tid / 40; const bool stager = tid < 320;
    const int seg = oct < 16 ? 0 : (oct < 32 ? 1 : 2);
    const int chl = seg == 0 ? 8 * oct : (seg == 1 ? 8 * (oct - 16) : 8 * (oct - 32));
    const int ch0 = h * 128 + (seg == 2 ? half * 64 : 0) + chl;
    const bf16_t* src = (const bf16_t*)(ws + WS_GQ + (size_t)seg * 32 * MiB) + (size_t)b * SEQ * 1024 + ch0;
    float wt[4][8];
    if (stager) {
#pragma unroll
        for (int k = 0; k < 4; ++k)
#pragma unroll
            for (int e = 0; e < 8; ++e) wt[k][e] = p.in[4][(size_t)k * 3072 + seg * 1024 + ch0 + e];
    }
    const int r8 = lane & 7, cw = w * 8 + (lane >> 3);
    float S[16];
#pragma unroll
    for (int d = 0; d < 16; ++d) S[d] = 0.f;
    const float* ab = (const float*)(ws + WS_AB) + (size_t)b * SEQ * 16;
    bf16_t* zrow = (bf16_t*)(ws + WS_Z) + (size_t)b * SEQ * 1024 + h * 128 + half * 64;
    float* ssp = (float*)(ws + WS_SS) + (size_t)b * SEQ * 16 + h * 2 + half;
    const float nw = p.in[7][half * 64 + lane];
    for (int c0 = 0; c0 < SEQ / 64; ++c0) {
        const int t0 = c0 * 64;
        if (stager) {
            u32x4 raw[11];
#pragma unroll
            for (int i = 0; i < 11; ++i) { const int tt = t0 + 8 * tr - 3 + i; raw[i] = tt >= 0 ? *(const u32x4*)(src + (size_t)tt * 1024) : (u32x4){0u, 0u, 0u, 0u}; }
            LAS float* dstb = (seg == 0 ? QS : (seg == 1 ? KS : VS)) + chl; const int dld = seg == 2 ? 64 : 128;
#pragma unroll
            for (int tt = 0; tt < 8; ++tt) { float o[8];
#pragma unroll
                for (int e = 0; e < 8; ++e) o[e] = 0.f;
#pragma unroll
                for (int k = 0; k < 4; ++k) { const u32x4 rw = raw[tt + k];
#pragma unroll
                    for (int q = 0; q < 4; ++q) { o[2 * q] += wt[k][2 * q] * bflo(rw[q]); o[2 * q + 1] += wt[k][2 * q + 1] * bfhi(rw[q]); } }
#pragma unroll
                for (int e = 0; e < 8; ++e) o[e] = siluf_(o[e]);
                LAS float* d = dstb + (8 * tr + tt) * dld;
                *(LAS f32x4*)d = (f32x4){o[0], o[1], o[2], o[3]}; *(LAS f32x4*)(d + 4) = (f32x4){o[4], o[5], o[6], o[7]}; }
        }
        if (tid >= 448) { const int i = tid - 448; const float* a = ab + (size_t)(t0 + i) * 16; AB[2 * i] = __expf(a[8 + h]); AB[2 * i + 1] = a[h]; }
        __syncthreads();
#pragma unroll 4
        for (int i = 0; i < 16; ++i) { const int rr = w * 16 + i; LAS float* row = (rr < 64 ? QS : KS) + (rr & 63) * 128; const float x0 = row[lane], x1 = row[lane + 64];
            const float ss = wave_sum(x0 * x0 + x1 * x1); const float sc = rsqrtf(ss + RMS_EPS) * (rr < 64 ? 0.08838834764831845f : 1.f); row[lane] = x0 * sc; row[lane + 64] = x1 * sc; }
        __syncthreads();
        for (int i = 0; i < 64; ++i) {
            const float alpha = AB[2 * i], beta = AB[2 * i + 1];
            f32x4 kx[4], qx[4];
#pragma unroll
            for (int j = 0; j < 4; ++j) { kx[j] = *(const LAS f32x4*)(KS + i * 128 + 16 * r8 + 4 * j); qx[j] = *(const LAS f32x4*)(QS + i * 128 + 16 * r8 + 4 * j); }
            float kv = 0.f;
#pragma unroll
            for (int d = 0; d < 16; ++d) { S[d] *= alpha; kv += kx[d >> 2][d & 3] * S[d]; }
            kv += __shfl_xor(kv, 1); kv += __shfl_xor(kv, 2); kv += __shfl_xor(kv, 4);
            const float v = VS[i * 64 + cw];
            const float u = beta * (v - kv);
            float o = 0.f;
#pragma unroll
            for (int d = 0; d < 16; ++d) { S[d] += kx[d >> 2][d & 3] * u; o += qx[d >> 2][d & 3] * S[d]; }
            o += __shfl_xor(o, 1); o += __shfl_xor(o, 2); o += __shfl_xor(o, 4);
            if (r8 == 0) VS[i * 64 + cw] = o;
        }
        __syncthreads();
#pragma unroll 2
        for (int i = 0; i < 8; ++i) { const int tl = w * 8 + i; const float o = VS[tl * 64 + lane]; const float ss = wave_sum(o * o);
            bf16_t* zp = zrow + (size_t)(t0 + tl) * 1024 + lane; const float z = bf2f(*zp); *zp = f2bf(o * nw * siluf_(z));
            if (lane == 0) ssp[(size_t)(t0 + tl) * 16] = ss; }
        __syncthreads();
    }
}

__device__ __forceinline__ void phase_mixer(const Params& p, const Ctx& C) {
    unsigned* q = (unsigned*)(p.ws + WS_CTL) + CW_QUEUE;
    LAS int* itemw = (LAS int*)(C.lds + MIX_ITEM_OFF);
    for (;;) {
        if (C.tid == 0) *itemw = (int)atomicAdd(q, 1u);
        __syncthreads();
        const int item = *itemw;
        __syncthreads();
        if (item >= 128 + 512) break;
#ifndef NO_GDN
        if (item < 128) gdn_item(p, C, item >> 4, (item >> 1) & 7, item & 1);
#endif
#ifndef NO_NSA
        if (item >= 128) { const int k = item - 128; nsa_item(p, C, (k & 15) >> 1, k & 1, 31 - (k >> 4)); }
#endif
    }
}
#ifndef MK_N_LAUNCHES
#define MK_N_LAUNCHES 1
#endif
constexpr int N_PHASES = 19;
constexpr int LDS_TILEE = LDS_SCR + 16 * 1024;

#define XB_TMO      128
#define XB_XCNT(j)  (256  + 64 * (j))
#define XB_XSUB(j)  (1280 + 64 * (j))
#define XB_XGEN(j)  (2304 + 64 * (j))
#define XB_TOP      3328
#define XB_TOPGEN   3392
#define XCD_BAR_WORDS 3456
#define XB_SPIN_CAP (1u << 20)
__device__ __forceinline__ unsigned xb_ld(unsigned* p)              { return __hip_atomic_load(p, __ATOMIC_RELAXED, __HIP_MEMORY_SCOPE_AGENT); }
__device__ __forceinline__ unsigned xb_add(unsigned* p, unsigned v) { return __hip_atomic_fetch_add(p, v, __ATOMIC_RELAXED, __HIP_MEMORY_SCOPE_AGENT); }
__device__ __forceinline__ unsigned xb_xcc_id() { return (unsigned)__builtin_amdgcn_s_getreg((3 << 11) | 20) & 0xFu; }
#define XB_SPIN(cond, bar) do { unsigned _sp = 0; while (cond) { __builtin_amdgcn_s_sleep(1); \
    if ((++_sp & 255u) == 0u) { if (xb_ld(&(bar)[XB_TMO])) break; if (_sp > XB_SPIN_CAP) { atomicAdd(&(bar)[XB_TMO], 1u); break; } } } } while (0)
struct XcdBarrier { unsigned* bar; unsigned x; volatile LAS unsigned* st; };
__device__ __forceinline__ XcdBarrier xcd_barrier_post(unsigned* bar, volatile LAS unsigned* st) {
    XcdBarrier b; b.bar = bar; b.x = xb_xcc_id(); b.st = st;
    if (threadIdx.x == 0) (void)xb_add(&bar[XB_XCNT(b.x)], 1u);
    return b;
}
__device__ __forceinline__ void xcd_barrier_complete(unsigned* bar, unsigned x, unsigned& nloc, unsigned& nx) {
    const unsigned G = gridDim.x;
    unsigned sum, cnt, mine, sp = 0u;
    for (;;) {
        sum = 0u; cnt = 0u; mine = 0u;
#pragma unroll
        for (unsigned j = 0; j < 16; ++j) { const unsigned c = xb_ld(&bar[XB_XCNT(j)]); sum += c; cnt += (c > 0u) ? 1u : 0u; mine = (j == x) ? c : mine; }
        if (sum == G) break;
        __builtin_amdgcn_s_sleep(1);
        if ((++sp & 255u) == 0u) { if (xb_ld(&bar[XB_TMO])) break; if (sp > XB_SPIN_CAP) { atomicAdd(&bar[XB_TMO], 1u); break; } }
    }
    nloc = mine > 0u ? mine : 1u; nx = cnt > 0u ? cnt : 1u;
}
__device__ __forceinline__ void xcd_barrier(const XcdBarrier& b) {
    asm volatile("s_waitcnt vmcnt(0)" ::: "memory");
    __syncthreads();
    if (threadIdx.x == 0) {
        unsigned* bar = b.bar;
        __builtin_amdgcn_s_waitcnt(0);
        unsigned nloc = b.st[0], nx = b.st[1];
        if (nloc == 0u) { xcd_barrier_complete(bar, b.x, nloc, nx); b.st[0] = nloc; b.st[1] = nx; }
        const unsigned old = xb_add(&bar[XB_XSUB(b.x)], 1u);
        const unsigned gen = old / nloc;
        if (old + 1u == (gen + 1u) * nloc) {
            __builtin_amdgcn_fence(__ATOMIC_RELEASE, "agent");
            asm volatile("s_waitcnt vmcnt(0)" ::: "memory");
            const unsigned og = xb_add(&bar[XB_TOP], 1u);
            const unsigned tg = og / nx;
            if (og + 1u == (tg + 1u) * nx) xb_add(&bar[XB_TOPGEN], 1u);
            else XB_SPIN(xb_ld(&bar[XB_TOPGEN]) == tg, bar);
            __builtin_amdgcn_fence(__ATOMIC_ACQUIRE, "agent");
            xb_add(&bar[XB_XGEN(b.x)], 1u);
            asm volatile("s_waitcnt vmcnt(0)" ::: "memory");
        } else {
            XB_SPIN(xb_ld(&bar[XB_XGEN(b.x)]) == gen, bar);
            __builtin_amdgcn_fence(__ATOMIC_ACQUIRE, "agent");
            asm volatile("s_waitcnt vmcnt(0)" ::: "memory");
        }
    }
    __syncthreads();
}
constexpr int LDS_MISC = LDS_BYTES - 256;

__global__ void __launch_bounds__(NTHREADS, 2) mega_fwd(Params p) {
    extern __shared__ __attribute__((aligned(16))) unsigned char lds_raw[];
    Ctx C; C.tid = threadIdx.x; C.lane = C.tid & 63; C.wave = __builtin_amdgcn_readfirstlane(C.tid >> 6); C.gw = blockIdx.x * NWAVES + C.wave; C.ngw = gridDim.x * NWAVES; C.lds = (LAS unsigned char*)lds_raw;
    const int G = gridDim.x, bx = blockIdx.x;
    unsigned char* ws = p.ws; unsigned char* dout = (unsigned char*)p.out;
    LAS unsigned char* lds = C.lds;
#ifdef ONLY_PHASE
#define IN(k) ((k) == ONLY_PHASE)
#else
#define IN(k) (p.ph_lo <= (k) && (k) < p.ph_hi)
#endif
#define SEAM(k) do { if (IN(k) && IN((k) + 1)) xcd_barrier(bar); } while (0)
    volatile LAS unsigned* misc = (volatile LAS unsigned*)(lds + LDS_MISC);
    if (C.tid < 64) misc[C.tid] = 0u;
    __syncthreads();
    XcdBarrier bar; bar.bar = (unsigned*)(ws + WS_CTL) + CW_BAR; bar.x = 0; bar.st = misc;
    if (p.ph_hi - p.ph_lo > 1) bar = xcd_barrier_post((unsigned*)(ws + WS_CTL) + CW_BAR, misc);

    if (IN(0)) phase0(p, C);
    SEAM(0);
    if (IN(1)) {
        { ProbDense P = mk_dense(dout + DO_XB, ws + WS_W1T, 1024, 1024, 1024); pg8::StaticOrder S; S.init(NTOK, 6656, G, bx); EpiProj1 E{ws, dout}; pg8::gemm_phase(lds, P, S, E); }
        { ProbDense P = mk_dense(ws + WS_FREE, ws + WS_WKVT, 1024, 1024, 1024); pg8::StaticOrder S; S.init(2048, 2048, 64, (bx >= 128 && bx < 192) ? bx - 128 : -1);
          EpiKvx E{(bf16_t*)(ws + WS_KX), (bf16_t*)(ws + WS_VT)}; pg8::gemm_phase(lds, P, S, E); }
    }
    SEAM(1);
    if (IN(2)) phase2(p, C);
    SEAM(2);
    if (IN(3)) { ProbCompress P; P.KV = (const char*)(ws + WS_KV); P.W = (const char*)(ws + WS_WC1T); P.ldb = 4096 * 2; P.K = 512;
        pg8::GroupOrder S; S.init(16, 8, 1, G, bx); EpiPart E{(float*)(ws + WS_PART)}; pg8::gemm_phase(lds, P, S, E); }
    SEAM(3);
    if (IN(4)) phase4(p, C);
    SEAM(4);
    if (IN(5)) { ProbDense P = mk_dense(ws + WS_HID, ws + WS_WC2T, 256, 256, 256); P.as1 = (size_t)2048 * 256 * 2; P.bs1 = (size_t)65536 * 2;
        pg8::GroupOrder S; S.init(2, 8, 1, G, bx); EpiCmp2 E{(bf16_t*)(ws + WS_CMPK)}; pg8::gemm_phase(lds, P, S, E); }
    SEAM(5);
    if (IN(6)) phase_mixer(p, C);
    SEAM(6);
    if (IN(7)) {
        phase_moe_weights(p, C);
        __syncthreads();
        ProbDense P = mk_dense(dout + DO_XB, ws + WS_W2T, 1024, 1024, 1024); pg8::StaticOrder S; S.init(NTOK, 2048, G, bx);
        EpiMerge E{(const bf16_t*)(ws + WS_Z), (const bf16_t*)(dout + DO_NQ), (bf16_t*)(ws + WS_FREE), (const float*)(ws + WS_SS)}; pg8::gemm_phase(lds, P, S, E);
    }
    SEAM(7);
    if (IN(8)) { ProbDense P = mk_dense(ws + WS_FREE, ws + WS_WOT, 1024, 1024, 1024); pg8::StaticOrder S; S.init(NTOK, 1024, G, bx);
        EpiResF32 E{p.in[0], (float*)(ws + WS_H), DN_ALPHA}; pg8::gemm_phase(lds, P, S, E); }
    SEAM(8);
    if (IN(9)) phase_ln1(p, C);
    SEAM(9);
    if (IN(10)) { ProbDense P = mk_dense(ws + WS_HB, ws + WS_WQT, 1024, 1024, 1024); pg8::StaticOrder S; S.init(NTOK, 1024, G, bx);
        EpiStoreBf16 E{(bf16_t*)(dout + DO_XB), 1024, 1, 0, 0, 0.0625f}; pg8::gemm_phase(lds, P, S, E); }
    SEAM(10);
    if (IN(11)) { ProbDense P = mk_dense(dout + DO_XB, ws + WS_KX, 1024, 1024, 256); P.gdiv = 4; P.as1 = (size_t)2048 * 1024 * 2; P.as2 = 512; P.bs1 = (size_t)256 * 1024 * 2; P.bs2 = 512;
        pg8::GroupOrder S; S.init(32, 8, 1, G, bx); EpiSoftmax E{(bf16_t*)(dout + DO_NQ)}; pg8::gemm_phase(lds, P, S, E); }
    SEAM(11);
    if (IN(12)) { ProbDense P = mk_dense(dout + DO_NQ, ws + WS_VT, 256, 256, 256); P.as1 = (size_t)2048 * 256 * 2; P.bs1 = (size_t)65536 * 2;
        pg8::GroupOrder S; S.init(32, 8, 1, G, bx); EpiStoreBf16 E{(bf16_t*)(dout + DO_XB), 1024, 4, (size_t)2048 * 1024, 256, 1.f}; pg8::gemm_phase(lds, P, S, E); }
    SEAM(12);
    if (IN(13)) { ProbDense P = mk_dense(dout + DO_XB, ws + WS_WXOT, 1024, 1024, 1024); pg8::StaticOrder S; S.init(NTOK, 1024, G, bx);
        EpiResF32 E{(const float*)(ws + WS_H), (float*)(ws + WS_H), DN_ALPHA}; pg8::gemm_phase(lds, P, S, E); }
    SEAM(13);
    if (IN(14)) phase_ln2_router(p, C);
    SEAM(14);
    if (IN(15)) phase_scatter(p, C);
    SEAM(15);
    if (IN(16) || IN(17)) {
        LAS int* tileE = (LAS int*)(lds + LDS_TILEE); const int* tg = (const int*)(ws + WS_TILEE);
        if (C.tid < 256) tileE[C.tid] = (C.tid < MAXTILES || C.tid == 255) ? tg[C.tid] : 0;
        __syncthreads();
    }
    if (IN(16)) { ProbGather P; P.A = (const char*)(ws + WS_HB); P.postk = (const int*)(ws + WS_POSTK); P.W = (const char*)(ws + WS_WGUT); P.lda = 2048; P.ldb = 2048; P.K = 1024; P.bstride = (size_t)512 * 1024 * 2;
        MoeOrder S{(const LAS int*)(lds + LDS_TILEE), 2, G, bx}; EpiGateUp E{(bf16_t*)(ws + WS_HG)}; pg8::gemm_phase(lds, P, S, E); }
    SEAM(16);
    if (IN(17)) { ProbExpertDense P; P.A = (const char*)(ws + WS_HG); P.W = (const char*)(ws + WS_WDT); P.lda = 512; P.ldb = 512; P.K = 256; P.bstride = (size_t)1024 * 256 * 2;
        MoeOrder S{(const LAS int*)(lds + LDS_TILEE), 4, G, bx}; EpiDown E{(const int*)(ws + WS_POSTK), (const float*)(ws + WS_POSW), (bf16_t*)(ws + WS_Y0), (bf16_t*)(ws + WS_Y1)}; pg8::gemm_phase(lds, P, S, E); }
    SEAM(17);
    if (IN(18)) phase_final(p, C);
#undef IN
#undef SEAM
}

extern "C" void kernel_launch(void* const* d_in, const int* in_sizes, int n_in, void* d_out, int out_size, void* d_ws, size_t ws_size, hipStream_t stream) {
    static int grid = 0;
    if (grid == 0) {
        if (n_in != 29 || out_size != NTOK * DM || ws_size < WS_END) { fprintf(stderr, "kernel_launch: unexpected shapes (n_in %d out %d ws %zu)\n", n_in, out_size, ws_size); grid = -1; return; }
        int dev = 0, cus = 0, per_cu = 0;
        hipGetDevice(&dev); hipDeviceGetAttribute(&cus, hipDeviceAttributeMultiprocessorCount, dev);
        if (hipFuncSetAttribute((const void*)mega_fwd, hipFuncAttributeMaxDynamicSharedMemorySize, LDS_BYTES) != hipSuccess) { fprintf(stderr, "kernel_launch: hipFuncSetAttribute failed\n"); }
        if (hipOccupancyMaxActiveBlocksPerMultiprocessor(&per_cu, (const void*)mega_fwd, NTHREADS, LDS_BYTES) != hipSuccess || per_cu < 1) { fprintf(stderr, "kernel_launch: occupancy query says %d\n", per_cu); per_cu = 1; }
        (void)hipGetLastError();
        grid = cus;
    }
    if (grid < 0) return;
    (void)hipMemsetAsync((char*)d_ws + WS_CTL, 0, 64 * 1024, stream);
    Params p{};
    for (int i = 0; i < 29; ++i) p.in[i] = (const float*)d_in[i];
    p.positions = (const int*)d_in[2]; p.out = (float*)d_out; p.ws = (unsigned char*)d_ws;
    for (int li = 0; li < MK_N_LAUNCHES; ++li) {
        p.ph_lo = (MK_N_LAUNCHES == 1) ? 0 : li; p.ph_hi = (MK_N_LAUNCHES == 1) ? N_PHASES : li + 1;
        void* args[] = {&p};
        hipError_t e = hipLaunchCooperativeKernel((const void*)mega_fwd, dim3(grid), dim3(NTHREADS), args, LDS_BYTES, stream);
        if (e != hipSuccess) { fprintf(stderr, "kernel_launch: cooperative launch %d failed: %s (grid %d)\n", li, hipGetErrorString(e), grid); break; }
    }
}
```

```cpp
#include <hip/hip_runtime.h>
#include <cstdio>
#include <cstdint>

#define LAS __attribute__((address_space(3)))
typedef unsigned short bf16_t;
typedef short bf16x8 __attribute__((ext_vector_type(8)));
typedef short s16x4 __attribute__((ext_vector_type(4)));
typedef float f32x2 __attribute__((ext_vector_type(2)));
typedef float f32x4 __attribute__((ext_vector_type(4)));
typedef float f32x16 __attribute__((ext_vector_type(16)));
typedef unsigned u32x2 __attribute__((ext_vector_type(2)));
typedef unsigned u32x4 __attribute__((ext_vector_type(4)));
typedef __bf16 bf16x2_t __attribute__((ext_vector_type(2)));

__device__ __forceinline__ unsigned cvtpk(float lo, float hi) { f32x2 v = {lo, hi}; bf16x2_t b = __builtin_convertvector(v, bf16x2_t); return __builtin_bit_cast(unsigned, b); }
__device__ __forceinline__ float bflo(unsigned u) { return __uint_as_float(u << 16); }
__device__ __forceinline__ float bfhi(unsigned u) { return __uint_as_float(u & 0xffff0000u); }
__device__ __forceinline__ float bf2f(bf16_t h) { return __uint_as_float(((unsigned)h) << 16); }
__device__ __forceinline__ bf16_t f2bf(float f) { return (bf16_t)(cvtpk(f, 0.f) & 0xffffu); }
__device__ __forceinline__ float sigmoidf_(float x) { return __builtin_amdgcn_rcpf(1.f + __expf(-x)); }
__device__ __forceinline__ float siluf_(float x) { return x * __builtin_amdgcn_rcpf(1.f + __expf(-x)); }
template <int CTRL> __device__ __forceinline__ float dpp_f(float v) { return __int_as_float(__builtin_amdgcn_update_dpp(0, __float_as_int(v), CTRL, 0xF, 0xF, true)); }
__device__ __forceinline__ float sum4(float v) { v += dpp_f<0xB1>(v); v += dpp_f<0x4E>(v); return v; }
__device__ __forceinline__ float sum8(float v) { v = sum4(v); v += dpp_f<0x141>(v); return v; }
__device__ __forceinline__ float sum16(float v) { v = sum8(v); v += dpp_f<0x140>(v); return v; }
__device__ __forceinline__ float rdlane(float v, int l) { return __int_as_float(__builtin_amdgcn_readlane(__float_as_int(v), l)); }
__device__ __forceinline__ float wave_sum(float v) {
    v = sum16(v);
    v += __int_as_float(__builtin_amdgcn_update_dpp(0, __float_as_int(v), 0x142, 0xA, 0xF, false));
    v += __int_as_float(__builtin_amdgcn_update_dpp(0, __float_as_int(v), 0x143, 0xC, 0xF, false));
    return rdlane(v, 63);
}
__device__ __forceinline__ float xor32_sum(float v) { auto rr = __builtin_amdgcn_permlane32_swap(__float_as_uint(v), __float_as_uint(v), false, false); return __uint_as_float(rr[0]) + __uint_as_float(rr[1]); }
__device__ __forceinline__ float xor32_max(float v) { auto rr = __builtin_amdgcn_permlane32_swap(__float_as_uint(v), __float_as_uint(v), false, false); return fmaxf(__uint_as_float(rr[0]), __uint_as_float(rr[1])); }
__device__ __forceinline__ float xor32_get(float v, int hi) { auto rr = __builtin_amdgcn_permlane32_swap(__float_as_uint(v), __float_as_uint(v), false, false); return hi ? __uint_as_float(rr[0]) : __uint_as_float(rr[1]); }
__device__ __forceinline__ int lane_id() { int l = (int)__builtin_amdgcn_mbcnt_hi(~0u, __builtin_amdgcn_mbcnt_lo(~0u, 0u)); asm volatile("" : "+v"(l)); return l; }
#define LDS_WAIT() asm volatile("s_waitcnt lgkmcnt(0)" ::: "memory")
#define RAW_BAR() do { asm volatile("s_waitcnt lgkmcnt(0)" ::: "memory"); __builtin_amdgcn_s_barrier(); asm volatile("" ::: "memory"); } while (0)

namespace pg8 {
constexpr int BM = 256, BK = 64, HALF = 128, HTB = HALF * BK * 2, STAGE_BYTES = 8 * HTB, NXCD = 8, WGM = 8;
__host__ __device__ __forceinline__ int lds_byte(int r, int c) { const int st = (r >> 4) * 2 + (c >> 5), rr = r & 15, cc = c & 31, ob = rr * 64 + cc * 2; return st * 1024 + (ob ^ (((ob >> 9) & 1) << 5)); }
__host__ __device__ __forceinline__ void stage_rc(int b, int& R, int& C) { const int st = b / 1024, sb = b % 1024, swz = sb ^ (((sb >> 9) & 1) << 5); R = (st >> 1) * 16 + swz / 64; C = (st & 1) * 32 + (swz % 64) / 2; }
__host__ __device__ __forceinline__ int perm32(int rho) { const int n = rho >> 4, i = rho & 15; return 8 * (i >> 2) + 4 * n + (i & 3); }

struct Unit { int pm, pn, g; };

struct StaticOrder {
    int nM, nN, nwg, G, c;
    __device__ void init(int M, int N, int G_, int c_) { nM = M / BM; nN = N / BM; nwg = nM * nN; G = G_; c = c_; }
    __device__ bool next(int i, Unit& u) const {
        if (c < 0) return false;
        const long L = (long)i * G + c; if (L >= nwg) return false;
        int wgid = (int)L; { const int q = nwg / NXCD, r = nwg % NXCD, xcd = wgid % NXCD, off = wgid / NXCD; wgid = (xcd < r ? xcd * (q + 1) : r * (q + 1) + (xcd - r) * q) + off; }
        const int nig = WGM * nN, gid = wgid / nig, fm = gid * WGM, gsz = (nM - fm) < WGM ? (nM - fm) : WGM;
        u.pm = fm + ((wgid % nig) % gsz); u.pn = (wgid % nig) / gsz; u.g = 0; return true;
    }
    __device__ __forceinline__ void a_ready(const Unit&) const {}
    __device__ __forceinline__ void done(const Unit&) const {}
};
struct GroupOrder {
    int nM, nN, ng, G, c;
    __device__ void init(int ng_, int nM_, int nN_, int G_, int c_) { ng = ng_; nM = nM_; nN = nN_; G = G_; c = c_; }
    __device__ bool next(int i, Unit& u) const {
        if (c < 0) return false;
        const long L = (long)i * G + c; if (L >= (long)ng * nM * nN) return false;
        const int per = nM * nN; u.g = (int)(L / per); const int r = (int)(L % per); u.pm = r / nN; u.pn = r % nN; return true;
    }
    __device__ __forceinline__ void a_ready(const Unit&) const {}
    __device__ __forceinline__ void done(const Unit&) const {}
};

template <class Prob, class Epi, class Sched>
__device__ __forceinline__ void gemm_phase(LAS unsigned char* lds, int wid, const Prob& P, const Sched& S, const Epi& E) {
    const int lane = lane_id(), tid = wid * 64 + lane, wr = wid >> 2, wc = wid & 3, fr = lane & 15, fq = lane >> 4;
    const int nt = P.K / BK;
    int Rp[2], Cp[2];
    unsigned voffB[2];
#pragma unroll
    for (int i = 0; i < 2; ++i) { stage_rc(tid * 16 + i * 8192, Rp[i], Cp[i]); const int Rb = Epi::PERM ? ((Rp[i] & ~31) + perm32(Rp[i] & 31)) : Rp[i]; voffB[i] = (unsigned)(Rb * P.ldb + Cp[i] * 2); }
    const size_t kstep = (size_t)(BK * 2);
    const size_t hstepB = (size_t)HALF * P.ldb;
    const unsigned ldsw = (unsigned)wid * 1024u;
    const int aoff = lds_byte(wr * 64 + fr, fq * 8), boff = lds_byte(wc * 32 + fr, fq * 8);
#define PG8_SA(b, h) (((b) * 2 + (h)) * HTB)
#define PG8_SB(b, h) ((4 + (b) * 2 + (h)) * HTB)
#define PG8_STAGEB(bufoff, gbase) do { _Pragma("unroll") for (int _i = 0; _i < 2; ++_i) \
        __builtin_amdgcn_global_load_lds((const unsigned*)((const char*)(gbase) + voffB[_i]), (LAS unsigned*)(lds + (bufoff) + ldsw + _i * 8192), 16, 0, 0); } while (0)
#define PG8_STAGEA(bufoff, gbase, v0, v1) do { \
        __builtin_amdgcn_global_load_lds((const unsigned*)((const char*)(gbase) + (v0)), (LAS unsigned*)(lds + (bufoff) + ldsw), 16, 0, 0); \
        __builtin_amdgcn_global_load_lds((const unsigned*)((const char*)(gbase) + (v1)), (LAS unsigned*)(lds + (bufoff) + ldsw + 8192), 16, 0, 0); } while (0)
#define PG8_LDA(dst, b, h) do { _Pragma("unroll") for (int m = 0; m < 4; ++m) _Pragma("unroll") for (int k = 0; k < 2; ++k) dst[m][k] = *(const LAS bf16x8*)(lds + PG8_SA(b, h) + aoff + m * 2048 + k * 1024); } while (0)
#define PG8_LDB(dst, b, h) do { _Pragma("unroll") for (int n = 0; n < 2; ++n) _Pragma("unroll") for (int k = 0; k < 2; ++k) dst[n][k] = *(const LAS bf16x8*)(lds + PG8_SB(b, h) + boff + n * 2048 + k * 1024); } while (0)
#define PG8_MMA(ai, bj, At, Bt) do { __builtin_amdgcn_s_setprio(1); _Pragma("unroll") for (int m = 0; m < 4; ++m) _Pragma("unroll") for (int n = 0; n < 2; ++n) _Pragma("unroll") for (int k = 0; k < 2; ++k) \
        acc[ai][bj][m][n] = __builtin_amdgcn_mfma_f32_16x16x32_bf16(Bt[n][k], At[m][k], acc[ai][bj][m][n], 0, 0, 0); __builtin_amdgcn_s_setprio(0); } while (0)
#define PG8_WAIT_V(n) asm volatile("s_waitcnt vmcnt(" #n ")" ::: "memory")
#define PG8_WAIT_L(n) asm volatile("s_waitcnt lgkmcnt(" #n ")" ::: "memory")
#define PG8_BAR __builtin_amdgcn_s_barrier()
#define PG8_SCHED __builtin_amdgcn_sched_barrier(0)
    Unit cur, nxt; int ui = 0;
    if (!S.next(0, cur)) return;
    f32x4 acc[2][2][4][2];
#pragma unroll
    for (int a = 0; a < 2; ++a)
#pragma unroll
        for (int b = 0; b < 2; ++b)
#pragma unroll
            for (int m = 0; m < 4; ++m)
#pragma unroll
                for (int n = 0; n < 2; ++n) acc[a][b][m][n] = (f32x4){0.f, 0.f, 0.f, 0.f};
    bf16x8 At[4][2], B0[2][2], B1[2][2];
    const char* cA = P.a_base(cur); const char* cB = P.b_base(cur);
    unsigned vc00, vc01, vc10, vc11, vn00, vn01, vn10, vn11;
    vc00 = P.a_rowoff(cur, Rp[0]) + Cp[0] * 2; vc01 = P.a_rowoff(cur, Rp[1]) + Cp[1] * 2;
    vc10 = P.a_rowoff(cur, HALF + Rp[0]) + Cp[0] * 2; vc11 = P.a_rowoff(cur, HALF + Rp[1]) + Cp[1] * 2;
    {
        PG8_STAGEB(PG8_SB(0, 0), cB); PG8_STAGEB(PG8_SB(0, 1), cB + hstepB);
        S.a_ready(cur);
        PG8_STAGEA(PG8_SA(0, 0), cA + P.a_koff(0), vc00, vc01); PG8_STAGEA(PG8_SA(0, 1), cA + P.a_koff(0), vc10, vc11);
        if (wr == 1) PG8_BAR;
        PG8_WAIT_V(2); PG8_BAR;
        PG8_STAGEB(PG8_SB(1, 0), cB + kstep); PG8_STAGEA(PG8_SA(1, 0), cA + P.a_koff(1), vc00, vc01); PG8_STAGEB(PG8_SB(1, 1), cB + hstepB + kstep);
        PG8_WAIT_V(6); PG8_BAR;
    }
    for (;;) {
        const bool has_next = S.next(ui + 1, nxt);
        const char* nA = has_next ? P.a_base(nxt) : cA; const char* nB = has_next ? P.b_base(nxt) : cB;
        if (Prob::UNIT_DEP && has_next) {
            vn00 = P.a_rowoff(nxt, Rp[0]) + Cp[0] * 2; vn01 = P.a_rowoff(nxt, Rp[1]) + Cp[1] * 2;
            vn10 = P.a_rowoff(nxt, HALF + Rp[0]) + Cp[0] * 2; vn11 = P.a_rowoff(nxt, HALF + Rp[1]) + Cp[1] * 2;
        } else { vn00 = vc00; vn01 = vc01; vn10 = vc10; vn11 = vc11; }
        for (int t = 0; t < nt; t += 2) {
            const bool last = (t == nt - 2);
            if (last && has_next) S.a_ready(nxt);
            const char* a1 = cA + P.a_koff(t + 1);
            const char* a2 = last ? nA + P.a_koff(0) : cA + P.a_koff(t + 2);
            const char* a3 = last ? nA + P.a_koff(1) : cA + P.a_koff(t + 3);
            const char* b2 = last ? nB : cB + (size_t)(t + 2) * kstep; const char* b3 = b2 + kstep;
            const unsigned w00 = (Prob::UNIT_DEP && last) ? vn00 : vc00, w01 = (Prob::UNIT_DEP && last) ? vn01 : vc01, w10 = (Prob::UNIT_DEP && last) ? vn10 : vc10, w11 = (Prob::UNIT_DEP && last) ? vn11 : vc11;
            PG8_LDB(B0, 0, 0); PG8_LDB(B1, 0, 1); PG8_SCHED; PG8_LDA(At, 0, 0); PG8_STAGEA(PG8_SA(1, 1), a1, vc10, vc11);
            PG8_WAIT_V(8); PG8_WAIT_L(0); PG8_BAR; PG8_MMA(0, 0, At, B0); PG8_MMA(0, 1, At, B1); PG8_BAR; PG8_SCHED;
            PG8_LDA(At, 0, 1); PG8_STAGEB(PG8_SB(0, 0), b2); PG8_STAGEB(PG8_SB(0, 1), b2 + hstepB); PG8_STAGEA(PG8_SA(0, 0), a2, w00, w01);
            PG8_WAIT_V(8); PG8_WAIT_L(0); PG8_BAR; PG8_MMA(1, 0, At, B0); PG8_MMA(1, 1, At, B1); PG8_BAR; PG8_SCHED;
            PG8_LDB(B0, 1, 0); PG8_LDB(B1, 1, 1); PG8_SCHED; PG8_LDA(At, 1, 0); PG8_STAGEA(PG8_SA(0, 1), a2, w10, w11);
            PG8_WAIT_V(8); PG8_WAIT_L(0); PG8_BAR; PG8_MMA(0, 0, At, B0); PG8_MMA(0, 1, At, B1); PG8_BAR; PG8_SCHED;
            PG8_LDA(At, 1, 1); PG8_STAGEB(PG8_SB(1, 0), b3); PG8_STAGEB(PG8_SB(1, 1), b3 + hstepB); PG8_STAGEA(PG8_SA(1, 0), a3, w00, w01);
            PG8_WAIT_V(8); PG8_WAIT_L(0); PG8_BAR; PG8_MMA(1, 0, At, B0); PG8_MMA(1, 1, At, B1); PG8_BAR; PG8_SCHED;
        }
        if (wr == 0) PG8_BAR;
        E(acc, cur, wr, wc, fr, fq, lds + STAGE_BYTES, wid, lane);
        S.done(cur);
        if (!has_next) break;
#pragma unroll
        for (int a = 0; a < 2; ++a)
#pragma unroll
            for (int b = 0; b < 2; ++b)
#pragma unroll
                for (int m = 0; m < 4; ++m)
#pragma unroll
                    for (int n = 0; n < 2; ++n) acc[a][b][m][n] = (f32x4){0.f, 0.f, 0.f, 0.f};
        cur = nxt; cA = nA; cB = nB; vc00 = vn00; vc01 = vn01; vc10 = vn10; vc11 = vn11; ++ui;
        if (wr == 1) PG8_BAR;
    }
    PG8_WAIT_V(0);
    PG8_BAR;
#undef PG8_SA
#undef PG8_SB
#undef PG8_STAGEA
#undef PG8_STAGEB
#undef PG8_LDA
#undef PG8_LDB
#undef PG8_MMA
#undef PG8_WAIT_V
#undef PG8_WAIT_L
#undef PG8_BAR
#undef PG8_SCHED
}

__device__ __forceinline__ void store_tile_bf16(const f32x4 (&acc)[2][2][4][2], bf16_t* tile_base, size_t ld, int wr, int wc, int fr, int fq, float sc) {
#pragma unroll
    for (int ai = 0; ai < 2; ++ai)
#pragma unroll
        for (int m = 0; m < 4; ++m) { bf16_t* rowp = tile_base + (size_t)(ai * HALF + wr * 64 + m * 16 + fr) * ld + wc * 32 + 8 * fq;
#pragma unroll
            for (int bj = 0; bj < 2; ++bj) { const f32x4 v0 = acc[ai][bj][m][0] * sc, v1 = acc[ai][bj][m][1] * sc; u32x4 w; w.x = cvtpk(v0[0], v0[1]); w.y = cvtpk(v0[2], v0[3]); w.z = cvtpk(v1[0], v1[1]); w.w = cvtpk(v1[2], v1[3]);
                *(u32x4*)(rowp + bj * HALF) = w; } }
}
}
constexpr int NTOK = 16384, DM = 1024, SEQ = 2048, NB = 8, INW = 8744;
constexpr int NWAVES = 8, NTHREADS = 512;
constexpr float DN_ALPHA = 1.189207115002721f;
constexpr float LN_EPS = 1e-5f, RMS_EPS = 1e-6f;
constexpr size_t MiB = 1u << 20;
constexpr size_t WS_CTL = 0;
constexpr size_t WS_LG = 1 * MiB;
constexpr size_t WS_WSMALL = 3 * MiB + 512 * 1024;
constexpr size_t WS_WR = WS_WSMALL + 40 * 4096;
constexpr size_t WS_BIASP = WS_WR + 36 * 4096;
constexpr size_t WS_CMPK = 4 * MiB;
constexpr size_t WS_CMPV = 4 * MiB + 512 * 1024;
constexpr size_t WS_HID = 5 * MiB;
constexpr size_t WS_LIST = 4 * MiB;
constexpr size_t WS_LISTW = 6 * MiB;
constexpr int MOE_CAP = 16384;
constexpr int MAXPOS = 40960, MAXTILES = 160;
constexpr size_t WS_KX = 8 * MiB;
constexpr size_t WS_VT = 12 * MiB;
constexpr size_t WS_W1T = 16 * MiB;
constexpr size_t WS_W2T = 29 * MiB + 512 * 1024;
constexpr size_t WS_WC1T = 33 * MiB + 512 * 1024;
constexpr size_t WS_WC2T = 37 * MiB + 512 * 1024;
constexpr size_t WS_WOT = 38 * MiB;
constexpr size_t WS_WQT = WS_WOT + 2 * MiB;
constexpr size_t WS_WKVT = WS_WQT + 2 * MiB;
constexpr size_t WS_WXOT = WS_WKVT + 4 * MiB;
constexpr size_t WS_GQ = 48 * MiB, WS_GK = 80 * MiB, WS_GV = 112 * MiB, WS_Z = 144 * MiB;
constexpr size_t WS_KV = 176 * MiB;
constexpr size_t WS_FREE = 224 * MiB;
constexpr size_t WS_PART = 240 * MiB;
constexpr size_t WS_HALO = 228 * MiB;
constexpr size_t WS_H = 48 * MiB;
constexpr size_t WS_HB = 112 * MiB;
constexpr size_t WS_WGUT = 176 * MiB;
constexpr size_t WS_WDT = 208 * MiB;
constexpr size_t WS_HG = 144 * MiB;
constexpr size_t WS_Y0 = 8 * MiB;
constexpr size_t WS_Y1 = 224 * MiB;
constexpr size_t WS_END = 256 * MiB;
constexpr size_t DO_XB = 0, DO_NQ = 32 * MiB;
constexpr int CW_QUEUE = 64;
constexpr int CW_CNT = 8192;
constexpr int CW_BAR = 1024;
constexpr int CW_CMP = 4608;
constexpr int CW_RDY = 5120;
constexpr int CW_PAN = 10240;
constexpr int CW_GRDY = 13312;
constexpr int CW_C2RDY = 14336;
constexpr int CW_LNX = 16384;
constexpr size_t WS_XBUF = WS_LG;

constexpr int LDS_BYTES = 152 * 1024;
constexpr int LDS_SCR = pg8::STAGE_BYTES;

__device__ const float INV_FREQ[64] = {
1.000000000e+00f, 8.659643531e-01f, 7.498942614e-01f, 6.493816376e-01f, 5.623413324e-01f, 4.869675338e-01f, 4.216965139e-01f, 3.651741147e-01f, 3.162277639e-01f, 2.738419771e-01f, 2.371373773e-01f, 2.053525001e-01f, 1.778279394e-01f, 1.539926529e-01f, 1.333521307e-01f, 1.154782027e-01f, 1.000000015e-01f, 8.659642935e-02f, 7.498941571e-02f, 6.493816525e-02f, 5.623413250e-02f, 4.869675264e-02f, 4.216965288e-02f, 3.651741147e-02f, 3.162277490e-02f, 2.738419734e-02f, 2.371373773e-02f, 2.053525113e-02f, 1.778279431e-02f, 1.539926510e-02f, 1.333521493e-02f, 1.154782064e-02f, 9.999999776e-03f, 8.659643121e-03f, 7.498941850e-03f, 6.493816152e-03f, 5.623413250e-03f, 4.869675264e-03f, 4.216964822e-03f, 3.651741194e-03f, 3.162277630e-03f, 2.738419687e-03f, 2.371373586e-03f, 2.053524833e-03f, 1.778279431e-03f, 1.539926510e-03f, 1.333521446e-03f, 1.154781901e-03f, 1.000000047e-03f, 8.659643354e-04f, 7.498942432e-04f, 6.493816618e-04f, 5.623413017e-04f, 4.869675322e-04f, 4.216965172e-04f, 3.651741426e-04f, 3.162277571e-04f, 2.738419571e-04f, 2.371373703e-04f, 2.053525095e-04f, 1.778279402e-04f, 1.539926452e-04f, 1.333521504e-04f, 1.154782003e-04f
};
constexpr double TWO_PI_D = 6.283185307179586476925287, INV_2PI_D = 0.159154943091895335768884;

struct Params {
    const float* in[29];
    const int* positions;
    float* out;
    unsigned char* ws;
    int ph_lo, ph_hi;
};

struct Ctx { int wave, gw, ngw; LAS unsigned char* lds;
    __device__ __forceinline__ int lane() const { return lane_id(); }
    __device__ __forceinline__ int tid() const { return wave * 64 + lane_id(); } };

template <bool ROPEPERM = false> __device__ __forceinline__ void transpose_seg(const Ctx& C, const float* W, int K, int Nsrc, int col0, int cnt, bf16_t* WT, int drow0, int ldd) {
    LAS float* scr = (LAS float*)(C.lds + C.wave * 16384);
    const int nblk = cnt / 32, nitems = (K / 64) * nblk, lane = C.lane();
    for (int item = C.gw; item < nitems; item += C.ngw) {
        const int kb = item / nblk, nb = item % nblk, k0 = 64 * kb, n0 = col0 + 32 * nb;
#pragma unroll 8
        for (int i = 0; i < 32; ++i) { const int kk = 2 * i + (lane >> 5); scr[kk * 33 + (lane & 31)] = W[(size_t)(k0 + kk) * Nsrc + n0 + (lane & 31)]; }
        LDS_WAIT(); asm volatile("" ::: "memory");
        const int c = lane & 7;
#pragma unroll
        for (int j = 0; j < 4; ++j) { const int n = (lane >> 3) + 8 * j; const LAS float* s = scr + (8 * c) * 33 + n;
            u32x4 o; o.x = cvtpk(s[0 * 33], s[1 * 33]); o.y = cvtpk(s[2 * 33], s[3 * 33]); o.z = cvtpk(s[4 * 33], s[5 * 33]); o.w = cvtpk(s[6 * 33], s[7 * 33]);
            int dr = 32 * nb + n; if (ROPEPERM) { const int hc = dr & 127; dr = (dr & ~127) + (hc < 64 ? 2 * hc : 2 * (hc - 64) + 1); }
            *(u32x4*)(WT + (size_t)(drow0 + dr) * ldd + k0 + 8 * c) = o; }
        LDS_WAIT(); asm volatile("" ::: "memory");
    }
}
__device__ __forceinline__ void cvt_rows(const Ctx& C, const float* src, bf16_t* dst, size_t n) {
    const size_t nv = n / 8;
    for (size_t i = (size_t)C.gw * 64 + C.lane(); i < nv; i += (size_t)C.ngw * 64) {
        const f32x4 a = *(const f32x4*)(src + i * 8), b = *(const f32x4*)(src + i * 8 + 4);
        u32x4 o; o.x = cvtpk(a[0], a[1]); o.y = cvtpk(a[2], a[3]); o.z = cvtpk(b[0], b[1]); o.w = cvtpk(b[2], b[3]);
        *(u32x4*)(dst + i * 8) = o;
    }
}
__device__ __forceinline__ void extract_cols_f32(const Ctx& C, const float* W, int K, int Nsrc, int col0, int cnt, float* WT, int drow0) {
    const int total = K * cnt;
    for (int i = C.gw * 64 + C.lane(); i < total; i += C.ngw * 64) { const int k = i / cnt, j = i % cnt; WT[(size_t)(drow0 + j) * K + k] = W[(size_t)k * Nsrc + col0 + j]; }
}
struct ProbDense {
    static constexpr bool UNIT_DEP = false;
    const char* A; const char* Bt; int lda, ldb, K; int gsh; size_t as1, as2, bs1, bs2;
    __device__ __forceinline__ const char* a_base(const pg8::Unit& u) const { return A + (size_t)(u.g >> gsh) * as1 + (size_t)(u.g & ((1 << gsh) - 1)) * as2 + (size_t)u.pm * 256 * lda; }
    __device__ __forceinline__ unsigned a_rowoff(const pg8::Unit&, int r) const { return (unsigned)(r * lda); }
    __device__ __forceinline__ size_t a_koff(int t) const { return (size_t)t * 128; }
    __device__ __forceinline__ const char* b_base(const pg8::Unit& u) const { return Bt + (size_t)(u.g >> gsh) * bs1 + (size_t)(u.g & ((1 << gsh) - 1)) * bs2 + (size_t)u.pn * 256 * ldb; }
};
__device__ __forceinline__ ProbDense mk_dense(const void* A, const void* Bt, int lda_el, int ldb_el, int K) { ProbDense p; p.A = (const char*)A; p.Bt = (const char*)Bt; p.lda = lda_el * 2; p.ldb = ldb_el * 2; p.K = K; p.gsh = 0; p.as1 = p.as2 = p.bs1 = p.bs2 = 0; return p; }

struct ProbBatchB {
    static constexpr bool UNIT_DEP = false;
    const char* A; const char* Bt; int lda, ldb, K; size_t bstride;
    __device__ __forceinline__ const char* a_base(const pg8::Unit& u) const { return A + (size_t)u.pm * 256 * lda; }
    __device__ __forceinline__ unsigned a_rowoff(const pg8::Unit&, int r) const { return (unsigned)(r * lda); }
    __device__ __forceinline__ size_t a_koff(int t) const { return (size_t)t * 128; }
    __device__ __forceinline__ const char* b_base(const pg8::Unit& u) const { return Bt + (size_t)(u.pm >> 3) * bstride + (size_t)u.pn * 256 * ldb; }
};
struct ProbCompress {
    static constexpr bool UNIT_DEP = false;
    const char* KV; const char* W; int ldb, K;
    __device__ __forceinline__ const char* a_base(const pg8::Unit& u) const { return KV + (size_t)(u.g >> 3) * 8 * MiB + (size_t)(u.g & 7) * 4 * 512 + (size_t)u.pm * 2048 * 512; }
    __device__ __forceinline__ unsigned a_rowoff(const pg8::Unit&, int r) const { int n = r & 127; n = n > 126 ? 126 : n; return (unsigned)(n * 16 * 512 + (r >> 7) * 256); }
    __device__ __forceinline__ size_t a_koff(int t) const { return (size_t)(t >> 1) * 512 + (size_t)(t & 1) * 128; }
    __device__ __forceinline__ const char* b_base(const pg8::Unit& u) const { return W + (size_t)(u.g >> 3) * 256 * 4096 * 2 + (size_t)(u.g & 7) * 512 * 2; }
};
__device__ __forceinline__ int moe_entry(const int* list, const LAS int* tinfo, const pg8::Unit& u, int r) {
    const int sl = (u.pm - tinfo[u.g]) * 256 + r; return sl < tinfo[33 + u.g] ? list[u.g * MOE_CAP + sl] : -1;
}
struct ProbGather {
    static constexpr bool UNIT_DEP = true;
    const char* A; const int* list; const LAS int* tinfo; const char* W; int lda, ldb, K; size_t bstride;
    __device__ __forceinline__ const char* a_base(const pg8::Unit&) const { return A; }
    __device__ __forceinline__ unsigned a_rowoff(const pg8::Unit& u, int r) const { int t = moe_entry(list, tinfo, u, r); t = t < 0 ? 0 : (t >> 1); return (unsigned)(t * lda); }
    __device__ __forceinline__ size_t a_koff(int t) const { return (size_t)t * 128; }
    __device__ __forceinline__ const char* b_base(const pg8::Unit& u) const { return W + (size_t)u.g * bstride + (size_t)u.pn * 256 * ldb; }
};
struct ProbExpertDense {
    static constexpr bool UNIT_DEP = false;
    const char* A; const char* W; int lda, ldb, K; size_t bstride;
    __device__ __forceinline__ const char* a_base(const pg8::Unit& u) const { return A + (size_t)u.pm * 256 * lda; }
    __device__ __forceinline__ unsigned a_rowoff(const pg8::Unit&, int r) const { return (unsigned)(r * lda); }
    __device__ __forceinline__ size_t a_koff(int t) const { return (size_t)t * 128; }
    __device__ __forceinline__ const char* b_base(const pg8::Unit& u) const { return W + (size_t)u.g * bstride + (size_t)u.pn * 256 * ldb; }
};
struct MoeUpOrder {
    const LAS int* tileE; int G, c; unsigned* ready; int wave;
    __device__ bool next(int i, pg8::Unit& u) const {
        const int L = i * G + c, tt = L >> 1; if (tt >= tileE[255]) return false;
        u.pm = tt; u.pn = L & 1; u.g = tileE[tt]; return true;
    }
    __device__ __forceinline__ void a_ready(const pg8::Unit&) const {}
    __device__ __forceinline__ void done(const pg8::Unit& u) const {
        asm volatile("s_waitcnt vmcnt(0)" ::: "memory"); __builtin_amdgcn_s_barrier(); asm volatile("" ::: "memory");
        if (wave == 0 && lane_id() == 0) __hip_atomic_fetch_add(ready + 16 * u.pm, 1u, __ATOMIC_RELAXED, __HIP_MEMORY_SCOPE_AGENT);
    }
};
#ifndef MOE_SLOTS
#define MOE_SLOTS 2
#endif
struct MoeDownOrder {
    const LAS int* tileE; int G, c; const unsigned* ready; int wave;
    __device__ __forceinline__ int cmin(int s, int U1) const { int v = U1 - G * (s / MOE_SLOTS); v = v < 0 ? 0 : v; return v > G ? G : v; }
    __device__ bool next(int i, pg8::Unit& u) const {
        const int T = tileE[255], U1 = 2 * T; const int n1 = c < U1 ? (U1 - c + G - 1) / G : 0; const int s = MOE_SLOTS * n1 + i;
        int k = c - cmin(s, U1);
#pragma unroll 1
        for (int q = 0; q < s; ++q) k += G - cmin(q, U1);
        if (k >= 4 * T) return false;
        u.pm = k >> 2; u.pn = k & 3; u.g = tileE[u.pm]; return true;
    }
    __device__ __forceinline__ void a_ready(const pg8::Unit& u) const {
        if (wave == 0) {
            unsigned sp = 0;
            while ((unsigned)__builtin_amdgcn_readfirstlane(__hip_atomic_load(ready + 16 * u.pm, __ATOMIC_RELAXED, __HIP_MEMORY_SCOPE_AGENT)) < 2u) { __builtin_amdgcn_s_sleep(2); if (++sp > (1u << 22)) break; }
            __builtin_amdgcn_fence(__ATOMIC_ACQUIRE, "agent");
            asm volatile("s_waitcnt vmcnt(0)" ::: "memory");
        }
        asm volatile("" ::: "memory"); __builtin_amdgcn_s_barrier(); asm volatile("" ::: "memory");
    }
    __device__ __forceinline__ void done(const pg8::Unit&) const {}
};

__device__ __forceinline__ void panel_wait(const unsigned* w, int wave) {
    if (wave == 0) { unsigned sp = 0;
        while ((unsigned)__builtin_amdgcn_readfirstlane(__hip_atomic_load(w, __ATOMIC_RELAXED, __HIP_MEMORY_SCOPE_AGENT)) < 4u) { __builtin_amdgcn_s_sleep(2); if (++sp > (1u << 22)) break; }
        __builtin_amdgcn_fence(__ATOMIC_ACQUIRE, "agent");
        asm volatile("s_waitcnt vmcnt(0)" ::: "memory"); }
    asm volatile("" ::: "memory"); __builtin_amdgcn_s_barrier(); asm volatile("" ::: "memory");
}
__device__ __forceinline__ void panel_count(unsigned* p, int wave) {
    asm volatile("s_waitcnt vmcnt(0)" ::: "memory"); __builtin_amdgcn_s_barrier(); asm volatile("" ::: "memory");
    if (wave == 0 && lane_id() == 0) __hip_atomic_fetch_add(p, 1u, __ATOMIC_RELAXED, __HIP_MEMORY_SCOPE_AGENT);
}
struct PanelStatic : pg8::StaticOrder { const unsigned* wait; unsigned* pub; int wave;
    __device__ __forceinline__ void a_ready(const pg8::Unit& u) const { if (wait) panel_wait(wait + 16 * u.pm, wave); }
    __device__ __forceinline__ void done(const pg8::Unit& u) const { if (pub) panel_count(pub + 16 * u.pm, wave); }
};
struct PanelScore { int c; const unsigned* wait; unsigned* pub; int wave;
    __device__ bool next(int i, pg8::Unit& u) const { if (i > 0 || c < 0 || c >= 256) return false; u.g = (c & 7) * 4 + (c >> 6); u.pm = (c >> 3) & 7; u.pn = 0; return true; }
    __device__ __forceinline__ void a_ready(const pg8::Unit& u) const { panel_wait(wait + 16 * ((u.g >> 2) * 8 + u.pm), wave); }
    __device__ __forceinline__ void done(const pg8::Unit& u) const { panel_count(pub + 16 * ((u.g >> 2) * 8 + u.pm), wave); }
};
struct PanelGroup : pg8::GroupOrder { const unsigned* wait; unsigned* pub; int wave;
    __device__ __forceinline__ void a_ready(const pg8::Unit& u) const { if (wait) panel_wait(wait + 16 * ((u.g >> 2) * 8 + u.pm), wave); }
    __device__ __forceinline__ void done(const pg8::Unit& u) const { if (pub) panel_count(pub + 16 * ((u.g >> 2) * 8 + u.pm), wave); }
};

#define EPI_ARGS f32x4 (&acc)[2][2][4][2], const pg8::Unit& u, int wr, int wc, int fr, int fq, LAS unsigned char* scr, int wid, int lane
struct EpiSmall { static constexpr bool PERM = true; float* lg;
    __device__ __forceinline__ void operator()(EPI_ARGS) const {
        if (wc == 0 || (wc == 1 && fq == 0)) {
#pragma unroll
            for (int ai = 0; ai < 2; ++ai)
#pragma unroll
                for (int m = 0; m < 4; ++m) { float* rowp = lg + ((size_t)u.pm * 256 + ai * 128 + wr * 64 + m * 16 + fr) * 40 + wc * 32 + 8 * fq;
                    *(f32x4*)rowp = acc[ai][0][m][0]; *(f32x4*)(rowp + 4) = acc[ai][0][m][1]; } }
    } };
struct EpiProj1 { static constexpr bool PERM = true; unsigned char* ws; unsigned char* dout; const int* pos;
    __device__ __forceinline__ void operator()(EPI_ARGS) const {
        bf16_t* base; size_t ld; int col0;
        if (u.pn < 16) { base = (bf16_t*)(ws + WS_GQ + (size_t)(u.pn >> 2) * 32 * MiB); ld = 1024; col0 = (u.pn & 3) * 256; }
        else if (u.pn < 20) { base = (bf16_t*)(dout + DO_NQ); ld = 1024; col0 = (u.pn - 16) * 256; }
        else { base = (bf16_t*)(ws + WS_KV + (size_t)(u.pn - 20) * 8 * MiB); ld = 256; col0 = 0; }
        const bool roped = (u.pn >= 16 && u.pn < 20) || u.pn == 20 || u.pn == 22 || u.pn == 24;
        if (!roped) { pg8::store_tile_bf16(acc, base + (size_t)u.pm * 256 * ld + col0, ld, wr, wc, fr, fq, 1.f);
            if (u.pn < 12 && fr >= 13) {
                bf16_t* hb = (bf16_t*)(ws + WS_HALO) + (size_t)(fr - 13) * 3072 + u.pn * 256 + wc * 32 + 8 * fq;
#pragma unroll
                for (int ai = 0; ai < 2; ++ai) { bf16_t* rowp = hb + (size_t)(u.pm * 4 + 2 * ai + wr) * 3 * 3072;
#pragma unroll
                    for (int bj = 0; bj < 2; ++bj) { const f32x4 v0 = acc[ai][bj][3][0], v1 = acc[ai][bj][3][1]; u32x4 w; w.x = cvtpk(v0[0], v0[1]); w.y = cvtpk(v0[2], v0[3]); w.z = cvtpk(v1[0], v1[1]); w.w = cvtpk(v1[2], v1[3]);
                        *(u32x4*)(rowp + bj * 128) = w; } } }
            return; }
        const int i0 = 16 * wc + 4 * fq;
#pragma unroll
        for (int ai = 0; ai < 2; ++ai)
#pragma unroll
            for (int m = 0; m < 4; ++m) { const int row = u.pm * 256 + ai * 128 + wr * 64 + m * 16 + fr; const float pf = (float)pos[row];
                float cs[4], sn[4];
#pragma unroll
                for (int q = 0; q < 4; ++q) { const float rv = (pf * INV_FREQ[i0 + q]) * 0.15915494309189535f; const float fr_ = rv - floorf(rv); cs[q] = __builtin_amdgcn_cosf(fr_); sn[q] = __builtin_amdgcn_sinf(fr_); }
                bf16_t* rowp = base + (size_t)row * ld + col0 + i0;
#pragma unroll
                for (int bj = 0; bj < 2; ++bj) { float y1[4], y2[4];
#pragma unroll
                    for (int q = 0; q < 4; ++q) { const float x1 = acc[ai][bj][m][q >> 1][(q & 1) * 2], x2 = acc[ai][bj][m][q >> 1][(q & 1) * 2 + 1]; y1[q] = x1 * cs[q] - x2 * sn[q]; y2[q] = x2 * cs[q] + x1 * sn[q]; }
                    u32x2 w1; w1.x = cvtpk(y1[0], y1[1]); w1.y = cvtpk(y1[2], y1[3]); u32x2 w2; w2.x = cvtpk(y2[0], y2[1]); w2.y = cvtpk(y2[2], y2[3]);
                    *(u32x2*)(rowp + bj * 128) = w1; *(u32x2*)(rowp + bj * 128 + 64) = w2; } }
    } };
struct EpiStoreBf16 { static constexpr bool PERM = true; bf16_t* O; size_t ld; int gsh; size_t s1, s2; float sc;
    __device__ __forceinline__ void operator()(EPI_ARGS) const {
        pg8::store_tile_bf16(acc, O + (size_t)(u.g >> gsh) * s1 + (size_t)(u.g & ((1 << gsh) - 1)) * s2 + (size_t)u.pm * 256 * ld + (size_t)u.pn * 256, ld, wr, wc, fr, fq, sc);
    } };
struct EpiKvx { static constexpr bool PERM = true; bf16_t* Kx; bf16_t* Vx;
    __device__ __forceinline__ void operator()(EPI_ARGS) const {
        pg8::store_tile_bf16(acc, (u.pn < 4 ? Kx : Vx) + (size_t)u.pm * 256 * 1024 + (u.pn & 3) * 256, 1024, wr, wc, fr, fq, 1.f);
    } };
struct EpiPart { static constexpr bool PERM = true; bf16_t* part;
    __device__ __forceinline__ void operator()(EPI_ARGS) const {
        const __amdgpu_buffer_rsrc_t rs = __builtin_amdgcn_make_buffer_rsrc(part, 0, 16 * 2048 * 256 * 2, 0x00020000);
        const unsigned base = (unsigned)((((u.g & 7) * 2 + (u.g >> 3)) * 2048 + u.pm * 256) * 256 * 2);
#pragma unroll
        for (int ai = 0; ai < 2; ++ai)
#pragma unroll
            for (int m = 0; m < 4; ++m) { const unsigned ro = base + (unsigned)(((ai * 128 + wr * 64 + m * 16 + fr) * 256 + wc * 32 + 8 * fq) * 2);
#pragma unroll
                for (int bj = 0; bj < 2; ++bj) { const f32x4 v0 = acc[ai][bj][m][0], v1 = acc[ai][bj][m][1]; u32x4 w; w.x = cvtpk(v0[0], v0[1]); w.y = cvtpk(v0[2], v0[3]); w.z = cvtpk(v1[0], v1[1]); w.w = cvtpk(v1[2], v1[3]);
                    __builtin_amdgcn_raw_buffer_store_b128(w, rs, ro + bj * 256, 0, 16); } }
    } };
struct CmpOrder : pg8::GroupOrder { unsigned* ready; int wave;
    __device__ __forceinline__ void done(const pg8::Unit& u) const { panel_count(ready + 16 * ((u.g >> 3) * 8 + u.pm), wave); }
};
struct EpiCmp2 { static constexpr bool PERM = true; bf16_t* out;
    __device__ __forceinline__ void operator()(EPI_ARGS) const {
        const __amdgpu_buffer_rsrc_t rs = __builtin_amdgcn_make_buffer_rsrc(out, 0, 2 * 2048 * 128 * 2, 0x00020000);
        const unsigned base = (unsigned)((u.g * (2048 * 128) + u.pm * 256 * 128) * 2);
#pragma unroll
        for (int ai = 0; ai < 2; ++ai)
#pragma unroll
            for (int m = 0; m < 4; ++m) { const unsigned ro = base + (unsigned)(((ai * 128 + wr * 64 + m * 16 + fr) * 128 + wc * 32 + 8 * fq) * 2);
                const f32x4 v0 = acc[ai][0][m][0], v1 = acc[ai][0][m][1]; u32x4 w; w.x = cvtpk(v0[0], v0[1]); w.y = cvtpk(v0[2], v0[3]); w.z = cvtpk(v1[0], v1[1]); w.w = cvtpk(v1[2], v1[3]);
                __builtin_amdgcn_raw_buffer_store_b128(w, rs, ro, 0, 16); }
    } };
struct Cmp2Order : pg8::GroupOrder { unsigned* ready; int wave;
    __device__ __forceinline__ void done(const pg8::Unit& u) const { panel_count(ready + 16 * u.pm, wave); }
};
struct EpiMerge { static constexpr bool PERM = true; const bf16_t* ya; const bf16_t* yb; bf16_t* merged; const float* ss;
    __device__ __forceinline__ void operator()(EPI_ARGS) const {
#pragma unroll
        for (int ai = 0; ai < 2; ++ai)
#pragma unroll
            for (int m = 0; m < 4; ++m) { const size_t off = (size_t)(u.pm * 256 + ai * 128 + wr * 64 + m * 16 + fr) * 1024 + u.pn * 128 + wc * 32 + 8 * fq;
                const u32x4 a = *(const u32x4*)(ya + off), b = *(const u32x4*)(yb + off); u32x4 w;
                const float rstd = 1.f;
#pragma unroll
                for (int q = 0; q < 4; ++q) { const int n = q >> 1, j = (q & 1) * 2;
                    const float lo = sigmoidf_(acc[ai][0][m][n][j]) * (bflo(a[q]) * rstd) + sigmoidf_(acc[ai][1][m][n][j]) * bflo(b[q]);
                    const float hi = sigmoidf_(acc[ai][0][m][n][j + 1]) * (bfhi(a[q]) * rstd) + sigmoidf_(acc[ai][1][m][n][j + 1]) * bfhi(b[q]);
                    w[q] = cvtpk(lo, hi); }
                *(u32x4*)(merged + off) = w; }
    } };
struct EpiResF32 { static constexpr bool PERM = false; const float* res; float* out; float alpha;
    __device__ __forceinline__ void operator()(EPI_ARGS) const {
#pragma unroll
        for (int ai = 0; ai < 2; ++ai)
#pragma unroll
            for (int m = 0; m < 4; ++m) { const size_t off = (size_t)(u.pm * 256 + ai * 128 + wr * 64 + m * 16 + fr) * 1024 + u.pn * 256 + wc * 32 + 4 * fq;
#pragma unroll
                for (int bj = 0; bj < 2; ++bj)
#pragma unroll
                    for (int n = 0; n < 2; ++n) { const f32x4 r = *(const f32x4*)(res + off + bj * 128 + n * 16); *(f32x4*)(out + off + bj * 128 + n * 16) = r * alpha + acc[ai][bj][m][n]; } }
    } };

struct EpiLnFused { static constexpr bool PERM = false;
    const float* res; const bf16_t* resb; float alpha; const float* g; const float* b; bf16_t* outb; unsigned long long* xbuf; unsigned* cnt;
    __device__ __forceinline__ void operator()(EPI_ARGS) const {
        LAS f32x2* P = (LAS f32x2*)scr;
        LAS f32x2* S = (LAS f32x2*)(scr + 8192);
#pragma unroll
        for (int ai = 0; ai < 2; ++ai)
#pragma unroll
            for (int m = 0; m < 4; ++m) { const size_t off = (size_t)(u.pm * 256 + ai * 128 + wr * 64 + m * 16 + fr) * 1024 + u.pn * 256 + wc * 32 + 4 * fq; float s = 0.f;
#pragma unroll
                for (int bj = 0; bj < 2; ++bj)
#pragma unroll
                    for (int n = 0; n < 2; ++n) { f32x4 r; if (res) r = *(const f32x4*)(res + off + bj * 128 + n * 16); else { const u32x2 rb = *(const u32x2*)(resb + off + bj * 128 + n * 16); r = (f32x4){bflo(rb.x), bfhi(rb.x), bflo(rb.y), bfhi(rb.y)}; }
                        const f32x4 x = r * alpha + acc[ai][bj][m][n]; acc[ai][bj][m][n] = x; s += (x[0] + x[1]) + (x[2] + x[3]); }
                s += __shfl_xor(s, 16); s += __shfl_xor(s, 32);
                const float mw = s * (1.0f / 64.0f); float q = 0.f;
#pragma unroll
                for (int bj = 0; bj < 2; ++bj)
#pragma unroll
                    for (int n = 0; n < 2; ++n) { const f32x4 d = acc[ai][bj][m][n] - mw; q += (d[0] * d[0] + d[1] * d[1]) + (d[2] * d[2] + d[3] * d[3]); }
                q += __shfl_xor(q, 16); q += __shfl_xor(q, 32);
                if (fq == 0) P[(ai * 128 + wr * 64 + m * 16 + fr) * 4 + wc] = (f32x2){mw, q}; }
        RAW_BAR();
        const int row = wid * 32 + (lane & 31);
        if (lane < 32) {
            const f32x2 a = P[row * 4 + 0], b2 = P[row * 4 + 1], c2 = P[row * 4 + 2], d = P[row * 4 + 3];
            const float mt = (a[0] + b2[0] + c2[0] + d[0]) * 0.25f;
            const float da = a[0] - mt, db = b2[0] - mt, dc = c2[0] - mt, dd = d[0] - mt;
            const float m2 = (a[1] + b2[1]) + (c2[1] + d[1]) + 64.0f * ((da * da + db * db) + (dc * dc + dd * dd));
            unsigned long long* slot = xbuf + ((size_t)(u.pm * 256 + row) * 4 + u.pn);
            __hip_atomic_store(slot, ((unsigned long long)__float_as_uint(m2) << 32) | __float_as_uint(mt), __ATOMIC_RELAXED, __HIP_MEMORY_SCOPE_AGENT);
        }
        asm volatile("s_waitcnt vmcnt(0)" ::: "memory"); __builtin_amdgcn_s_barrier(); asm volatile("" ::: "memory");
        if (wid == 0) {
            if (lane == 0) __hip_atomic_fetch_add(cnt + 64 * u.pm, 1u, __ATOMIC_RELAXED, __HIP_MEMORY_SCOPE_AGENT);
            unsigned sp = 0;
            while ((unsigned)__builtin_amdgcn_readfirstlane(__hip_atomic_load(cnt + 64 * u.pm, __ATOMIC_RELAXED, __HIP_MEMORY_SCOPE_AGENT)) < 4u) { __builtin_amdgcn_s_sleep(2); if (++sp > (1u << 22)) break; }
            __builtin_amdgcn_fence(__ATOMIC_ACQUIRE, "agent");
        }
        asm volatile("s_waitcnt vmcnt(0) lgkmcnt(0)" ::: "memory"); __builtin_amdgcn_s_barrier(); asm volatile("" ::: "memory");
        if (lane < 32) {
            const unsigned long long* slot = xbuf + (size_t)(u.pm * 256 + row) * 4; float mt[4], m2[4]; float ms = 0.f;
#pragma unroll
            for (int t = 0; t < 4; ++t) { const unsigned long long w = __hip_atomic_load(slot + t, __ATOMIC_RELAXED, __HIP_MEMORY_SCOPE_AGENT); mt[t] = __uint_as_float((unsigned)w); m2[t] = __uint_as_float((unsigned)(w >> 32)); ms += mt[t]; }
            const float mean = ms * 0.25f; float q = 0.f;
#pragma unroll
            for (int t = 0; t < 4; ++t) { const float dm = mt[t] - mean; q += m2[t] + 256.0f * dm * dm; }
            S[row] = (f32x2){mean, 1.0f / sqrtf(q * (1.0f / 1024.0f) + LN_EPS)};
        }
        RAW_BAR();
        const __amdgpu_buffer_rsrc_t ors = __builtin_amdgcn_make_buffer_rsrc(outb, 0, NTOK * 1024 * 2, 0x00020000);
#pragma unroll
        for (int ai = 0; ai < 2; ++ai)
#pragma unroll
            for (int m = 0; m < 4; ++m) { const int r = ai * 128 + wr * 64 + m * 16 + fr; const f32x2 sr = S[r]; const size_t off = (size_t)(u.pm * 256 + r) * 1024 + u.pn * 256 + wc * 32 + 4 * fq;
#pragma unroll
                for (int bj = 0; bj < 2; ++bj)
#pragma unroll
                    for (int n = 0; n < 2; ++n) { const int cc = u.pn * 256 + wc * 32 + 4 * fq + bj * 128 + n * 16; const f32x4 gg = *(const f32x4*)(g + cc), bb = *(const f32x4*)(b + cc);
                        const f32x4 y = (acc[ai][bj][m][n] - sr[0]) * sr[1] * gg + bb;
                        u32x2 w; w.x = cvtpk(y[0], y[1]); w.y = cvtpk(y[2], y[3]); __builtin_amdgcn_raw_buffer_store_b64(w, ors, (unsigned)((off + bj * 128 + n * 16) * 2), 0, 16); } }
    } };
struct EpiSoftmax { static constexpr bool PERM = true; bf16_t* Pm;
    __device__ __forceinline__ void operator()(EPI_ARGS) const {
        LAS float* X = (LAS float*)scr;
        LAS float* Y = X + 1024;
#pragma unroll
        for (int ai = 0; ai < 2; ++ai)
#pragma unroll
            for (int m = 0; m < 4; ++m) { float v = -3.0e38f;
#pragma unroll
                for (int bj = 0; bj < 2; ++bj)
#pragma unroll
                    for (int n = 0; n < 2; ++n)
#pragma unroll
                        for (int j = 0; j < 4; ++j) v = fmaxf(v, acc[ai][bj][m][n][j]);
                v = fmaxf(v, __shfl_xor(v, 16)); v = fmaxf(v, __shfl_xor(v, 32));
                if (fq == 0) X[(ai * 128 + wr * 64 + m * 16 + fr) * 4 + wc] = v; }
        RAW_BAR();
#pragma unroll
        for (int ai = 0; ai < 2; ++ai)
#pragma unroll
            for (int m = 0; m < 4; ++m) { const int row = ai * 128 + wr * 64 + m * 16 + fr; const f32x4 t = *(const LAS f32x4*)(X + row * 4);
                const float mm = fmaxf(fmaxf(t[0], t[1]), fmaxf(t[2], t[3])); float s = 0.f;
#pragma unroll
                for (int bj = 0; bj < 2; ++bj)
#pragma unroll
                    for (int n = 0; n < 2; ++n) { f32x4 x = acc[ai][bj][m][n];
#pragma unroll
                        for (int j = 0; j < 4; ++j) { x[j] = __expf(x[j] - mm); s += x[j]; }
                        acc[ai][bj][m][n] = x; }
                s += __shfl_xor(s, 16); s += __shfl_xor(s, 32);
                if (fq == 0) Y[row * 4 + wc] = s; }
        RAW_BAR();
        const __amdgpu_buffer_rsrc_t prs = __builtin_amdgcn_make_buffer_rsrc(Pm, 0, NTOK * 1024 * 2, 0x00020000);
        const unsigned bo = (unsigned)((((u.g >> 2) * 2048 + u.pm * 256) * 1024 + (u.g & 3) * 256) * 2);
#pragma unroll
        for (int ai = 0; ai < 2; ++ai)
#pragma unroll
            for (int m = 0; m < 4; ++m) { const int row = ai * 128 + wr * 64 + m * 16 + fr; const f32x4 t = *(const LAS f32x4*)(Y + row * 4);
                const float inv = 1.f / ((t[0] + t[1]) + (t[2] + t[3])); const unsigned ro = bo + (unsigned)((row * 1024 + wc * 32 + 8 * fq) * 2);
#pragma unroll
                for (int bj = 0; bj < 2; ++bj) { const f32x4 v0 = acc[ai][bj][m][0] * inv, v1 = acc[ai][bj][m][1] * inv; u32x4 w; w.x = cvtpk(v0[0], v0[1]); w.y = cvtpk(v0[2], v0[3]); w.z = cvtpk(v1[0], v1[1]); w.w = cvtpk(v1[2], v1[3]);
                    __builtin_amdgcn_raw_buffer_store_b128(w, prs, ro + bj * 256, 0, 16); } }
    } };
struct EpiGateUp { static constexpr bool PERM = true; bf16_t* hg;
    __device__ __forceinline__ void operator()(EPI_ARGS) const {
        const __amdgpu_buffer_rsrc_t rs = __builtin_amdgcn_make_buffer_rsrc(hg, 0, MAXPOS * 256 * 2, 0x00020000);
#pragma unroll
        for (int ai = 0; ai < 2; ++ai)
#pragma unroll
            for (int m = 0; m < 4; ++m) { const unsigned off = (unsigned)(((u.pm * 256 + ai * 128 + wr * 64 + m * 16 + fr) * 256 + u.pn * 128 + wc * 32 + 8 * fq) * 2); u32x4 w;
#pragma unroll
                for (int q = 0; q < 4; ++q) { const int n = q >> 1, j = (q & 1) * 2;
                    w[q] = cvtpk(siluf_(acc[ai][0][m][n][j]) * acc[ai][1][m][n][j], siluf_(acc[ai][0][m][n][j + 1]) * acc[ai][1][m][n][j + 1]); }
                __builtin_amdgcn_raw_buffer_store_b128(w, rs, off, 0, 16); }
    } };
struct EpiDown { static constexpr bool PERM = true; const int* list; const float* listw; const LAS int* tinfo; bf16_t* Y0; bf16_t* Y1;
    __device__ __forceinline__ void operator()(EPI_ARGS) const {
        int tk[2][4]; float w[2][4];
        const int sl0 = (u.pm - tinfo[u.g]) * 256, nv = tinfo[33 + u.g] - sl0; const int* lp = list + u.g * MOE_CAP + sl0; const float* lw = listw + u.g * MOE_CAP + sl0;
#pragma unroll
        for (int ai = 0; ai < 2; ++ai)
#pragma unroll
            for (int m = 0; m < 4; ++m) { const int r = ai * 128 + wr * 64 + m * 16 + fr; const int t_ = lp[r]; const float w_ = lw[r]; tk[ai][m] = r < nv ? t_ : -1; w[ai][m] = w_; }
#pragma unroll
        for (int ai = 0; ai < 2; ++ai)
#pragma unroll
            for (int m = 0; m < 4; ++m) {
                if (tk[ai][m] >= 0) { bf16_t* rowp = ((tk[ai][m] & 1) ? Y1 : Y0) + (size_t)(tk[ai][m] >> 1) * 1024 + u.pn * 256 + wc * 32 + 8 * fq; const float ww = w[ai][m];
#pragma unroll
                    for (int bj = 0; bj < 2; ++bj) { const f32x4 v0 = acc[ai][bj][m][0] * ww, v1 = acc[ai][bj][m][1] * ww; u32x4 o; o.x = cvtpk(v0[0], v0[1]); o.y = cvtpk(v0[2], v0[3]); o.z = cvtpk(v1[0], v1[1]); o.w = cvtpk(v1[2], v1[3]);
                        *(u32x4*)(rowp + bj * 128) = o; } } }
    } };

template <bool ROPEPERM = false> __device__ __forceinline__ void seg_rot(const Ctx& C, int& rot, const float* W, int K, int Nsrc, int col0, int cnt, bf16_t* WT, int drow0, int ldd) {
    Ctx D = C; D.gw = (C.gw + C.ngw - (rot % C.ngw)) % C.ngw;
    transpose_seg<ROPEPERM>(D, W, K, Nsrc, col0, cnt, WT, drow0, ldd);
    rot += (K / 64) * (cnt / 32);
}

__device__ __forceinline__ void phase0(const Params& p, const Ctx& C) {
    unsigned char* ws = p.ws; int rot = 0;
    const float* w_in = p.in[3];
    bf16_t* W1T = (bf16_t*)(ws + WS_W1T); bf16_t* W2T = (bf16_t*)(ws + WS_W2T);
    seg_rot(C, rot, w_in, 1024, INW, 0, 4096, W1T, 0, 1024);
    seg_rot<true>(C, rot, w_in, 1024, INW, 4112, 1024, W1T, 4096, 1024);
    for (int sgi = 0; sgi < 6; ++sgi) { if (sgi & 1) seg_rot<false>(C, rot, w_in, 1024, INW, 5136 + 256 * sgi, 256, W1T, 5120 + 256 * sgi, 1024); else seg_rot<true>(C, rot, w_in, 1024, INW, 5136 + 256 * sgi, 256, W1T, 5120 + 256 * sgi, 1024); }
    for (int pn = 0; pn < 8; ++pn) { seg_rot(C, rot, w_in, 1024, INW, 6696 + 128 * pn, 128, W2T, 256 * pn, 1024); seg_rot(C, rot, w_in, 1024, INW, 7720 + 128 * pn, 128, W2T, 256 * pn + 128, 1024); }
    for (int j = 0; j < 2; ++j) seg_rot(C, rot, p.in[9] + (size_t)j * 4096 * 256, 4096, 256, 0, 256, (bf16_t*)(ws + WS_WC1T) + (size_t)j * 256 * 4096, 0, 4096);
    for (int j = 0; j < 2; ++j) seg_rot(C, rot, p.in[11] + (size_t)j * 256 * 128, 256, 128, 0, 128, (bf16_t*)(ws + WS_WC2T) + (size_t)j * 65536, 0, 256);
    seg_rot(C, rot, p.in[12], 1024, 1024, 0, 1024, (bf16_t*)(ws + WS_WOT), 0, 1024);
    cvt_rows(C, p.in[15], (bf16_t*)(ws + WS_WQT), (size_t)1024 * 1024);
    seg_rot(C, rot, p.in[16], 1024, 2048, 0, 2048, (bf16_t*)(ws + WS_WKVT), 0, 1024);
    seg_rot(C, rot, p.in[17], 1024, 1024, 0, 1024, (bf16_t*)(ws + WS_WXOT), 0, 1024);
    { const int gt = C.gw * 64 + C.lane(), ngt = C.ngw * 64;
      for (int i = gt; i < 2 * 128 * 256 / 8; i += ngt) { const int j = i / (128 * 32), r = i % (128 * 32); *(u32x4*)((bf16_t*)(ws + WS_WC2T) + (size_t)j * 65536 + 128 * 256 + r * 8) = (u32x4){0u, 0u, 0u, 0u}; } }
    cvt_rows(C, p.in[0], (bf16_t*)((unsigned char*)p.out + DO_XB), (size_t)NTOK * DM);
    cvt_rows(C, p.in[1], (bf16_t*)(ws + WS_FREE), (size_t)2048 * DM);
    { const int gt = C.gw * 64 + C.lane(), ngt = C.ngw * 64;
      for (int i = gt; i < 256 * 1024 / 8; i += ngt) { const int j = i >> 7, k0 = (i & 127) * 8; u32x4 o = (u32x4){0u, 0u, 0u, 0u};
          if (j < 40) { const float* srcp = w_in + (size_t)k0 * INW + (j < 16 ? 4096 + j : 6672 + (j - 16));
#pragma unroll
              for (int q = 0; q < 4; ++q) o[q] = cvtpk(srcp[(size_t)(2 * q) * INW], srcp[(size_t)(2 * q + 1) * INW]); }
          *(u32x4*)(W1T + (size_t)(6656 + j) * 1024 + k0) = o; } }
    extract_cols_f32(C, p.in[20], 1024, 4, 0, 4, (float*)(ws + WS_WR), 0);
    extract_cols_f32(C, p.in[22], 1024, 32, 0, 32, (float*)(ws + WS_WR), 4);
    if (blockIdx.x < 32) { const int j = blockIdx.x >> 4, kc = blockIdx.x & 15, lane = C.lane(), w = C.wave;
        const float* pe = p.in[8] + (size_t)j * 4096 + kc * 256 + w * 32; const float* w1 = p.in[9] + ((size_t)j * 4096 + kc * 256 + w * 32) * 256 + 4 * lane;
        f32x4 s = (f32x4){0.f, 0.f, 0.f, 0.f};
#pragma unroll 8
        for (int k = 0; k < 32; ++k) s += *(const f32x4*)(w1 + (size_t)k * 256) * pe[k];
        __syncthreads();
        LAS f32x4* red = (LAS f32x4*)C.lds; red[w * 64 + lane] = s;
        __syncthreads();
        if (w == 0) { f32x4 t = red[lane];
#pragma unroll
            for (int q = 1; q < 8; ++q) t += red[q * 64 + lane];
            *(f32x4*)((float*)(ws + WS_BIASP) + (j * 16 + kc) * 256 + 4 * lane) = t; }
        __syncthreads(); }
}

__device__ __forceinline__ void phase_moe_weights(const Params& p, const Ctx& C) {
    int rot = 0;
    for (int e = 0; e < 32; ++e) {
        bf16_t* gu = (bf16_t*)(p.ws + WS_WGUT) + (size_t)e * 512 * 1024;
        const float* wg = p.in[24] + (size_t)e * 1024 * 256; const float* wu = p.in[25] + (size_t)e * 1024 * 256;
        for (int pn = 0; pn < 2; ++pn) { seg_rot(C, rot, wg, 1024, 256, 128 * pn, 128, gu, 256 * pn, 1024); seg_rot(C, rot, wu, 1024, 256, 128 * pn, 128, gu, 256 * pn + 128, 1024); }
        seg_rot(C, rot, p.in[26] + (size_t)e * 256 * 1024, 256, 1024, 0, 1024, (bf16_t*)(p.ws + WS_WDT) + (size_t)e * 1024 * 256, 0, 256);
    }
}

__device__ __forceinline__ void rope_pair(bf16_t* ptr, int lane, float c, float s) {
    const float x1 = bf2f(ptr[lane]), x2 = bf2f(ptr[64 + lane]);
    ptr[lane] = f2bf(x1 * c - x2 * s); ptr[64 + lane] = f2bf(x2 * c + x1 * s);
}
__device__ __forceinline__ void conv_pass(const Params& p, const Ctx& C, int cw, int ncw, int nitems, bool do_store = true) {
    const int lane = C.lane(), hf = lane >> 5, l32 = lane & 31;
    const int nsteps = 4 * nitems;
    u32x4 rows[11], nxt[8], hn[3]; f32x4 wa[4], wb[4], wn[8];
    auto request = [&](int s) {
        const int item = cw + ncw * (s >> 2), grp = s & 3, j = item % 12, g = item / 12, ch = 256 * j + 8 * l32;
        const bf16_t* base = (const bf16_t*)(p.ws + WS_GQ + (size_t)(j >> 2) * 32 * MiB) + (ch & 1023) + ((size_t)g * 64 + 32 * hf) * 1024;
#pragma unroll
        for (int t = 0; t < 8; ++t) nxt[t] = *(const u32x4*)(base + (size_t)(grp * 8 + t) * 1024);
        if (grp == 0) {
            const bf16_t* hp = hf ? base - 3 * 1024 : (const bf16_t*)(p.ws + WS_HALO) + (size_t)(g > 0 ? g - 1 : 0) * 3 * 3072 + ch; const size_t hs = hf ? 1024 : 3072;
#pragma unroll
            for (int i = 0; i < 3; ++i) hn[i] = *(const u32x4*)(hp + i * hs);
            const float* wp = p.in[4] + ch;
#pragma unroll
            for (int k = 0; k < 4; ++k) { wn[2 * k] = *(const f32x4*)(wp + (size_t)k * 3072); wn[2 * k + 1] = *(const f32x4*)(wp + (size_t)k * 3072 + 4); }
        }
    };
    if (nsteps > 0) request(0);
#pragma unroll 1
    for (int s = 0; s < nsteps; ++s) {
        const int item = cw + ncw * (s >> 2), grp = s & 3, j = item % 12, g = item / 12, ch = 256 * j + 8 * l32;
        bf16_t* gb = (bf16_t*)(p.ws + WS_GQ + (size_t)(j >> 2) * 32 * MiB) + (ch & 1023) + ((size_t)g * 64 + 32 * hf + 8 * grp) * 1024;
        if (grp == 0) { const bool zero = hf == 0 && (g & 31) == 0;
#pragma unroll
            for (int i = 0; i < 3; ++i) rows[i] = zero ? (u32x4){0u, 0u, 0u, 0u} : hn[i];
#pragma unroll
            for (int k = 0; k < 4; ++k) { wa[k] = wn[2 * k]; wb[k] = wn[2 * k + 1]; } }
#pragma unroll
        for (int t = 0; t < 8; ++t) rows[3 + t] = nxt[t];
        if (s + 1 < nsteps) request(s + 1);
#pragma unroll
        for (int t = 0; t < 8; ++t) { f32x2 o[4];
#pragma unroll
            for (int k = 0; k < 4; ++k) { const u32x4 rw = rows[t + k];
#pragma unroll
                for (int q = 0; q < 4; ++q) { const f32x2 x = {bflo(rw[q]), bfhi(rw[q])}; const f32x2 w = q < 2 ? (f32x2){wa[k][2 * q], wa[k][2 * q + 1]} : (f32x2){wb[k][2 * q - 4], wb[k][2 * q - 3]};
                    o[q] = k == 0 ? w * x : __builtin_elementwise_fma(w, x, o[q]); } }
            f32x2 ss2 = {0.f, 0.f};
#pragma unroll
            for (int q = 0; q < 4; ++q) { const f32x2 tt = o[q] * -1.4426950408889634f; f32x2 e; e.x = __builtin_amdgcn_exp2f(tt.x); e.y = __builtin_amdgcn_exp2f(tt.y); e = e + 1.f;
                f32x2 r; r.x = __builtin_amdgcn_rcpf(e.x); r.y = __builtin_amdgcn_rcpf(e.y); o[q] = o[q] * r; ss2 = __builtin_elementwise_fma(o[q], o[q], ss2); }
            if (j < 8) { const float f = rsqrtf(sum16(ss2.x + ss2.y) + RMS_EPS) * (j < 4 ? 0.08838834764831845f : 1.f);
#pragma unroll
                for (int q = 0; q < 4; ++q) o[q] = o[q] * f; }
            u32x4 v; v.x = cvtpk(o[0].x, o[0].y); v.y = cvtpk(o[1].x, o[1].y); v.z = cvtpk(o[2].x, o[2].y); v.w = cvtpk(o[3].x, o[3].y);
            if (do_store) *(u32x4*)(gb + (size_t)t * 1024) = v; else asm volatile("" :: "v"(v)); }
        rows[0] = rows[8]; rows[1] = rows[9]; rows[2] = rows[10];
    }
}

__device__ __forceinline__ void combine_rows(const Params& p, const Ctx& C, int j, int row0, int nrows) {
    const bf16_t* part = (const bf16_t*)(p.ws + WS_PART); const float* bp = (const float*)(p.ws + WS_BIASP); bf16_t* hid = (bf16_t*)(p.ws + WS_HID);
    for (int i = C.tid(); i < nrows * 32; i += NTHREADS) {
        const int c8 = i & 31, r = row0 + (i >> 5);
        u32x4 pr[8];
#pragma unroll
        for (int s = 0; s < 8; ++s) pr[s] = *(const u32x4*)(part + ((size_t)(s * 2 + j) * 2048 + r) * 256 + c8 * 8);
        f32x4 v0 = *(const f32x4*)(p.in[10] + j * 256 + c8 * 8), v1 = *(const f32x4*)(p.in[10] + j * 256 + c8 * 8 + 4);
#pragma unroll
        for (int kc = 0; kc < 16; ++kc) { v0 += *(const f32x4*)(bp + (j * 16 + kc) * 256 + c8 * 8); v1 += *(const f32x4*)(bp + (j * 16 + kc) * 256 + c8 * 8 + 4); }
#pragma unroll
        for (int s = 0; s < 8; ++s) { v0[0] += bflo(pr[s].x); v0[1] += bfhi(pr[s].x); v0[2] += bflo(pr[s].y); v0[3] += bfhi(pr[s].y); v1[0] += bflo(pr[s].z); v1[1] += bfhi(pr[s].z); v1[2] += bflo(pr[s].w); v1[3] += bfhi(pr[s].w); }
        float o[8];
#pragma unroll
        for (int q = 0; q < 8; ++q) { const float x = q < 4 ? v0[q] : v1[q - 4]; const float t = 0.7978845608028654f * (x + 0.044715f * x * x * x); const float e = __expf(2.f * t); const float th = 1.f - 2.f / (e + 1.f); o[q] = 0.5f * x * (1.f + th); }
        u32x4 w; w.x = cvtpk(o[0], o[1]); w.y = cvtpk(o[2], o[3]); w.z = cvtpk(o[4], o[5]); w.w = cvtpk(o[6], o[7]);
        *(u32x4*)(hid + ((size_t)j * 2048 + r) * 256 + c8 * 8) = w;
    }
}
__device__ __forceinline__ void wg_wait_count(const unsigned* cnt, unsigned target, int wave) {
    if (wave == 0) { unsigned sp = 0;
        while ((unsigned)__builtin_amdgcn_readfirstlane(__hip_atomic_load(cnt, __ATOMIC_RELAXED, __HIP_MEMORY_SCOPE_AGENT)) < target) { __builtin_amdgcn_s_sleep(2); if (++sp > (1u << 22)) break; }
        __builtin_amdgcn_fence(__ATOMIC_ACQUIRE, "agent");
        asm volatile("s_waitcnt vmcnt(0)" ::: "memory"); }
    __syncthreads();
}

__device__ __forceinline__ void ln_row(f32x4 (&v)[4], const float* g, const float* b, int lane) {
    float s = 0.f;
#pragma unroll
    for (int j = 0; j < 4; ++j) s += (v[j][0] + v[j][1]) + (v[j][2] + v[j][3]);
    const float mean = wave_sum(s) * (1.f / 1024.f); float s2 = 0.f;
#pragma unroll
    for (int j = 0; j < 4; ++j) { v[j] = v[j] - mean; s2 += (v[j][0] * v[j][0] + v[j][1] * v[j][1]) + (v[j][2] * v[j][2] + v[j][3] * v[j][3]); }
    const float rstd = 1.f / sqrtf(wave_sum(s2) * (1.f / 1024.f) + LN_EPS);
#pragma unroll
    for (int j = 0; j < 4; ++j) { const f32x4 gg = *(const f32x4*)(g + 4 * lane + 256 * j), bb = *(const f32x4*)(b + 4 * lane + 256 * j); v[j] = v[j] * rstd * gg + bb; }
}
__device__ __forceinline__ void phase_ln1(const Params& p, const Ctx& C) {
    float* H = (float*)(p.ws + WS_H); bf16_t* HB = (bf16_t*)(p.ws + WS_HB); const int lane = C.lane();
    for (int m = C.gw; m < NTOK; m += C.ngw) {
        float* row = H + (size_t)m * 1024 + 4 * lane; f32x4 v[4];
#pragma unroll
        for (int j = 0; j < 4; ++j) v[j] = *(const f32x4*)(row + 256 * j);
        ln_row(v, p.in[13], p.in[14], lane);
#pragma unroll
        for (int j = 0; j < 4; ++j) { *(f32x4*)(row + 256 * j) = v[j]; u32x2 w; w.x = cvtpk(v[j][0], v[j][1]); w.y = cvtpk(v[j][2], v[j][3]); *(u32x2*)(HB + (size_t)m * 1024 + 4 * lane + 256 * j) = w; }
    }
}
__device__ __forceinline__ float dot_row(const f32x4 (&v)[4], const float* w, int lane) {
    float d = 0.f;
#pragma unroll
    for (int j = 0; j < 4; ++j) { const f32x4 x = *(const f32x4*)(w + 4 * lane + 256 * j); d += v[j][0] * x[0] + v[j][1] * x[1] + v[j][2] * x[2] + v[j][3] * x[3]; }
    return wave_sum(d);
}
__device__ __forceinline__ void phase_ln2_router(const Params& p, const Ctx& C, bool do_assign = true) {
    const bf16_t* HB = (const bf16_t*)(p.ws + WS_HB); const int lane = C.lane();
    const float* Wr = (const float*)(p.ws + WS_WR); unsigned* cnt = (unsigned*)(p.ws + WS_CTL) + CW_CNT;
    int* list = (int*)(p.ws + WS_LIST); float* listw = (float*)(p.ws + WS_LISTW);
    const float bias = lane < 4 ? p.in[21][lane] : (lane < 36 ? p.in[23][lane - 4] : 0.f);
#ifdef PROBE_T
#define RSTAMP(k) do { if (C.gw == 0 && lane == 0) ((unsigned long long*)(p.ws + WS_CTL + 49152))[40 + (k)] = __builtin_amdgcn_s_memrealtime(); } while (0)
#else
#define RSTAMP(k) do {} while (0)
#endif
    RSTAMP(0);
    for (int m0 = 8 * C.gw; m0 < NTOK; m0 += 8 * C.ngw) {
        const int w = C.wave, mb0 = m0 - 8 * w, l15 = lane & 15, lq = lane >> 4;
        LAS float* PL = (LAS float*)(C.lds + 1024);
        bf16x8 xf[4][4];
#pragma unroll
        for (int nt = 0; nt < 4; ++nt)
#pragma unroll
            for (int ks = 0; ks < 4; ++ks) xf[nt][ks] = *(const bf16x8*)(HB + (size_t)(mb0 + 16 * nt + l15) * 1024 + 128 * w + 32 * ks + 8 * lq);
        f32x4 acc[4][3];
#pragma unroll
        for (int nt = 0; nt < 4; ++nt)
#pragma unroll
            for (int mt = 0; mt < 3; ++mt) acc[nt][mt] = (f32x4){0.f, 0.f, 0.f, 0.f};
#pragma unroll
        for (int mt = 0; mt < 3; ++mt) { const int row = 16 * mt + l15; const bool live = row < 36;
            const float* wp = Wr + (size_t)(live ? row : 0) * 1024 + 128 * w + 8 * lq;
#pragma unroll
            for (int ks = 0; ks < 4; ++ks) { f32x4 fa = *(const f32x4*)(wp + 32 * ks), fb = *(const f32x4*)(wp + 32 * ks + 4);
                if (!live) { fa = (f32x4){0.f, 0.f, 0.f, 0.f}; fb = fa; }
                u32x4 h; h.x = cvtpk(fa[0], fa[1]); h.y = cvtpk(fa[2], fa[3]); h.z = cvtpk(fb[0], fb[1]); h.w = cvtpk(fb[2], fb[3]);
                u32x4 lo; lo.x = cvtpk(fa[0] - bflo(h.x), fa[1] - bfhi(h.x)); lo.y = cvtpk(fa[2] - bflo(h.y), fa[3] - bfhi(h.y)); lo.z = cvtpk(fb[0] - bflo(h.z), fb[1] - bfhi(h.z)); lo.w = cvtpk(fb[2] - bflo(h.w), fb[3] - bfhi(h.w));
                const bf16x8 wh = __builtin_bit_cast(bf16x8, h), wl = __builtin_bit_cast(bf16x8, lo);
#pragma unroll
                for (int nt = 0; nt < 4; ++nt) { acc[nt][mt] = __builtin_amdgcn_mfma_f32_16x16x32_bf16(wh, xf[nt][ks], acc[nt][mt], 0, 0, 0); acc[nt][mt] = __builtin_amdgcn_mfma_f32_16x16x32_bf16(wl, xf[nt][ks], acc[nt][mt], 0, 0, 0); } } }
#pragma unroll
        for (int nt = 0; nt < 4; ++nt)
#pragma unroll
            for (int mt = 0; mt < 3; ++mt) *(LAS f32x4*)(PL + (size_t)(w * 64 + 16 * nt + l15) * 52 + 16 * mt + 4 * lq) = acc[nt][mt];
        __syncthreads();
        RSTAMP(1);
        float lg[8];
#pragma unroll
        for (int i = 0; i < 8; ++i) { float s = bias;
            if (lane < 48) {
#pragma unroll
                for (int ww = 0; ww < 8; ++ww) s += PL[(size_t)(ww * 64 + 8 * w + i) * 52 + lane]; }
            lg[i] = s; }
        __syncthreads();
        RSTAMP(2);
        int myid = 0; float myw = 0.f;
#pragma unroll
        for (int i = 0; i < 8; ++i) {
            float gl[4];
#pragma unroll
            for (int gi = 0; gi < 4; ++gi) gl[gi] = rdlane(lg[i], gi);
            int gs = 0; float gm = gl[0];
#pragma unroll
            for (int gi = 1; gi < 4; ++gi) if (gl[gi] > gm) { gm = gl[gi]; gs = gi; }
            float gsum = 0.f;
#pragma unroll
            for (int gi = 0; gi < 4; ++gi) gsum += __expf(gl[gi] - gm);
            const float p_top = 1.f / gsum;
            float el[8];
#pragma unroll
            for (int e = 0; e < 8; ++e) { const float a0 = rdlane(lg[i], 4 + e), a1 = rdlane(lg[i], 12 + e), a2 = rdlane(lg[i], 20 + e), a3 = rdlane(lg[i], 28 + e); el[e] = gs == 0 ? a0 : (gs == 1 ? a1 : (gs == 2 ? a2 : a3)); }
            int e0 = 0; float m0v = el[0];
#pragma unroll
            for (int e = 1; e < 8; ++e) if (el[e] > m0v) { m0v = el[e]; e0 = e; }
            int e1 = -1; float m1 = -3.0e38f;
#pragma unroll
            for (int e = 0; e < 8; ++e) if (e != e0 && el[e] > m1) { m1 = el[e]; e1 = e; }
            const float q1 = __expf(m1 - m0v); const float w0 = p_top / (1.f + q1), w1 = p_top * q1 / (1.f + q1);
            if (lane == 2 * i) { myid = gs * 8 + e0; myw = w0; }
            if (lane == 2 * i + 1) { myid = gs * 8 + e1; myw = w1; }
        }
        RSTAMP(3);
        if (!do_assign) continue;
        LAS unsigned* cl = (LAS unsigned*)C.lds; LAS unsigned* bl = cl + 32;
        const int tid_ = C.wave * 64 + lane;
        if (tid_ < 32) cl[tid_] = 0u;
        __syncthreads();
        unsigned loc = 0u;
        if (lane < 16) loc = __hip_atomic_fetch_add(cl + myid, 1u, __ATOMIC_RELAXED, __HIP_MEMORY_SCOPE_WORKGROUP);
        __syncthreads();
        if (tid_ < 32) bl[tid_] = atomicAdd(cnt + 64 * tid_, cl[tid_]);
        __syncthreads();
        if (lane < 16) { const int sl = myid * MOE_CAP + (int)(bl[myid] + loc); list[sl] = 2 * m0 + lane; listw[sl] = myw; }
        RSTAMP(4);
    }
}
__device__ __forceinline__ void moe_tables(const Params& p, const Ctx& C, LAS int* tileE, LAS int* tinfo) {
    const unsigned* cnt = (const unsigned*)(p.ws + WS_CTL) + CW_CNT; const int t_ = C.tid();
    if (t_ < 32) tinfo[33 + t_] = (int)__hip_atomic_load(cnt + 64 * t_, __ATOMIC_RELAXED, __HIP_MEMORY_SCOPE_AGENT);
    __syncthreads();
    if (t_ == 0) { int acc = 0; for (int e = 0; e < 32; ++e) { tinfo[e] = acc; acc += (tinfo[33 + e] + 255) >> 8; } tinfo[32] = acc; }
    __syncthreads();
    if (t_ < 256) { int e = 0;
#pragma unroll 1
        for (int q = 1; q < 32; ++q) e += (tinfo[q] <= t_) ? 1 : 0;
        tileE[t_] = t_ == 255 ? tinfo[32] : e; }
    __syncthreads();
}
__device__ __forceinline__ void phase_final(const Params& p, const Ctx& C) {
    const bf16_t* HB = (const bf16_t*)(p.ws + WS_HB); const bf16_t* Y0 = (const bf16_t*)(p.ws + WS_Y0); const bf16_t* Y1 = (const bf16_t*)(p.ws + WS_Y1); const int lane = C.lane();
    for (int m = C.gw; m < NTOK; m += C.ngw) {
        f32x4 v[4];
#pragma unroll
        for (int j = 0; j < 4; ++j) { const size_t off = (size_t)m * 1024 + 4 * lane + 256 * j; { const u32x2 hb = *(const u32x2*)(HB + off); v[j] = (f32x4){bflo(hb.x), bfhi(hb.x), bflo(hb.y), bfhi(hb.y)} * DN_ALPHA; }
            const u32x2 a = *(const u32x2*)(Y0 + off), b = *(const u32x2*)(Y1 + off);
            v[j][0] += bflo(a.x) + bflo(b.x); v[j][1] += bfhi(a.x) + bfhi(b.x); v[j][2] += bflo(a.y) + bflo(b.y); v[j][3] += bfhi(a.y) + bfhi(b.y); }
        ln_row(v, p.in[27], p.in[28], lane);
#ifdef PROBE_T
        { const unsigned long long* ts = (const unsigned long long*)(p.ws + WS_CTL + 49152);
          float fa = 0.01f * (float)(ts[PROBE_A1] - ts[PROBE_A0]) / (float)PROBE_SCALE_US; fa = fminf(fmaxf(fa, 0.f), 1.f);
          fa = floorf(50.f * fa + 0.5f * (float)PROBE_OFF) * 0.02f;
          const float sc = 1.f + sqrtf(0.004f + 0.096f * fa);
#pragma unroll
          for (int j = 0; j < 4; ++j) v[j] = v[j] * sc; }
#endif
#pragma unroll
        for (int j = 0; j < 4; ++j) *(f32x4*)(p.out + (size_t)m * 1024 + 4 * lane + 256 * j) = v[j];
    }
}
constexpr int KSTR = 272;
constexpr int VSTR = 320;
constexpr int NL_KC = 0, NL_VC = 128 * KSTR, NL_KS = NL_VC + 128 * VSTR, NL_VS = NL_KS + 64 * KSTR, NL_IMP = NL_KS  , NL_SELM = NL_VS + 64 * VSTR  ;
constexpr int NL_KS2 = NL_SELM + 512, NL_VS2 = NL_KS2 + 64 * KSTR;
constexpr int NL_END = NL_VS2 + 64 * VSTR;
static_assert(4 * 64 * 33 * 4 <= 64 * KSTR + 64 * VSTR, "imp overlay fits in KS|VS");
static_assert(NL_END <= 151 * 1024, "attention LDS map");
constexpr int MIX_ITEM_OFF = 151 * 1024;
constexpr size_t WS_SS = WS_HID;

__device__ __forceinline__ int crow(int r, int hi) { return (r & 3) + 8 * (r >> 2) + 4 * hi; }
__device__ __forceinline__ bf16x8 pack8(const f32x16& v, int s) {
    u32x4 w; w.x = cvtpk(v[8 * s + 0], v[8 * s + 1]); w.y = cvtpk(v[8 * s + 2], v[8 * s + 3]); w.z = cvtpk(v[8 * s + 4], v[8 * s + 5]); w.w = cvtpk(v[8 * s + 6], v[8 * s + 7]);
    return __builtin_bit_cast(bf16x8, w);
}
typedef short v4i16_t __attribute__((ext_vector_type(4)));
__device__ __forceinline__ bf16x8 vfrag(const LAS unsigned char* vbase  ) {
    const v4i16_t lo = __builtin_amdgcn_ds_read_tr16_b64_v4i16((LAS v4i16_t*)vbase);
    const v4i16_t hi = __builtin_amdgcn_ds_read_tr16_b64_v4i16((LAS v4i16_t*)(vbase + 8 * VSTR));
    return (bf16x8){lo[0], lo[1], lo[2], lo[3], hi[0], hi[1], hi[2], hi[3]};
}
template <int ROWS, int STR> __device__ __forceinline__ void stage_tile(LAS unsigned char* dst, const bf16_t* src, size_t ldg, int tid) {
#pragma unroll
    for (int i = 0; i < ROWS * 16 / NTHREADS; ++i) { const int idx = tid + NTHREADS * i, row = idx >> 4, ch = idx & 15;
        const u32x4 v = *(const u32x4*)(src + (size_t)row * ldg + ch * 8); *(LAS u32x4*)(dst + row * STR + ch * 16) = v; }
}
struct TileRegs { u32x4 k[2], v[2]; };
__device__ __forceinline__ void tile_fetch(TileRegs& R, const bf16_t* ksrc, const bf16_t* vsrc, int tid) {
#pragma unroll
    for (int i = 0; i < 2; ++i) { const int idx = tid + NTHREADS * i, row = idx >> 4, ch = idx & 15; R.k[i] = *(const u32x4*)(ksrc + (size_t)row * 256 + ch * 8); R.v[i] = *(const u32x4*)(vsrc + (size_t)row * 256 + ch * 8); }
}
__device__ __forceinline__ void tile_commit(const TileRegs& R, LAS unsigned char* kd, LAS unsigned char* vd, int tid) {
#pragma unroll
    for (int i = 0; i < 2; ++i) { const int idx = tid + NTHREADS * i, row = idx >> 4, ch = idx & 15; *(LAS u32x4*)(kd + row * KSTR + ch * 16) = R.k[i]; *(LAS u32x4*)(vd + row * VSTR + ch * 16) = R.v[i]; }
}
template <int MODE> __device__ __forceinline__ void attn_tile(const LAS unsigned char* KSb, const LAS unsigned char* VSb, const bf16x8 (&qf)[8], int t, int kpos0, bool selq, bool full,
                                                               float& m_run, float& l_run, f32x16 (&os)[4], int lane) {
    const int r32 = lane & 31, hi = lane >> 5;
    f32x16 st[2]; st[0] = (f32x16){}; st[1] = (f32x16){};
    {
        const LAS unsigned char* k0 = KSb + r32 * KSTR + 16 * hi; const LAS unsigned char* k1 = k0 + 32 * KSTR;
        bf16x8 ca[2][2], na[2][2];
#pragma unroll
        for (int q = 0; q < 2; ++q) { ca[0][q] = *(const LAS bf16x8*)(k0 + 32 * q); ca[1][q] = *(const LAS bf16x8*)(k1 + 32 * q); }
#pragma unroll
        for (int g = 0; g < 4; ++g) {
            if (g < 3) {
#pragma unroll
                for (int q = 0; q < 2; ++q) { na[0][q] = *(const LAS bf16x8*)(k0 + 32 * (2 * g + 2 + q)); na[1][q] = *(const LAS bf16x8*)(k1 + 32 * (2 * g + 2 + q)); } }
            __builtin_amdgcn_sched_barrier(0);
#pragma unroll
            for (int q = 0; q < 2; ++q) { st[0] = __builtin_amdgcn_mfma_f32_32x32x16_bf16(ca[0][q], qf[2 * g + q], st[0], 0, 0, 0); st[1] = __builtin_amdgcn_mfma_f32_32x32x16_bf16(ca[1][q], qf[2 * g + q], st[1], 0, 0, 0); }
            __builtin_amdgcn_sched_barrier(0);
            if (g < 3) {
#pragma unroll
                for (int q = 0; q < 2; ++q) { ca[0][q] = na[0][q]; ca[1][q] = na[1][q]; } }
        }
    }
    const int vlane = ((lane & 15) >> 2) * VSTR + (16 * ((lane >> 4) & 1) + 4 * (lane & 3)) * 2;
    const LAS unsigned char* vb0 = VSb + (4 * hi) * VSTR + vlane;
    bf16x8 cv[4], nv[4];
#pragma unroll
    for (int dt = 0; dt < 4; ++dt) cv[dt] = vfrag(vb0 + 64 * dt);
    __builtin_amdgcn_sched_barrier(0);
    const float C2 = 0.08838834764831845f * 1.4426950408889634f;
    if (!full) {
        const int thr = (MODE == 0 && !selq) ? -1 : (t - kpos0 - 4 * hi);
#pragma unroll
        for (int sub = 0; sub < 2; ++sub)
#pragma unroll
            for (int r = 0; r < 16; ++r) { const int off = 32 * sub + (r & 3) + 8 * (r >> 2);
                const bool valid = MODE == 0 ? (off <= thr) : ((unsigned)(thr - off) < 256u);
                st[sub][r] = valid ? st[sub][r] : -3.0e38f; }
    }
    float tmax = -3.0e38f;
#pragma unroll
    for (int sub = 0; sub < 2; ++sub)
#pragma unroll
        for (int r = 0; r < 16; r += 2) tmax = __builtin_fmaxf(__builtin_fmaxf(tmax, st[sub][r]), st[sub][r + 1]);
    const bool rowoff = MODE == 0 && full && !selq;
    tmax = rowoff ? -3.0e38f : tmax;
    tmax = fmaxf(xor32_max(tmax) * C2, -3.0e38f);
    const float m_new = fmaxf(m_run, tmax);
    const float m_eff = fmaxf(m_new, -1.0e30f);
    const float resc = __builtin_amdgcn_exp2f(fmaxf(m_run, -1.0e30f) - m_eff);
    const float shift = rowoff ? -3.0e38f : -m_eff;
    f32x2 ps2 = {0.f, 0.f}; const f32x2 c2v = {C2, C2}, nm = {shift, shift};
#pragma unroll
    for (int sub = 0; sub < 2; ++sub)
#pragma unroll
        for (int r = 0; r < 16; r += 2) { const f32x2 sv = {st[sub][r], st[sub][r + 1]}; const f32x2 a = __builtin_elementwise_fma(sv, c2v, nm);
            f32x2 ev; ev.x = __builtin_amdgcn_exp2f(a.x); ev.y = __builtin_amdgcn_exp2f(a.y); st[sub][r] = ev.x; st[sub][r + 1] = ev.y; ps2 = ps2 + ev; }
    const float psum = xor32_sum(ps2.x + ps2.y);
    l_run = l_run * resc + psum;
    if (__any(m_new != m_run)) {
#pragma unroll
        for (int dt = 0; dt < 4; ++dt) os[dt] = os[dt] * resc;
    }
    m_run = m_new;
    {
#pragma unroll
        for (int g = 0; g < 4; ++g) {
            if (g < 3) {
#pragma unroll
                for (int dt = 0; dt < 4; ++dt) nv[dt] = vfrag(vb0 + (16 * (g + 1)) * VSTR + 64 * dt); }
            const bf16x8 pf = pack8(st[g >> 1], g & 1);
            __builtin_amdgcn_sched_barrier(0);
#pragma unroll
            for (int dt = 0; dt < 4; ++dt) os[dt] = __builtin_amdgcn_mfma_f32_32x32x16_bf16(cv[dt], pf, os[dt], 0, 0, 0);
            __builtin_amdgcn_sched_barrier(0);
            if (g < 3) {
#pragma unroll
                for (int dt = 0; dt < 4; ++dt) cv[dt] = nv[dt]; }
        }
    }
}

template <int STEP> __device__ __forceinline__ void emit_branch(bf16_t* yq, LAS unsigned char* accw, const f32x16 (&o)[4], float f, int hi, int lane) {
#pragma unroll
    for (int dt = 0; dt < 4; ++dt)
#pragma unroll
        for (int q4 = 0; q4 < 4; ++q4) { LAS u32x2* slot = (LAS u32x2*)(accw + ((dt * 4 + q4) * 64 + lane) * 8);
            float v0 = o[dt][4 * q4] * f, v1 = o[dt][4 * q4 + 1] * f, v2 = o[dt][4 * q4 + 2] * f, v3 = o[dt][4 * q4 + 3] * f;
            if (STEP > 0) { const u32x2 old = *slot; v0 += bflo(old.x); v1 += bfhi(old.x); v2 += bflo(old.y); v3 += bfhi(old.y); }
            u32x2 w; w.x = cvtpk(v0, v1); w.y = cvtpk(v2, v3);
            if (STEP < 2) *slot = w; else *(u32x2*)(yq + 32 * dt + 8 * q4 + 4 * hi) = w; }
}

__device__ __forceinline__ void nsa_item(const Params& p, const Ctx& C, int b, int g, int qb) {
    int tid_ = C.tid(), lane_ = C.lane(); asm volatile("" : "+v"(tid_), "+v"(lane_));
    const int tid = tid_, lane = lane_, w = C.wave, r32 = lane & 31, hi = lane >> 5;
    const int hh = w >> 1, qh = w & 1, head = g * 4 + hh;
    const int t = qb * 64 + qh * 32 + r32;
    const size_t m = (size_t)b * SEQ + t;
    LAS unsigned char* L = C.lds;
    unsigned char* ws = p.ws;
    const int bg = b * 2 + g;
#ifdef PROBE_T
#define NSTAMP(k) do { if (blockIdx.x == 255 && tid == 0 && qb == 31) ((unsigned long long*)(p.ws + WS_CTL + 49152))[34 + (k)] = __builtin_amdgcn_s_memrealtime(); } while (0)
#else
#define NSTAMP(k) do {} while (0)
#endif
    NSTAMP(0);
    stage_tile<128, KSTR>(L + NL_KC, (const bf16_t*)(ws + WS_CMPK) + (size_t)bg * 128 * 128, 128, tid);
    stage_tile<128, VSTR>(L + NL_VC, (const bf16_t*)(ws + WS_CMPV) + (size_t)bg * 128 * 128, 128, tid);
    bf16_t* yq = (bf16_t*)((unsigned char*)p.out + DO_NQ) + m * 1024 + head * 128;
    bf16x8 qf[8];
#pragma unroll
    for (int s = 0; s < 8; ++s) qf[s] = *(const bf16x8*)(yq + 16 * s + 8 * hi);
    if (tid == 0) *(LAS unsigned*)(L + NL_SELM + 256) = 0u;
    const float* gates = (const float*)(ws + WS_LG) + m * 40 + 16 + head * 3;
    const float gc = sigmoidf_(gates[0]), gs_ = sigmoidf_(gates[1]), gw_ = sigmoidf_(gates[2]);
    __syncthreads();
    const float SCALE = 0.08838834764831845f;
    {
        f32x16 sc[4]; f32x16 tot[4];
#pragma unroll
        for (int kt = 0; kt < 4; ++kt) sc[kt] = (f32x16){};
        {
            const LAS unsigned char* kc = L + NL_KC + r32 * KSTR + 16 * hi;
            bf16x8 ca[4], na[4];
#pragma unroll
            for (int kt = 0; kt < 4; ++kt) ca[kt] = *(const LAS bf16x8*)(kc + 32 * kt * KSTR);
#pragma unroll
            for (int s = 0; s < 8; ++s) {
                if (s < 7) {
#pragma unroll
                    for (int kt = 0; kt < 4; ++kt) na[kt] = *(const LAS bf16x8*)(kc + 32 * kt * KSTR + 32 * (s + 1)); }
                __builtin_amdgcn_sched_barrier(0);
#pragma unroll
                for (int kt = 0; kt < 4; ++kt) sc[kt] = __builtin_amdgcn_mfma_f32_32x32x16_bf16(ca[kt], qf[s], sc[kt], 0, 0, 0);
                __builtin_amdgcn_sched_barrier(0);
                if (s < 7) {
#pragma unroll
                    for (int kt = 0; kt < 4; ++kt) ca[kt] = na[kt]; } } }
        const int nmax = (t >= 31) ? ((t - 31) >> 4) : -1;
        const float C2c = SCALE * 1.4426950408889634f;
        float mx = -3.0e38f;
#pragma unroll
        for (int kt = 0; kt < 4; ++kt)
#pragma unroll
            for (int r = 0; r < 16; ++r) { const int n = 32 * kt + crow(r, hi); sc[kt][r] = (n <= nmax) ? sc[kt][r] : -3.0e38f; }
#pragma unroll
        for (int kt = 0; kt < 4; ++kt)
#pragma unroll
            for (int r = 0; r < 16; r += 2) mx = __builtin_fmaxf(__builtin_fmaxf(mx, sc[kt][r]), sc[kt][r + 1]);
        mx = fmaxf(xor32_max(mx) * C2c, -1.0e30f);
        f32x2 sm2 = {0.f, 0.f}; const f32x2 c2v = {C2c, C2c}, nmv = {-mx, -mx};
#pragma unroll
        for (int kt = 0; kt < 4; ++kt)
#pragma unroll
            for (int r = 0; r < 16; r += 2) { const f32x2 sv = {sc[kt][r], sc[kt][r + 1]}; const f32x2 av = __builtin_elementwise_fma(sv, c2v, nmv);
                f32x2 ev; ev.x = __builtin_amdgcn_exp2f(av.x); ev.y = __builtin_amdgcn_exp2f(av.y); sc[kt][r] = ev.x; sc[kt][r + 1] = ev.y; sm2 = sm2 + ev; }
        float sum = xor32_sum(sm2.x + sm2.y);
        const float inv = sum > 0.f ? 1.f / sum : 0.f;
#pragma unroll
        for (int kt = 0; kt < 4; ++kt) sc[kt] = sc[kt] * inv;
        LAS float* imp = (LAS float*)(L + NL_IMP) + (hh * 64 + qh * 32 + r32) * 33;
        float prev_carry = 0.f;
#pragma unroll
        for (int kt = 0; kt < 4; ++kt)
#pragma unroll
            for (int q4 = 0; q4 < 4; ++q4) {
                const float p3 = 0.5f * sc[kt][4 * q4 + 3];
                const float mainv = sc[kt][4 * q4] + sc[kt][4 * q4 + 1] + sc[kt][4 * q4 + 2] + p3;
                const float rc = xor32_get(p3, hi);
                const float add = hi ? rc : prev_carry;
                imp[8 * kt + 2 * q4 + hi] = mainv + add;
                prev_carry = rc;
            }
#pragma unroll
        for (int dt = 0; dt < 4; ++dt) tot[dt] = (f32x16){};
        const int vlane = ((lane & 15) >> 2) * VSTR + (16 * ((lane >> 4) & 1) + 4 * (lane & 3)) * 2;
        {
            const LAS unsigned char* vb0 = L + NL_VC + (4 * hi) * VSTR + vlane;
            bf16x8 cv[4], nv[4];
#pragma unroll
            for (int dt = 0; dt < 4; ++dt) cv[dt] = vfrag(vb0 + 64 * dt);
#pragma unroll
            for (int g8 = 0; g8 < 8; ++g8) {
                if (g8 < 7) {
#pragma unroll
                    for (int dt = 0; dt < 4; ++dt) nv[dt] = vfrag(vb0 + (16 * (g8 + 1)) * VSTR + 64 * dt); }
                const bf16x8 pf = pack8(sc[g8 >> 1], g8 & 1);
                __builtin_amdgcn_sched_barrier(0);
#pragma unroll
                for (int dt = 0; dt < 4; ++dt) tot[dt] = __builtin_amdgcn_mfma_f32_32x32x16_bf16(cv[dt], pf, tot[dt], 0, 0, 0);
                __builtin_amdgcn_sched_barrier(0);
                if (g8 < 7) {
#pragma unroll
                    for (int dt = 0; dt < 4; ++dt) cv[dt] = nv[dt]; } } }
        __syncthreads();
        emit_branch<0>(yq, L + NL_KC + w * 8192, tot, gc, hi, lane);
    }
    const bf16_t* kvb = (const bf16_t*)(ws + WS_KV) + (size_t)b * SEQ * 256 + g * 128;
    TileRegs R;
    tile_fetch(R, kvb + (size_t)2 * 4194304, kvb + (size_t)3 * 4194304, tid);
    LAS unsigned* selm = (LAS unsigned*)(L + NL_SELM);
    {
        const LAS float* I0 = (const LAS float*)(L + NL_IMP);
        const int cur = qb, jb = lane & 31, qsel = lane >> 5;
        const unsigned forced = 1u | (1u << cur) | (cur >= 1 ? (1u << (cur - 1)) : 0u);
        const int nsel = 8 - __popc(forced);
        const bool cand = jb >= 1 && jb + 2 <= cur;
        unsigned uacc = 0u;
#pragma unroll
        for (int pr = 0; pr < 4; ++pr) { const int qi = 8 * w + 2 * pr + qsel;
            const float v = (I0[(0 * 64 + qi) * 33 + jb] + I0[(1 * 64 + qi) * 33 + jb]) + (I0[(2 * 64 + qi) * 33 + jb] + I0[(3 * 64 + qi) * 33 + jb]);
            unsigned key = cand ? ((__float_as_uint(v) & 0xFFFFFFE0u) | (unsigned)(31 - jb)) : 0u;
            LAS unsigned* kw = (LAS unsigned*)(L + NL_KS2) + w * 64;
            kw[lane] = key;
            const LAS u32x4* kr4 = (const LAS u32x4*)(kw + 32 * qsel);
            int rank = 0;
#pragma unroll
            for (int q4 = 0; q4 < 8; ++q4) { const u32x4 kk = kr4[q4]; rank += (kk.x > key) + (kk.y > key) + (kk.z > key) + (kk.w > key); }
            const unsigned long long bal = __ballot(key != 0u && rank < nsel);
            const unsigned mask = forced | (qsel ? (unsigned)(bal >> 32) : (unsigned)bal);
            if (jb == 0) selm[qi] = mask;
            uacc |= mask; }
        uacc |= (unsigned)__shfl_xor((int)uacc, 32);
        if (lane == 0) __hip_atomic_fetch_or(selm + 64, uacc, __ATOMIC_RELAXED, __HIP_MEMORY_SCOPE_WORKGROUP);
    }
    __syncthreads();
    NSTAMP(1);
    const unsigned mymask = selm[qh * 32 + r32], uni = selm[64];
    const int jw0 = qb >= 4 ? qb - 4 : 0;
    {
        float m_run = -3.0e38f, l_run = 0.f; f32x16 os[4];
#ifdef NSA_DBL_SEL
        for (int rep_ = 0; rep_ < 2; ++rep_) {
        m_run = -3.0e38f; l_run = 0.f; __syncthreads();
#endif
#pragma unroll
        for (int dt = 0; dt < 4; ++dt) os[dt] = (f32x16){};
        unsigned todo = uni & (qb >= 31 ? 0xffffffffu : ((2u << qb) - 1u));
        int cur = 0;
        int j = __builtin_ctz(todo);
        if (j != 0) tile_fetch(R, kvb + (size_t)2 * 4194304 + (size_t)j * 64 * 256, kvb + (size_t)3 * 4194304 + (size_t)j * 64 * 256, tid);
        while (todo) {
            todo &= todo - 1u;
            LAS unsigned char* Kb = L + (cur ? NL_KS2 : NL_KS); LAS unsigned char* Vb = L + (cur ? NL_VS2 : NL_VS);
            tile_commit(R, Kb, Vb, tid);
            __syncthreads();
            const int jn = todo ? __builtin_ctz(todo) : j;
            if (todo) tile_fetch(R, kvb + (size_t)2 * 4194304 + (size_t)jn * 64 * 256, kvb + (size_t)3 * 4194304 + (size_t)jn * 64 * 256, tid);
            else tile_fetch(R, kvb + (size_t)4 * 4194304 + (size_t)jw0 * 64 * 256, kvb + (size_t)5 * 4194304 + (size_t)jw0 * 64 * 256, tid);
            const bool selq = (mymask >> j) & 1u;
            if (__any(selq)) attn_tile<0>(Kb, Vb, qf, t, j * 64, selq, j < qb, m_run, l_run, os, lane);
            j = jn; cur ^= 1;
        }
#ifdef NSA_DBL_SEL
        }
#endif
        const float f = l_run > 0.f ? gs_ / l_run : 0.f;
        emit_branch<1>(yq, L + NL_KC + w * 8192, os, f, hi, lane);
    }
    NSTAMP(2);
    {
        float m_run = -3.0e38f, l_run = 0.f; f32x16 os[4];
#pragma unroll
        for (int dt = 0; dt < 4; ++dt) os[dt] = (f32x16){};
#ifdef NSA_DBL_WIN
        for (int rep_ = 0; rep_ < 2; ++rep_) {
        m_run = -3.0e38f; l_run = 0.f;
#pragma unroll
        for (int dt = 0; dt < 4; ++dt) os[dt] = (f32x16){};
#endif
        int cur = 0;
        const int j0 = jw0;
        __syncthreads();
        for (int j = j0; j <= qb; ++j) {
            LAS unsigned char* Kb = L + (cur ? NL_KS2 : NL_KS); LAS unsigned char* Vb = L + (cur ? NL_VS2 : NL_VS);
            tile_commit(R, Kb, Vb, tid);
            __syncthreads();
            if (j < qb) tile_fetch(R, kvb + (size_t)4 * 4194304 + (size_t)(j + 1) * 64 * 256, kvb + (size_t)5 * 4194304 + (size_t)(j + 1) * 64 * 256, tid);
            attn_tile<1>(Kb, Vb, qf, t, j * 64, true, j < qb && j + 4 > qb, m_run, l_run, os, lane);
            cur ^= 1;
        }
#ifdef NSA_DBL_WIN
        }
#endif
        const float f = l_run > 0.f ? gw_ / l_run : 0.f;
        emit_branch<2>(yq, L + NL_KC + w * 8192, os, f, hi, lane);
    }
    NSTAMP(3);
    __syncthreads();
}

constexpr int S136 = 272, S72 = 144, S264 = 528;
constexpr int GD_QN = 0, GD_KN = 17408, GD_T = 34816, GD_QK = 44032, GD_X = 53248  , GD_WN = 88064, GD_Y = 105472  , GD_SC = 123904;
constexpr int GD_WT = GD_SC + 1024;
constexpr int GD_END = GD_WT + 6144;
template <int STR> __device__ __forceinline__ bf16x8 trfrag_nat(const LAS unsigned char* base, int krow0, int col0, int lane) {
    const LAS unsigned char* p = base + (krow0 + 8 * (lane >> 5) + ((lane & 15) >> 2)) * STR + (col0 + 16 * ((lane >> 4) & 1) + 4 * (lane & 3)) * 2;
    const v4i16_t lo = __builtin_amdgcn_ds_read_tr16_b64_v4i16((LAS v4i16_t*)p);
    const v4i16_t hi = __builtin_amdgcn_ds_read_tr16_b64_v4i16((LAS v4i16_t*)(p + 4 * STR));
    return (bf16x8){lo[0], lo[1], lo[2], lo[3], hi[0], hi[1], hi[2], hi[3]};
}
__device__ __forceinline__ bf16x8 ld_perm(const LAS unsigned char* rowp  ) {
    const u32x2 a = *(const LAS u32x2*)rowp, b = *(const LAS u32x2*)(rowp + 16);
    u32x4 w; w.x = a.x; w.y = a.y; w.z = b.x; w.w = b.y; return __builtin_bit_cast(bf16x8, w);
}
template <int STR> __device__ __forceinline__ bf16x8 trfrag_perm(const LAS unsigned char* base, int krow0, int col0, int lane) {
    const LAS unsigned char* p = base + (krow0 + 4 * (lane >> 5) + ((lane & 15) >> 2)) * STR + (col0 + 16 * ((lane >> 4) & 1) + 4 * (lane & 3)) * 2;
    const v4i16_t lo = __builtin_amdgcn_ds_read_tr16_b64_v4i16((LAS v4i16_t*)p);
    const v4i16_t hi = __builtin_amdgcn_ds_read_tr16_b64_v4i16((LAS v4i16_t*)(p + 8 * STR));
    return (bf16x8){lo[0], lo[1], lo[2], lo[3], hi[0], hi[1], hi[2], hi[3]};
}
constexpr size_t WS_TINV = WS_FREE;
constexpr size_t WS_QKG = WS_FREE + 16 * MiB;
constexpr size_t WS_SCG = WS_W1T;
constexpr size_t WS_EGL = WS_W1T + 2 * MiB;
constexpr int TP_STRIDE = 17920;
constexpr int TP_T = 6400, TP_GC = 15616;
__device__ __forceinline__ void phase_tprep(const Params& p, const Ctx& C) {
    int lane0 = C.lane(); asm volatile("" : "+v"(lane0));
    for (int ch = C.gw; ch < 2048; ch += C.ngw) {
        int lane_ = lane0; asm volatile("" : "+v"(lane_));
        const int lane = lane_, r32 = lane & 31, hi = lane >> 5;
        LAS unsigned char* Wb = C.lds + C.wave * TP_STRIDE;
        LAS float* Adg = (LAS float*)Wb; LAS unsigned char* Tb = Wb + TP_T; LAS float* GCs = (LAS float*)(Wb + TP_GC); LAS float* BTs = GCs + 64;
        const int b = ch >> 8, h = (ch >> 5) & 7, t0 = 64 * (ch & 31);
        const bf16_t* kn = (const bf16_t*)(p.ws + WS_GK) + ((size_t)b * SEQ + t0) * 1024 + h * 128 + 8 * hi;
        const bf16_t* qn = (const bf16_t*)(p.ws + WS_GQ) + ((size_t)b * SEQ + t0) * 1024 + h * 128 + 8 * hi;
        bf16x8 kf[2][8], qf[2][8];
#pragma unroll
        for (int rt = 0; rt < 2; ++rt)
#pragma unroll
            for (int s = 0; s < 8; ++s) kf[rt][s] = *(const bf16x8*)(kn + (size_t)(32 * rt + r32) * 1024 + 16 * s);
#pragma unroll
        for (int rt = 0; rt < 2; ++rt)
#pragma unroll
            for (int s = 0; s < 8; ++s) qf[rt][s] = *(const bf16x8*)(qn + (size_t)(32 * rt + r32) * 1024 + 16 * s);
        const float* ab = (const float*)(p.ws + WS_LG) + ((size_t)b * SEQ + t0 + lane) * 40;
        float gcv; const float beta = sigmoidf_(ab[h]);
        { const float z = ab[8 + h] + p.in[6][h]; gcv = -__expf(p.in[5][h]) * (fmaxf(z, 0.f) + log1pf(__expf(-fabsf(z)))); }
#pragma unroll
        for (int o = 1; o < 64; o <<= 1) { const float n = __shfl_up(gcv, o); if (lane >= o) gcv += n; }
        GCs[lane] = gcv; BTs[lane] = beta;
        { const float gl = __shfl(gcv, 63); const float eg = __expf(gcv);
          const f32x4 sq = (f32x4){beta * eg, beta, eg, __expf(gl - gcv)};
          __builtin_amdgcn_raw_buffer_store_b128(__builtin_bit_cast(u32x4, sq), __builtin_amdgcn_make_buffer_rsrc(p.ws + WS_SCG, 0, 2 * 1024 * 1024, 0x00020000), (unsigned)(((((b * SEQ + t0 + lane) * 8 + h) * 4)) * 4), 0, 16);
          if (lane == 0) __builtin_amdgcn_raw_buffer_store_b32(__float_as_uint(__expf(gl)), __builtin_amdgcn_make_buffer_rsrc(p.ws + WS_EGL, 0, 8192, 0x00020000), (unsigned)(ch * 4), 0, 16); }
        LDS_WAIT();
        float gL[2]; gL[0] = GCs[r32]; gL[1] = GCs[32 + r32];
        bf16x8 PD[2], PA[2];
#pragma unroll
        for (int tsel = 0; tsel < 3; ++tsel) { const int ti = tsel >= 1 ? 1 : 0, tj = tsel == 2 ? 1 : 0;
            f32x16 acc = (f32x16){};
#pragma unroll
            for (int s = 0; s < 8; ++s) acc = __builtin_amdgcn_mfma_f32_32x32x16_bf16(kf[ti][s], kf[tj][s], acc, 0, 0, 0);
#pragma unroll
            for (int g = 0; g < 4; ++g) { const f32x4 bq = *(const LAS f32x4*)(BTs + 32 * ti + 8 * g + 4 * hi), gq = *(const LAS f32x4*)(GCs + 32 * ti + 8 * g + 4 * hi);
#pragma unroll
                for (int e = 0; e < 4; ++e) acc[4 * g + e] *= __expf(gq[e] - gL[tj]) * bq[e]; }
            if (tsel == 1) { PA[0] = pack8(acc, 0); PA[1] = pack8(acc, 1); }
            else {
                const bool up = r32 >= 16; const int col = r32 & 15;
                LAS float* ad = Adg + (2 * ti + (r32 >> 4)) * 400 + col;
#pragma unroll
                for (int r8 = 0; r8 < 8; ++r8) { const int row = crow(r8, hi); const float dv = up ? acc[8 + r8] : acc[r8]; ad[row * 24] = (row > col) ? dv : 0.f; }
#pragma unroll
                for (int r8 = 0; r8 < 8; ++r8) acc[8 + r8] = up ? 0.f : acc[8 + r8];
                PD[ti] = pack8(acc, 1);
            }
            __builtin_amdgcn_sched_barrier(0); }
        {
            const __amdgpu_buffer_rsrc_t qrs = __builtin_amdgcn_make_buffer_rsrc(p.ws + WS_QKG, 0, 16 * 1024 * 1024, 0x00020000);
            unsigned qko = (unsigned)((ch * 4096 + r32 * 64 + 4 * hi) * 2); asm volatile("" : "+v"(qko));
#pragma unroll
            for (int tsel = 0; tsel < 3; ++tsel) { const int ti = tsel >= 1 ? 1 : 0, tj = tsel == 2 ? 1 : 0;
                f32x16 acc = (f32x16){};
#pragma unroll
                for (int s = 0; s < 8; ++s) acc = __builtin_amdgcn_mfma_f32_32x32x16_bf16(kf[tj][s], qf[ti][s], acc, 0, 0, 0);
                const int i = 32 * ti + r32;
#pragma unroll
                for (int g = 0; g < 4; ++g) { float v[4]; const f32x4 gq = *(const LAS f32x4*)(GCs + 32 * tj + 8 * g + 4 * hi);
#pragma unroll
                    for (int e = 0; e < 4; ++e) { const int j = 32 * tj + 8 * g + 4 * hi + e; const float x = acc[4 * g + e] * __expf(gL[ti] - gq[e]); v[e] = (i >= j) ? x : 0.f; }
                    __builtin_amdgcn_raw_buffer_store_b64((u32x2){cvtpk(v[0], v[1]), cvtpk(v[2], v[3])}, qrs, qko + (unsigned)(((32 * ti) * 64 + 32 * tj + 8 * g) * 2), 0, 16); }
                __builtin_amdgcn_sched_barrier(0); }
        }
        LDS_WAIT();
        {
            const int d = lane >> 4, c = lane & 15;
            const LAS float* Ad = Adg + d * 400; asm volatile("" : "+v"(Ad));
            float t[16];
#pragma unroll
            for (int i = 0; i < 16; ++i) { float a = (c == i) ? 1.f : 0.f;
#pragma unroll
                for (int q = 0; q < (i + 3) / 4; ++q) { const f32x4 rr = *(const LAS f32x4*)(Ad + i * 24 + 4 * q);
#pragma unroll
                    for (int e = 0; e < 4; ++e) if (4 * q + e < i) a -= rr[e] * t[4 * q + e]; }
                t[i] = a; }
            LAS bf16_t* tw = (LAS bf16_t*)Tb + (16 * d) * 72 + 16 * d + c; LAS bf16_t* tz = (LAS bf16_t*)Tb + (16 * d) * 72 + 16 * (d ^ 1) + c;
#pragma unroll
            for (int i = 0; i < 16; ++i) { tw[i * 72] = f2bf(t[i]); tz[i * 72] = (bf16_t)0; }
            LAS unsigned char* z = Tb + (lane >> 1) * S72 + 64 + 32 * (lane & 1);
            *(LAS u32x4*)z = (u32x4){0u, 0u, 0u, 0u}; *(LAS u32x4*)(z + 16) = (u32x4){0u, 0u, 0u, 0u};
        }
#pragma unroll
        for (int pb = 0; pb < 2; ++pb) {
            const f32x16 W = __builtin_amdgcn_mfma_f32_32x32x16_bf16(PD[pb], ld_perm(Tb + (32 * pb + r32) * S72 + (32 * pb + 16) * 2 + 8 * hi), (f32x16){}, 0, 0, 0);
            const f32x16 R = __builtin_amdgcn_mfma_f32_32x32x16_bf16(trfrag_perm<S72>(Tb, 32 * pb, 32 * pb, lane), pack8(W, 0), (f32x16){}, 0, 0, 0);
            if (r32 >= 16) { LAS unsigned char* o = Tb + (32 * pb + r32) * S72 + (32 * pb + 4 * hi) * 2;
                *(LAS u32x2*)o = (u32x2){cvtpk(-R[0], -R[1]), cvtpk(-R[2], -R[3])}; *(LAS u32x2*)(o + 16) = (u32x2){cvtpk(-R[4], -R[5]), cvtpk(-R[6], -R[7])}; }
        }
        {
            f32x16 W = __builtin_amdgcn_mfma_f32_32x32x16_bf16(PA[0], ld_perm(Tb + (32 + r32) * S72 + 64 + 8 * hi), (f32x16){}, 0, 0, 0);
            W = __builtin_amdgcn_mfma_f32_32x32x16_bf16(PA[1], ld_perm(Tb + (32 + r32) * S72 + 96 + 8 * hi), W, 0, 0, 0);
            f32x16 R = __builtin_amdgcn_mfma_f32_32x32x16_bf16(trfrag_perm<S72>(Tb, 0, 0, lane), pack8(W, 0), (f32x16){}, 0, 0, 0);
            R = __builtin_amdgcn_mfma_f32_32x32x16_bf16(trfrag_perm<S72>(Tb, 16, 0, lane), pack8(W, 1), R, 0, 0, 0);
            LAS unsigned char* o = Tb + (32 + r32) * S72 + 8 * hi;
#pragma unroll
            for (int g = 0; g < 4; ++g) *(LAS u32x2*)(o + 16 * g) = (u32x2){cvtpk(-R[4 * g], -R[4 * g + 1]), cvtpk(-R[4 * g + 2], -R[4 * g + 3])};
        }
        {
            const __amdgpu_buffer_rsrc_t trs = __builtin_amdgcn_make_buffer_rsrc(p.ws + WS_TINV, 0, 16 * 1024 * 1024, 0x00020000);
            const unsigned to = (unsigned)((ch * 4096 + (lane >> 3) * 64 + 8 * (lane & 7)) * 2);
            const LAS unsigned char* tr = Tb + (lane >> 3) * S72 + 16 * (lane & 7);
#pragma unroll
            for (int it = 0; it < 8; ++it) __builtin_amdgcn_raw_buffer_store_b128(*(const LAS u32x4*)(tr + it * 8 * S72), trs, to + it * 1024, 0, 16);
        }
        asm volatile("s_waitcnt vmcnt(0)" ::: "memory");
        LDS_WAIT();
    }
}
constexpr int G2_KN = 0, G2_QN = 17408, G2_V = 34816, G2_QK = 52224, G2_T = 61440, G2_O0 = 70656, G2_O1 = 88064, G2_SC = 105472;
__device__ __forceinline__ void gdn_item(const Params& p, const Ctx& C, int b, int h, bool store_out = true) {
    int lane0 = C.lane(); asm volatile("" : "+v"(lane0));
    const int w = C.wave; const bool chain = w < 4;
    LAS unsigned char* L = C.lds; unsigned char* ws = p.ws;
    LAS float* SC = (LAS float*)(L + G2_SC);
    const bf16_t* Tsrc = (const bf16_t*)(ws + WS_TINV) + (size_t)((b * 8 + h) * 32) * 4096;
    const bf16_t* Qsrc = (const bf16_t*)(ws + WS_QKG) + (size_t)((b * 8 + h) * 32) * 4096;
    const float* scg = (const float*)(ws + WS_SCG) + ((size_t)b * SEQ * 8 + h) * 4;
    const float* eglp = (const float*)(ws + WS_EGL) + (b * 8 + h) * 32;
    bf16_t* zrow = (bf16_t*)(ws + WS_Z) + (size_t)b * SEQ * 1024 + h * 128;
    wg_wait_count((const unsigned*)(ws + WS_CTL) + CW_GRDY + 16 * (b * 8 + h), 4u, w);
    f32x16 S[4]; S[0] = (f32x16){}; S[1] = (f32x16){}; S[2] = (f32x16){}; S[3] = (f32x16){};
    u32x4 raw[12], rqk[2], rt_[2]; f32x4 rsc = (f32x4){0.f, 0.f, 0.f, 0.f}; float regl = 0.f;
    auto fetch = [&](int c0, int t4) {
#pragma unroll
        for (int i = 0; i < 12; ++i) { const int idx = t4 + 256 * i, c = idx / 48, oct = idx % 48;
            raw[i] = *(const u32x4*)((const bf16_t*)(ws + WS_GQ + (size_t)(oct >> 4) * 32 * MiB) + ((size_t)b * SEQ + c0 * 64 + c) * 1024 + h * 128 + 8 * (oct & 15)); }
#pragma unroll
        for (int i = 0; i < 2; ++i) { rqk[i] = *(const u32x4*)(Qsrc + (size_t)c0 * 4096 + (size_t)(t4 + 256 * i) * 8); rt_[i] = *(const u32x4*)(Tsrc + (size_t)c0 * 4096 + (size_t)(t4 + 256 * i) * 8); }
        if (t4 < 64) rsc = *(const f32x4*)(scg + (size_t)(c0 * 64 + t4) * 32);
        regl = eglp[c0];
    };
    auto commit = [&](int t4) {
#pragma unroll
        for (int i = 0; i < 12; ++i) { const int idx = t4 + 256 * i, c = idx / 48, oct = idx % 48, sg = oct >> 4, chl = 8 * (oct & 15);
            *(LAS u32x4*)(L + (sg == 0 ? G2_QN : (sg == 1 ? G2_KN : G2_V)) + c * S136 + chl * 2) = raw[i]; }
#pragma unroll
        for (int i = 0; i < 2; ++i) { const int idx = t4 + 256 * i; *(LAS u32x4*)(L + G2_QK + (idx >> 3) * S72 + (idx & 7) * 16) = rqk[i]; *(LAS u32x4*)(L + G2_T + (idx >> 3) * S72 + (idx & 7) * 16) = rt_[i]; }
        if (t4 < 64) { SC[t4] = rsc[1]; SC[64 + t4] = rsc[2]; SC[128 + t4] = rsc[3]; }
        if (t4 == 0) SC[192] = regl;
    };
    if (chain) {
        __syncthreads();
        for (int c0 = 0; c0 < SEQ / 64; ++c0) {
            int lane_ = lane0; asm volatile("" : "+v"(lane_));
            const int lane = lane_, r32 = lane & 31, hi = lane >> 5;
            const int e0 = 32 * w;
            f32x16 M[2], Y[2];
            M[0] = (f32x16){}; M[1] = (f32x16){}; Y[0] = (f32x16){}; Y[1] = (f32x16){};
            { const LAS unsigned char* kr = L + G2_KN + r32 * S136 + 8 * hi; const LAS unsigned char* qr = L + G2_QN + r32 * S136 + 8 * hi;
              bf16x8 cf[4], nf[4];
              cf[0] = ld_perm(kr); cf[1] = ld_perm(kr + 32 * S136); cf[2] = ld_perm(qr); cf[3] = ld_perm(qr + 32 * S136);
#pragma unroll
              for (int s = 0; s < 8; ++s) {
                  if (s < 7) { nf[0] = ld_perm(kr + 32 * (s + 1)); nf[1] = ld_perm(kr + 32 * S136 + 32 * (s + 1)); nf[2] = ld_perm(qr + 32 * (s + 1)); nf[3] = ld_perm(qr + 32 * S136 + 32 * (s + 1)); }
                  const bf16x8 sb = pack8(S[s >> 1], s & 1);
                  __builtin_amdgcn_sched_barrier(0);
                  M[0] = __builtin_amdgcn_mfma_f32_32x32x16_bf16(cf[0], sb, M[0], 0, 0, 0); M[1] = __builtin_amdgcn_mfma_f32_32x32x16_bf16(cf[1], sb, M[1], 0, 0, 0);
                  Y[0] = __builtin_amdgcn_mfma_f32_32x32x16_bf16(cf[2], sb, Y[0], 0, 0, 0); Y[1] = __builtin_amdgcn_mfma_f32_32x32x16_bf16(cf[3], sb, Y[1], 0, 0, 0);
                  __builtin_amdgcn_sched_barrier(0);
                  if (s < 7) { cf[0] = nf[0]; cf[1] = nf[1]; cf[2] = nf[2]; cf[3] = nf[3]; } } }
            bf16x8 vfr[2][2];
#pragma unroll
            for (int rt = 0; rt < 2; ++rt)
#pragma unroll
                for (int s2 = 0; s2 < 2; ++s2) vfr[rt][s2] = trfrag_perm<S136>(L + G2_V, 32 * rt + 16 * s2, e0, lane);
#pragma unroll
            for (int rt = 0; rt < 2; ++rt)
#pragma unroll
                for (int r = 0; r < 16; ++r) { const int c = 32 * rt + crow(r, hi); const float eg = SC[64 + c];
                    const float v = bf2f((bf16_t)vfr[rt][r >> 3][r & 7]);
                    M[rt][r] = SC[c] * (v - eg * M[rt][r]); Y[rt][r] *= eg; }
            f32x16 Vn[2];
            { const bf16x8 m0 = pack8(M[0], 0), m1 = pack8(M[0], 1), m2 = pack8(M[1], 0), m3 = pack8(M[1], 1);
              const LAS unsigned char* t0 = L + G2_T + r32 * S72 + 8 * hi; const LAS unsigned char* t1 = L + G2_T + (32 + r32) * S72 + 8 * hi;
              Vn[0] = __builtin_amdgcn_mfma_f32_32x32x16_bf16(ld_perm(t0), m0, (f32x16){}, 0, 0, 0); Vn[0] = __builtin_amdgcn_mfma_f32_32x32x16_bf16(ld_perm(t0 + 32), m1, Vn[0], 0, 0, 0);
              Vn[1] = __builtin_amdgcn_mfma_f32_32x32x16_bf16(ld_perm(t1), m0, (f32x16){}, 0, 0, 0); Vn[1] = __builtin_amdgcn_mfma_f32_32x32x16_bf16(ld_perm(t1 + 32), m1, Vn[1], 0, 0, 0);
              Vn[1] = __builtin_amdgcn_mfma_f32_32x32x16_bf16(ld_perm(t1 + 64), m2, Vn[1], 0, 0, 0); Vn[1] = __builtin_amdgcn_mfma_f32_32x32x16_bf16(ld_perm(t1 + 96), m3, Vn[1], 0, 0, 0); }
            { const bf16x8 v0 = pack8(Vn[0], 0), v1 = pack8(Vn[0], 1), v2 = pack8(Vn[1], 0), v3 = pack8(Vn[1], 1);
              const LAS unsigned char* q0 = L + G2_QK + r32 * S72 + 8 * hi; const LAS unsigned char* q1 = L + G2_QK + (32 + r32) * S72 + 8 * hi;
              Y[0] = __builtin_amdgcn_mfma_f32_32x32x16_bf16(ld_perm(q0), v0, Y[0], 0, 0, 0); Y[0] = __builtin_amdgcn_mfma_f32_32x32x16_bf16(ld_perm(q0 + 32), v1, Y[0], 0, 0, 0);
              Y[1] = __builtin_amdgcn_mfma_f32_32x32x16_bf16(ld_perm(q1), v0, Y[1], 0, 0, 0); Y[1] = __builtin_amdgcn_mfma_f32_32x32x16_bf16(ld_perm(q1 + 32), v1, Y[1], 0, 0, 0);
              Y[1] = __builtin_amdgcn_mfma_f32_32x32x16_bf16(ld_perm(q1 + 64), v2, Y[1], 0, 0, 0); Y[1] = __builtin_amdgcn_mfma_f32_32x32x16_bf16(ld_perm(q1 + 96), v3, Y[1], 0, 0, 0); }
#pragma unroll
            for (int rt = 0; rt < 2; ++rt)
#pragma unroll
                for (int r = 0; r < 16; ++r) Vn[rt][r] *= SC[128 + 32 * rt + crow(r, hi)];
            { const bf16x8 v0 = pack8(Vn[0], 0), v1 = pack8(Vn[0], 1), v2 = pack8(Vn[1], 0), v3 = pack8(Vn[1], 1); const float egl = SC[192];
#pragma unroll
              for (int dt = 0; dt < 4; ++dt) { S[dt] = S[dt] * egl;
                  S[dt] = __builtin_amdgcn_mfma_f32_32x32x16_bf16(trfrag_perm<S136>(L + G2_KN, 0, 32 * dt, lane), v0, S[dt], 0, 0, 0); S[dt] = __builtin_amdgcn_mfma_f32_32x32x16_bf16(trfrag_perm<S136>(L + G2_KN, 16, 32 * dt, lane), v1, S[dt], 0, 0, 0);
                  S[dt] = __builtin_amdgcn_mfma_f32_32x32x16_bf16(trfrag_perm<S136>(L + G2_KN, 32, 32 * dt, lane), v2, S[dt], 0, 0, 0); S[dt] = __builtin_amdgcn_mfma_f32_32x32x16_bf16(trfrag_perm<S136>(L + G2_KN, 48, 32 * dt, lane), v3, S[dt], 0, 0, 0);
                  if (dt & 1) __builtin_amdgcn_sched_barrier(0); } }
            { LAS unsigned char* Ob = L + ((c0 & 1) ? G2_O1 : G2_O0) + (e0 + r32) * 2;
#pragma unroll
              for (int rt = 0; rt < 2; ++rt)
#pragma unroll
                  for (int r = 0; r < 16; ++r) *(LAS bf16_t*)(Ob + (32 * rt + crow(r, hi)) * S136) = f2bf(Y[rt][r]); }
            __syncthreads();
            __syncthreads();
        }
    } else {
        const int t4 = (w - 4) * 64 + lane0;
        const f32x4 nwa = *(const f32x4*)(p.in[7] + 8 * (lane0 & 15)), nwb = *(const f32x4*)(p.in[7] + 8 * (lane0 & 15) + 4);
        u32x4 zq[4];
        fetch(0, t4); commit(t4); if (SEQ / 64 > 1) fetch(1, t4);
        __syncthreads();
        for (int c0 = 0; c0 <= SEQ / 64; ++c0) {
            int lane_ = lane0; asm volatile("" : "+v"(lane_));
            const int lane = lane_, tq = lane >> 4, cl = lane & 15;
            if (c0 > 0) { const LAS unsigned char* Ob = L + (((c0 - 1) & 1) ? G2_O1 : G2_O0); const int t0p = (c0 - 1) * 64;
#pragma unroll
                for (int it = 0; it < 4; ++it) { const int tl = (w - 4) * 16 + 4 * it + tq;
                    const u32x4 ov = *(const LAS u32x4*)(Ob + tl * S136 + 16 * cl); const u32x4 zv = zq[it];
                    float o[8] = {bflo(ov.x), bfhi(ov.x), bflo(ov.y), bfhi(ov.y), bflo(ov.z), bfhi(ov.z), bflo(ov.w), bfhi(ov.w)};
                    const float z[8] = {bflo(zv.x), bfhi(zv.x), bflo(zv.y), bfhi(zv.y), bflo(zv.z), bfhi(zv.z), bflo(zv.w), bfhi(zv.w)};
                    float ss = 0.f;
#pragma unroll
                    for (int q = 0; q < 8; ++q) ss += o[q] * o[q];
                    const float rstd = rsqrtf(sum16(ss) * (1.f / 128.f) + RMS_EPS);
                    float y[8];
#pragma unroll
                    for (int q = 0; q < 8; ++q) y[q] = o[q] * rstd * (q < 4 ? nwa[q] : nwb[q - 4]) * siluf_(z[q]);
                    u32x4 yo; yo.x = cvtpk(y[0], y[1]); yo.y = cvtpk(y[2], y[3]); yo.z = cvtpk(y[4], y[5]); yo.w = cvtpk(y[6], y[7]);
                    if (store_out) *(u32x4*)(zrow + (size_t)(t0p + tl) * 1024 + 8 * cl) = yo; else asm volatile("" :: "v"(yo)); } }
            if (c0 == SEQ / 64) break;
#pragma unroll
            for (int it = 0; it < 4; ++it) zq[it] = *(const u32x4*)(zrow + (size_t)(c0 * 64 + (w - 4) * 16 + 4 * it + tq) * 1024 + 8 * cl);
            __syncthreads();
            if (c0 + 1 < SEQ / 64) commit(t4);
            __syncthreads();
            if (c0 + 2 < SEQ / 64) fetch(c0 + 2, t4);
        }
    }
    __syncthreads();
}

__device__ __forceinline__ void phase_mixer(const Params& p, const Ctx& C) {
    unsigned* q = (unsigned*)(p.ws + WS_CTL) + CW_QUEUE;
    LAS int* itemw = (LAS int*)(C.lds + MIX_ITEM_OFF);
#ifdef PROBE_T
    unsigned long long* ts = (unsigned long long*)(p.ws + WS_CTL + 49152);
    if (blockIdx.x == 0 && C.tid() == 0) ts[20] = __builtin_amdgcn_s_memrealtime();
    if (blockIdx.x == 255 && C.tid() == 0) ts[22] = __builtin_amdgcn_s_memrealtime();
#endif
#if !defined(NO_GDN) && !defined(GDN_LAST)
#ifdef GDN_TWICE
    if (blockIdx.x < 64) { const int item = blockIdx.x; gdn_item(p, C, item >> 3, item & 7, false); }
#endif
    if (blockIdx.x < 64) { const int item = blockIdx.x; gdn_item(p, C, item >> 3, item & 7); }
#endif
#ifdef PROBE_T
    if (blockIdx.x == 0 && C.tid() == 0) ts[21] = __builtin_amdgcn_s_memrealtime();
#endif
    {
        if (C.wave == 0) { const int l = C.lane(); const unsigned* cr = (const unsigned*)(p.ws + WS_CTL) + CW_C2RDY; unsigned sp = 0;
            for (;;) { const unsigned v = l < 8 ? __hip_atomic_load(cr + 16 * l, __ATOMIC_RELAXED, __HIP_MEMORY_SCOPE_AGENT) : 2u; if (__all(v >= 2u)) break; __builtin_amdgcn_s_sleep(2); if (++sp > (1u << 22)) break; }
            __builtin_amdgcn_fence(__ATOMIC_ACQUIRE, "agent"); asm volatile("s_waitcnt vmcnt(0)" ::: "memory"); }
        __syncthreads(); }
    for (int it = 0;; ++it) {
        if (C.tid() == 0) *itemw = (int)atomicAdd(q, 1u);
        __syncthreads();
        const int k = *itemw;
        __syncthreads();
        if (k >= 512) break;
#ifndef NO_NSA
        nsa_item(p, C, (k & 15) >> 1, k & 1, 31 - (k >> 4));
#endif
#ifdef PROBE_T
        if (blockIdx.x == 255 && C.tid() == 0 && it == 0) ts[23] = __builtin_amdgcn_s_memrealtime();
#endif
    }
#ifdef GDN_LAST
    if (blockIdx.x < 64) { const int item = blockIdx.x; gdn_item(p, C, item >> 3, item & 7); }
#endif
}
#ifndef MK_N_LAUNCHES
#define MK_N_LAUNCHES 1
#endif
constexpr int N_PHASES = 19;
constexpr int LDS_TILEE = LDS_SCR + 16 * 1024;

#define XB_TMO      128
#define XB_XCNT(j)  (256  + 64 * (j))
#define XB_XSUB(j)  (1280 + 64 * (j))
#define XB_XGEN(j)  (2304 + 64 * (j))
#define XB_TOP      3328
#define XB_TOPGEN   3392
#define XCD_BAR_WORDS 3456
#define XB_SPIN_CAP (1u << 20)
__device__ __forceinline__ unsigned xb_ld(unsigned* p)              { return __hip_atomic_load(p, __ATOMIC_RELAXED, __HIP_MEMORY_SCOPE_AGENT); }
__device__ __forceinline__ unsigned xb_add(unsigned* p, unsigned v) { return __hip_atomic_fetch_add(p, v, __ATOMIC_RELAXED, __HIP_MEMORY_SCOPE_AGENT); }
__device__ __forceinline__ unsigned xb_xcc_id() { return (unsigned)__builtin_amdgcn_s_getreg((3 << 11) | 20) & 0xFu; }
#define XB_SPIN(cond, bar) do { unsigned _sp = 0; while (cond) { __builtin_amdgcn_s_sleep(1); \
    if ((++_sp & 255u) == 0u) { if (xb_ld(&(bar)[XB_TMO])) break; if (_sp > XB_SPIN_CAP) { atomicAdd(&(bar)[XB_TMO], 1u); break; } } } } while (0)
struct XcdBarrier { unsigned* bar; unsigned x; volatile LAS unsigned* st; };
__device__ __forceinline__ XcdBarrier xcd_barrier_post(unsigned* bar, volatile LAS unsigned* st, int tid) {
    XcdBarrier b; b.bar = bar; b.x = xb_xcc_id(); b.st = st;
    if (tid == 0) (void)xb_add(&bar[XB_XCNT(b.x)], 1u);
    return b;
}
__device__ __forceinline__ void xcd_barrier_complete(unsigned* bar, unsigned x, unsigned& nloc, unsigned& nx) {
    const unsigned G = gridDim.x;
    unsigned sum, cnt, mine, sp = 0u;
    for (;;) {
        sum = 0u; cnt = 0u; mine = 0u;
#pragma unroll
        for (unsigned j = 0; j < 16; ++j) { const unsigned c = xb_ld(&bar[XB_XCNT(j)]); sum += c; cnt += (c > 0u) ? 1u : 0u; mine = (j == x) ? c : mine; }
        if (sum == G) break;
        __builtin_amdgcn_s_sleep(1);
        if ((++sp & 255u) == 0u) { if (xb_ld(&bar[XB_TMO])) break; if (sp > XB_SPIN_CAP) { atomicAdd(&bar[XB_TMO], 1u); break; } }
    }
    nloc = mine > 0u ? mine : 1u; nx = cnt > 0u ? cnt : 1u;
}
__device__ __forceinline__ void xcd_barrier(const XcdBarrier& b, int tid) {
    asm volatile("s_waitcnt vmcnt(0)" ::: "memory");
    __syncthreads();
    if (tid == 0) {
        unsigned* bar = b.bar;
        __builtin_amdgcn_s_waitcnt(0);
        unsigned nloc = b.st[0], nx = b.st[1];
        if (nloc == 0u) { xcd_barrier_complete(bar, b.x, nloc, nx); b.st[0] = nloc; b.st[1] = nx; }
        const unsigned old = xb_add(&bar[XB_XSUB(b.x)], 1u);
        const unsigned gen = old / nloc;
        if (old + 1u == (gen + 1u) * nloc) {
            __builtin_amdgcn_fence(__ATOMIC_RELEASE, "agent");
            asm volatile("s_waitcnt vmcnt(0)" ::: "memory");
            const unsigned og = xb_add(&bar[XB_TOP], 1u);
            const unsigned tg = og / nx;
            if (og + 1u == (tg + 1u) * nx) xb_add(&bar[XB_TOPGEN], 1u);
            else XB_SPIN(xb_ld(&bar[XB_TOPGEN]) == tg, bar);
            __builtin_amdgcn_fence(__ATOMIC_ACQUIRE, "agent");
            xb_add(&bar[XB_XGEN(b.x)], 1u);
            asm volatile("s_waitcnt vmcnt(0)" ::: "memory");
        } else {
            XB_SPIN(xb_ld(&bar[XB_XGEN(b.x)]) == gen, bar);
            __builtin_amdgcn_fence(__ATOMIC_ACQUIRE, "agent");
            asm volatile("s_waitcnt vmcnt(0)" ::: "memory");
        }
    }
    __syncthreads();
}
constexpr int LDS_MISC = LDS_BYTES - 256;

__global__ void __launch_bounds__(NTHREADS, 2) mega_fwd(Params p) {
    extern __shared__ __attribute__((aligned(16))) unsigned char lds_raw[];
    Ctx C; C.wave = __builtin_amdgcn_readfirstlane((int)threadIdx.x >> 6); C.gw = blockIdx.x * NWAVES + C.wave; C.ngw = gridDim.x * NWAVES; C.lds = (LAS unsigned char*)lds_raw;
    const int G = gridDim.x, bx = blockIdx.x;
    const __attribute__((address_space(4))) Params* kp = (const __attribute__((address_space(4))) Params*)__builtin_amdgcn_kernarg_segment_ptr();
#define PP() (*({ const __attribute__((address_space(4))) Params* q_ = kp; asm volatile("" : "+s"(q_)); (const Params*)q_; }))
    unsigned char* ws = PP().ws; unsigned char* dout = (unsigned char*)PP().out;
    LAS unsigned char* lds = C.lds;
#ifndef DOUBLE_PHASE
#define DOUBLE_PHASE -1
#endif
#define REP(k) for (int rep_ = 0; rep_ < ((k) == DOUBLE_PHASE ? 2 : 1); ++rep_)
#ifdef ONLY_PHASE
#define IN(k) ((k) == ONLY_PHASE)
#else
#define IN(k) (p.ph_lo <= (k) && (k) < p.ph_hi)
#endif
#ifdef PROBE_T
#define SEAM(k) do { if (IN(k) && IN((k) + 1)) xcd_barrier(bar, C.tid()); if (blockIdx.x == 0 && C.tid() == 0) __hip_atomic_store((unsigned long long*)(ws + WS_CTL + 49152) + (k) + 1, __builtin_amdgcn_s_memrealtime(), __ATOMIC_RELAXED, __HIP_MEMORY_SCOPE_AGENT); if ((k) == 17) xcd_barrier(bar, C.tid()); } while (0)
#else
#ifdef DOUBLE_BARRIER
#define SEAM(k) do { if (IN(k) && IN((k) + 1)) { xcd_barrier(bar, C.tid()); xcd_barrier(bar, C.tid()); } } while (0)
#else
#define SEAM(k) do { if (IN(k) && IN((k) + 1)) xcd_barrier(bar, C.tid()); } while (0)
#endif
#endif
    volatile LAS unsigned* misc = (volatile LAS unsigned*)(lds + LDS_MISC);
    { const int t_ = C.tid(); if (t_ < 64) misc[t_] = 0u; }
    __syncthreads();
    XcdBarrier bar; bar.bar = (unsigned*)(ws + WS_CTL) + CW_BAR; bar.x = 0; bar.st = misc;
    if (p.ph_hi - p.ph_lo > 1) bar = xcd_barrier_post((unsigned*)(ws + WS_CTL) + CW_BAR, misc, C.tid());
#ifdef PROBE_T
    if (blockIdx.x == 0 && C.tid() == 0) __hip_atomic_store((unsigned long long*)(ws + WS_CTL + 49152), __builtin_amdgcn_s_memrealtime(), __ATOMIC_RELAXED, __HIP_MEMORY_SCOPE_AGENT);
#endif

    if (IN(0)) REP(0) phase0(PP(), C);
    SEAM(0);
    if (IN(1)) REP(1) {
        { ProbDense P = mk_dense(dout + DO_XB, ws + WS_W1T, 1024, 1024, 1024); pg8::StaticOrder S; S.init(NTOK, 6656, G, bx); EpiProj1 E{ws, dout, PP().positions}; pg8::gemm_phase(lds, C.wave, P, S, E); }
        { ProbDense P = mk_dense(ws + WS_FREE, ws + WS_WKVT, 1024, 1024, 1024); pg8::StaticOrder S; S.init(2048, 2048, 64, (bx >= 128 && bx < 192) ? bx - 128 : -1);
          EpiKvx E{(bf16_t*)(ws + WS_KX), (bf16_t*)(ws + WS_VT)}; pg8::gemm_phase(lds, C.wave, P, S, E); }
        { ProbDense P = mk_dense(dout + DO_XB, ws + WS_W1T + (size_t)6656 * 2048, 1024, 1024, 1024); pg8::StaticOrder S; S.init(NTOK, 256, 64, bx >= 192 ? bx - 192 : -1);
          EpiSmall E{(float*)(ws + WS_LG)}; pg8::gemm_phase(lds, C.wave, P, S, E); }
    }
    SEAM(1);
    if (IN(3)) {
        if (DOUBLE_PHASE == 33 && bx >= 128) conv_pass(PP(), C, (bx - 128) * 8 + C.wave, 1024, 2, false);
        if (bx >= 128) conv_pass(PP(), C, (bx - 128) * 8 + C.wave, 1024, 2); }
    if (IN(3)) {
        unsigned* crdy = (unsigned*)(ws + WS_CTL) + CW_CMP;
        { ProbCompress P; P.KV = (const char*)(ws + WS_KV); P.W = (const char*)(ws + WS_WC1T); P.ldb = 4096 * 2; P.K = 512;
          CmpOrder S; S.init(16, 8, 1, 128, bx < 128 ? bx : -1); S.ready = crdy; S.wave = C.wave; EpiPart E{(bf16_t*)(ws + WS_PART)}; pg8::gemm_phase(lds, C.wave, P, S, E); }
        if (bx < 128) conv_pass(PP(), C, 2048 + bx * 8 + C.wave, 1024, 1);
        else { const int q = bx - 128, cj = q >> 6, cpm = (q >> 3) & 7;
            wg_wait_count(crdy + 16 * (cj * 8 + cpm), 8u, C.wave); combine_rows(PP(), C, cj, 256 * cpm + 32 * (q & 7), 32); }
    }
    SEAM(3);
    if (IN(5)) {
        { ProbDense P = mk_dense(ws + WS_HID, ws + WS_WC2T, 256, 256, 256); P.as1 = (size_t)2048 * 256 * 2; P.bs1 = (size_t)65536 * 2;
          Cmp2Order S; S.init(2, 8, 1, G, bx); S.ready = (unsigned*)(ws + WS_CTL) + CW_C2RDY; S.wave = C.wave; EpiCmp2 E{(bf16_t*)(ws + WS_CMPK)}; pg8::gemm_phase(lds, C.wave, P, S, E); }
        __syncthreads();
        phase_tprep(PP(), C); __syncthreads();
        if (C.tid() == 0) __hip_atomic_fetch_add((unsigned*)(ws + WS_CTL) + CW_GRDY + 16 * (bx >> 2), 1u, __ATOMIC_RELAXED, __HIP_MEMORY_SCOPE_AGENT); }
    if (IN(6)) phase_mixer(PP(), C);
    SEAM(6);
    if (IN(7)) REP(7) {
        phase_moe_weights(PP(), C);
        __syncthreads();
        ProbDense P = mk_dense(dout + DO_XB, ws + WS_W2T, 1024, 1024, 1024); pg8::StaticOrder S; S.init(NTOK, 2048, G, bx);
        EpiMerge E{(const bf16_t*)(ws + WS_Z), (const bf16_t*)(dout + DO_NQ), (bf16_t*)(ws + WS_FREE), (const float*)(ws + WS_SS)}; pg8::gemm_phase(lds, C.wave, P, S, E);
    }
    if (IN(7)) {
        { ProbDense P = mk_dense(ws + WS_KX, ws + WS_WQT, 1024, 1024, 256); P.gsh = 2; P.as1 = (size_t)256 * 2048; P.as2 = 512; P.bs1 = 0; P.bs2 = 512;
          pg8::GroupOrder S; S.init(32, 1, 4, 128, bx < 128 ? bx : -1); EpiStoreBf16 E{(bf16_t*)(ws + WS_H), 1024, 0, (size_t)256 * 1024, 0, 0.0625f}; pg8::gemm_phase(lds, C.wave, P, S, E); }
        { ProbDense P = mk_dense(ws + WS_WXOT, ws + WS_VT, 1024, 1024, 256); P.gsh = 2; P.as1 = 0; P.as2 = 512; P.bs1 = (size_t)256 * 2048; P.bs2 = 512;
          pg8::GroupOrder S; S.init(32, 4, 1, 128, bx >= 128 ? bx - 128 : -1); EpiStoreBf16 E{(bf16_t*)(ws + WS_H) + (size_t)8 * 1024 * 1024, 1024, 2, (size_t)1024 * 1024, 256, 1.f}; pg8::gemm_phase(lds, C.wave, P, S, E); }
    }
    SEAM(7);
    if (IN(8) && DOUBLE_PHASE == 80) { ProbDense P = mk_dense(ws + WS_FREE, ws + WS_WOT, 1024, 1024, 1024); pg8::StaticOrder S; S.init(NTOK, 1024, G, bx);
        EpiStoreBf16 E{(bf16_t*)(ws + WS_Z), 1024, 0, 0, 0, 1.f}; pg8::gemm_phase(lds, C.wave, P, S, E); xcd_barrier(bar, C.tid()); }
    unsigned* pan = (unsigned*)(ws + WS_CTL) + CW_PAN;
    if (IN(8)) REP(8) { ProbDense P = mk_dense(ws + WS_FREE, ws + WS_WOT, 1024, 1024, 1024); PanelStatic S; S.init(NTOK, 1024, G, bx); S.wait = nullptr; S.pub = pan; S.wave = C.wave;
        EpiLnFused E{nullptr, (const bf16_t*)(dout + DO_XB), DN_ALPHA, PP().in[13], PP().in[14], (bf16_t*)(ws + WS_HB), (unsigned long long*)(ws + WS_XBUF), (unsigned*)(ws + WS_CTL) + CW_LNX + 8192 * rep_}; pg8::gemm_phase(lds, C.wave, P, S, E); }
    if (IN(10)) REP(10) {
        ProbDense P = mk_dense(ws + WS_HB, ws + WS_H, 1024, 1024, 1024); P.gsh = 2; P.as1 = (size_t)2048 * 2048; P.as2 = 0; P.bs1 = (size_t)4 * 256 * 2048; P.bs2 = (size_t)256 * 2048;
        PanelScore S{bx, pan, pan + 1024, C.wave}; EpiSoftmax E{(bf16_t*)(dout + DO_NQ)}; pg8::gemm_phase(lds, C.wave, P, S, E); }
    if (IN(13)) REP(13) { ProbBatchB P; P.A = (const char*)(dout + DO_NQ); P.Bt = (const char*)(ws + WS_H) + (size_t)16 * MiB; P.lda = 2048; P.ldb = 2048; P.K = 1024; P.bstride = (size_t)1024 * 2048;
        PanelStatic S; S.init(NTOK, 1024, G, bx); S.wait = pan + 1024; S.pub = pan + 2048; S.wave = C.wave;
        EpiLnFused E{nullptr, (const bf16_t*)(ws + WS_HB), DN_ALPHA, PP().in[18], PP().in[19], (bf16_t*)(ws + WS_HB), (unsigned long long*)(ws + WS_XBUF) + (size_t)NTOK * 4, (unsigned*)(ws + WS_CTL) + CW_LNX + 4096 + 8192 * rep_}; pg8::gemm_phase(lds, C.wave, P, S, E); }
    if (IN(14)) { const int tb = 32 * (bx & 7) + (bx >> 3);
        Ctx D = C; D.gw = tb * NWAVES + C.wave; wg_wait_count(pan + 2048 + 16 * (tb >> 2), 4u, C.wave); phase_ln2_router(PP(), D, true); }
    SEAM(14);
    LAS int* tinfo = (LAS int*)(lds + LDS_TILEE + 1024);
    if (IN(16)) moe_tables(PP(), C, (LAS int*)(lds + LDS_TILEE), tinfo);
    if (IN(16)) {
        unsigned* rdy = (unsigned*)(ws + WS_CTL) + CW_RDY;
        { ProbGather P; P.A = (const char*)(ws + WS_HB); P.list = (const int*)(ws + WS_LIST); P.tinfo = tinfo; P.W = (const char*)(ws + WS_WGUT); P.lda = 2048; P.ldb = 2048; P.K = 1024; P.bstride = (size_t)512 * 1024 * 2;
          MoeUpOrder S{(const LAS int*)(lds + LDS_TILEE), G, bx, rdy, C.wave}; EpiGateUp E{(bf16_t*)(ws + WS_HG)}; pg8::gemm_phase(lds, C.wave, P, S, E); }
        { ProbExpertDense P; P.A = (const char*)(ws + WS_HG); P.W = (const char*)(ws + WS_WDT); P.lda = 512; P.ldb = 512; P.K = 256; P.bstride = (size_t)1024 * 256 * 2;
          MoeDownOrder S{(const LAS int*)(lds + LDS_TILEE), G, bx, rdy, C.wave}; EpiDown E{(const int*)(ws + WS_LIST), (const float*)(ws + WS_LISTW), tinfo, (bf16_t*)(ws + WS_Y0), (bf16_t*)(ws + WS_Y1)}; pg8::gemm_phase(lds, C.wave, P, S, E); }
    }
    SEAM(17);
    if (IN(18)) REP(18) phase_final(PP(), C);
#undef IN
#undef SEAM
}

extern "C" void kernel_launch(void* const* d_in, const int* in_sizes, int n_in, void* d_out, int out_size, void* d_ws, size_t ws_size, hipStream_t stream) {
    static int grid = 0;
    if (grid == 0) {
        if (n_in != 29 || out_size != NTOK * DM || ws_size < WS_END) { fprintf(stderr, "kernel_launch: unexpected shapes (n_in %d out %d ws %zu)\n", n_in, out_size, ws_size); grid = -1; return; }
        int dev = 0, cus = 0, per_cu = 0;
        hipGetDevice(&dev); hipDeviceGetAttribute(&cus, hipDeviceAttributeMultiprocessorCount, dev);
        if (hipFuncSetAttribute((const void*)mega_fwd, hipFuncAttributeMaxDynamicSharedMemorySize, LDS_BYTES) != hipSuccess) { fprintf(stderr, "kernel_launch: hipFuncSetAttribute failed\n"); }
        if (hipOccupancyMaxActiveBlocksPerMultiprocessor(&per_cu, (const void*)mega_fwd, NTHREADS, LDS_BYTES) != hipSuccess || per_cu < 1) { fprintf(stderr, "kernel_launch: occupancy query says %d\n", per_cu); per_cu = 1; }
        (void)hipGetLastError();
        grid = cus;
    }
    if (grid < 0) return;
    (void)hipMemsetAsync((char*)d_ws + WS_CTL, 0, 128 * 1024, stream);
    Params p{};
    for (int i = 0; i < 29; ++i) p.in[i] = (const float*)d_in[i];
    p.positions = (const int*)d_in[2]; p.out = (float*)d_out; p.ws = (unsigned char*)d_ws;
    for (int li = 0; li < MK_N_LAUNCHES; ++li) {
        p.ph_lo = (MK_N_LAUNCHES == 1) ? 0 : li; p.ph_hi = (MK_N_LAUNCHES == 1) ? N_PHASES : li + 1;
        void* args[] = {&p};
        hipError_t e = hipLaunchCooperativeKernel((const void*)mega_fwd, dim3(grid), dim3(NTHREADS), args, LDS_BYTES, stream);
        if (e != hipSuccess) { fprintf(stderr, "kernel_launch: cooperative launch %d failed: %s (grid %d)\n", li, hipGetErrorString(e), grid); break; }
    }
}
```

```cpp
#include <hip/hip_runtime.h>
#include <cstdio>
#include <cstdint>

#define LAS __attribute__((address_space(3)))
typedef unsigned short bf16_t;
typedef short bf16x8 __attribute__((ext_vector_type(8)));
typedef short s16x4 __attribute__((ext_vector_type(4)));
typedef float f32x2 __attribute__((ext_vector_type(2)));
typedef float f32x4 __attribute__((ext_vector_type(4)));
typedef float f32x16 __attribute__((ext_vector_type(16)));
typedef unsigned u32x2 __attribute__((ext_vector_type(2)));
typedef unsigned u32x4 __attribute__((ext_vector_type(4)));
typedef __bf16 bf16x2_t __attribute__((ext_vector_type(2)));

__device__ __forceinline__ unsigned cvtpk(float lo, float hi) { f32x2 v = {lo, hi}; bf16x2_t b = __builtin_convertvector(v, bf16x2_t); return __builtin_bit_cast(unsigned, b); }
__device__ __forceinline__ float bflo(unsigned u) { return __uint_as_float(u << 16); }
__device__ __forceinline__ float bfhi(unsigned u) { return __uint_as_float(u & 0xffff0000u); }
__device__ __forceinline__ float bf2f(bf16_t h) { return __uint_as_float(((unsigned)h) << 16); }
__device__ __forceinline__ bf16_t f2bf(float f) { return (bf16_t)(cvtpk(f, 0.f) & 0xffffu); }
__device__ __forceinline__ float sigmoidf_(float x) { return __builtin_amdgcn_rcpf(1.f + __expf(-x)); }
__device__ __forceinline__ float siluf_(float x) { return x * __builtin_amdgcn_rcpf(1.f + __expf(-x)); }
template <int CTRL> __device__ __forceinline__ float dpp_f(float v) { return __int_as_float(__builtin_amdgcn_update_dpp(0, __float_as_int(v), CTRL, 0xF, 0xF, true)); }
__device__ __forceinline__ float sum4(float v) { v += dpp_f<0xB1>(v); v += dpp_f<0x4E>(v); return v; }
__device__ __forceinline__ float sum8(float v) { v = sum4(v); v += dpp_f<0x141>(v); return v; }
__device__ __forceinline__ float sum16(float v) { v = sum8(v); v += dpp_f<0x140>(v); return v; }
__device__ __forceinline__ float rdlane(float v, int l) { return __int_as_float(__builtin_amdgcn_readlane(__float_as_int(v), l)); }
__device__ __forceinline__ float wave_sum(float v) {
    v = sum16(v);
    v += __int_as_float(__builtin_amdgcn_update_dpp(0, __float_as_int(v), 0x142, 0xA, 0xF, false));
    v += __int_as_float(__builtin_amdgcn_update_dpp(0, __float_as_int(v), 0x143, 0xC, 0xF, false));
    return rdlane(v, 63);
}
__device__ __forceinline__ float xor32_sum(float v) { auto rr = __builtin_amdgcn_permlane32_swap(__float_as_uint(v), __float_as_uint(v), false, false); return __uint_as_float(rr[0]) + __uint_as_float(rr[1]); }
__device__ __forceinline__ float xor16_sum(float v) { auto rr = __builtin_amdgcn_permlane16_swap(__float_as_uint(v), __float_as_uint(v), false, false); return __uint_as_float(rr[0]) + __uint_as_float(rr[1]); }
__device__ __forceinline__ float xor16_max(float v) { auto rr = __builtin_amdgcn_permlane16_swap(__float_as_uint(v), __float_as_uint(v), false, false); return fmaxf(__uint_as_float(rr[0]), __uint_as_float(rr[1])); }
__device__ __forceinline__ float xor32_max(float v) { auto rr = __builtin_amdgcn_permlane32_swap(__float_as_uint(v), __float_as_uint(v), false, false); return fmaxf(__uint_as_float(rr[0]), __uint_as_float(rr[1])); }
__device__ __forceinline__ float xor32_get(float v, int hi) { auto rr = __builtin_amdgcn_permlane32_swap(__float_as_uint(v), __float_as_uint(v), false, false); return hi ? __uint_as_float(rr[0]) : __uint_as_float(rr[1]); }
__device__ __forceinline__ int lane_id() { int l = (int)__builtin_amdgcn_mbcnt_hi(~0u, __builtin_amdgcn_mbcnt_lo(~0u, 0u)); asm volatile("" : "+v"(l)); return l; }
#define LDS_WAIT() asm volatile("s_waitcnt lgkmcnt(0)" ::: "memory")
#define RAW_BAR() do { asm volatile("s_waitcnt lgkmcnt(0)" ::: "memory"); __builtin_amdgcn_s_barrier(); asm volatile("" ::: "memory"); } while (0)

namespace pg8 {
constexpr int BM = 256, BK = 64, HALF = 128, HTB = HALF * BK * 2, STAGE_BYTES = 8 * HTB, NXCD = 8, WGM = 8;
__host__ __device__ __forceinline__ int lds_byte(int r, int c) { const int st = (r >> 4) * 2 + (c >> 5), rr = r & 15, cc = c & 31, ob = rr * 64 + cc * 2; return st * 1024 + (ob ^ (((ob >> 9) & 1) << 5)); }
__host__ __device__ __forceinline__ void stage_rc(int b, int& R, int& C) { const int st = b / 1024, sb = b % 1024, swz = sb ^ (((sb >> 9) & 1) << 5); R = (st >> 1) * 16 + swz / 64; C = (st & 1) * 32 + (swz % 64) / 2; }
__host__ __device__ __forceinline__ int perm32(int rho) { const int n = rho >> 4, i = rho & 15; return 8 * (i >> 2) + 4 * n + (i & 3); }

struct Unit { int pm, pn, g; };

struct StaticOrder {
    int nM, nN, nwg, G, c;
    __device__ void init(int M, int N, int G_, int c_) { nM = M / BM; nN = N / BM; nwg = nM * nN; G = G_; c = c_; }
    __device__ bool next(int i, Unit& u) const {
        if (c < 0) return false;
        const long L = (long)i * G + c; if (L >= nwg) return false;
        int wgid = (int)L; { const int q = nwg / NXCD, r = nwg % NXCD, xcd = wgid % NXCD, off = wgid / NXCD; wgid = (xcd < r ? xcd * (q + 1) : r * (q + 1) + (xcd - r) * q) + off; }
        const int nig = WGM * nN, gid = wgid / nig, fm = gid * WGM, gsz = (nM - fm) < WGM ? (nM - fm) : WGM;
        u.pm = fm + ((wgid % nig) % gsz); u.pn = (wgid % nig) / gsz; u.g = 0; return true;
    }
    __device__ __forceinline__ void a_ready(const Unit&) const {}
    __device__ __forceinline__ void done(const Unit&) const {}
};
struct GroupOrder {
    int nM, nN, ng, G, c;
    __device__ void init(int ng_, int nM_, int nN_, int G_, int c_) { ng = ng_; nM = nM_; nN = nN_; G = G_; c = c_; }
    __device__ bool next(int i, Unit& u) const {
        if (c < 0) return false;
        const long L = (long)i * G + c; if (L >= (long)ng * nM * nN) return false;
        const int per = nM * nN; u.g = (int)(L / per); const int r = (int)(L % per); u.pm = r / nN; u.pn = r % nN; return true;
    }
    __device__ __forceinline__ void a_ready(const Unit&) const {}
    __device__ __forceinline__ void done(const Unit&) const {}
};

template <class Prob, class Epi, class Sched>
__device__ __forceinline__ void gemm_phase(LAS unsigned char* lds, int wid, const Prob& P, const Sched& S, const Epi& E) {
    const int lane = lane_id(), tid = wid * 64 + lane, wr = wid >> 2, wc = wid & 3, fr = lane & 15, fq = lane >> 4;
    const int nt = P.K / BK;
    int Rp[2], Cp[2];
    unsigned voffB[2];
#pragma unroll
    for (int i = 0; i < 2; ++i) { stage_rc(tid * 16 + i * 8192, Rp[i], Cp[i]); const int Rb = Epi::PERM ? ((Rp[i] & ~31) + perm32(Rp[i] & 31)) : Rp[i]; voffB[i] = (unsigned)(Rb * P.ldb + Cp[i] * 2); }
    const size_t kstep = (size_t)(BK * 2);
    const size_t hstepB = (size_t)HALF * P.ldb;
    const unsigned ldsw = (unsigned)wid * 1024u;
    const int aoff = lds_byte(wr * 64 + fr, fq * 8), boff = lds_byte(wc * 32 + fr, fq * 8);
#define PG8_SA(b, h) (((b) * 2 + (h)) * HTB)
#define PG8_SB(b, h) ((4 + (b) * 2 + (h)) * HTB)
#define PG8_STAGEB(bufoff, gbase) do { _Pragma("unroll") for (int _i = 0; _i < 2; ++_i) \
        __builtin_amdgcn_global_load_lds((const unsigned*)((const char*)(gbase) + voffB[_i]), (LAS unsigned*)(lds + (bufoff) + ldsw + _i * 8192), 16, 0, 0); } while (0)
#define PG8_STAGEA(bufoff, gbase, v0, v1) do { \
        __builtin_amdgcn_global_load_lds((const unsigned*)((const char*)(gbase) + (v0)), (LAS unsigned*)(lds + (bufoff) + ldsw), 16, 0, 0); \
        __builtin_amdgcn_global_load_lds((const unsigned*)((const char*)(gbase) + (v1)), (LAS unsigned*)(lds + (bufoff) + ldsw + 8192), 16, 0, 0); } while (0)
#define PG8_LDA(dst, b, h) do { _Pragma("unroll") for (int m = 0; m < 4; ++m) _Pragma("unroll") for (int k = 0; k < 2; ++k) dst[m][k] = *(const LAS bf16x8*)(lds + PG8_SA(b, h) + aoff + m * 2048 + k * 1024); } while (0)
#define PG8_LDB(dst, b, h) do { _Pragma("unroll") for (int n = 0; n < 2; ++n) _Pragma("unroll") for (int k = 0; k < 2; ++k) dst[n][k] = *(const LAS bf16x8*)(lds + PG8_SB(b, h) + boff + n * 2048 + k * 1024); } while (0)
#define PG8_MMA(ai, bj, At, Bt) do { __builtin_amdgcn_s_setprio(1); _Pragma("unroll") for (int m = 0; m < 4; ++m) _Pragma("unroll") for (int n = 0; n < 2; ++n) _Pragma("unroll") for (int k = 0; k < 2; ++k) \
        acc[ai][bj][m][n] = __builtin_amdgcn_mfma_f32_16x16x32_bf16(Bt[n][k], At[m][k], acc[ai][bj][m][n], 0, 0, 0); __builtin_amdgcn_s_setprio(0); } while (0)
#define PG8_WAIT_V(n) asm volatile("s_waitcnt vmcnt(" #n ")" ::: "memory")
#define PG8_WAIT_L(n) asm volatile("s_waitcnt lgkmcnt(" #n ")" ::: "memory")
#define PG8_BAR __builtin_amdgcn_s_barrier()
#define PG8_SCHED __builtin_amdgcn_sched_barrier(0)
    Unit cur, nxt; int ui = 0;
    if (!S.next(0, cur)) return;
    f32x4 acc[2][2][4][2];
#pragma unroll
    for (int a = 0; a < 2; ++a)
#pragma unroll
        for (int b = 0; b < 2; ++b)
#pragma unroll
            for (int m = 0; m < 4; ++m)
#pragma unroll
                for (int n = 0; n < 2; ++n) acc[a][b][m][n] = (f32x4){0.f, 0.f, 0.f, 0.f};
    bf16x8 At[4][2], B0[2][2], B1[2][2];
    S.a_ready(cur);
    const char* cA = P.a_base(cur); const char* cB = P.b_base(cur);
    unsigned vc00, vc01, vc10, vc11, vn00, vn01, vn10, vn11;
    vc00 = P.a_rowoff(cur, Rp[0]) + Cp[0] * 2; vc01 = P.a_rowoff(cur, Rp[1]) + Cp[1] * 2;
    vc10 = P.a_rowoff(cur, HALF + Rp[0]) + Cp[0] * 2; vc11 = P.a_rowoff(cur, HALF + Rp[1]) + Cp[1] * 2;
    {
        PG8_STAGEB(PG8_SB(0, 0), cB); PG8_STAGEB(PG8_SB(0, 1), cB + hstepB); PG8_STAGEA(PG8_SA(0, 0), cA + P.a_koff(0), vc00, vc01); PG8_STAGEA(PG8_SA(0, 1), cA + P.a_koff(0), vc10, vc11);
        if (wr == 1) PG8_BAR;
        PG8_WAIT_V(2); PG8_BAR;
        PG8_STAGEB(PG8_SB(1, 0), cB + kstep); PG8_STAGEA(PG8_SA(1, 0), cA + P.a_koff(1), vc00, vc01); PG8_STAGEB(PG8_SB(1, 1), cB + hstepB + kstep);
        PG8_WAIT_V(6); PG8_BAR;
    }
    for (;;) {
        const bool has_next = S.next(ui + 1, nxt);
        const char* nA = has_next ? P.a_base(nxt) : cA; const char* nB = has_next ? P.b_base(nxt) : cB;
        if (Prob::UNIT_DEP && has_next) {
            vn00 = P.a_rowoff(nxt, Rp[0]) + Cp[0] * 2; vn01 = P.a_rowoff(nxt, Rp[1]) + Cp[1] * 2;
            vn10 = P.a_rowoff(nxt, HALF + Rp[0]) + Cp[0] * 2; vn11 = P.a_rowoff(nxt, HALF + Rp[1]) + Cp[1] * 2;
        } else { vn00 = vc00; vn01 = vc01; vn10 = vc10; vn11 = vc11; }
        for (int t = 0; t < nt; t += 2) {
            const bool last = (t == nt - 2);
            if (last && has_next) S.a_ready(nxt);
            const char* a1 = cA + P.a_koff(t + 1);
            const char* a2 = last ? nA + P.a_koff(0) : cA + P.a_koff(t + 2);
            const char* a3 = last ? nA + P.a_koff(1) : cA + P.a_koff(t + 3);
            const char* b2 = last ? nB : cB + (size_t)(t + 2) * kstep; const char* b3 = b2 + kstep;
            const unsigned w00 = (Prob::UNIT_DEP && last) ? vn00 : vc00, w01 = (Prob::UNIT_DEP && last) ? vn01 : vc01, w10 = (Prob::UNIT_DEP && last) ? vn10 : vc10, w11 = (Prob::UNIT_DEP && last) ? vn11 : vc11;
            PG8_LDB(B0, 0, 0); PG8_LDB(B1, 0, 1); PG8_SCHED; PG8_LDA(At, 0, 0); PG8_STAGEA(PG8_SA(1, 1), a1, vc10, vc11);
            PG8_WAIT_V(8); PG8_WAIT_L(0); PG8_BAR; PG8_MMA(0, 0, At, B0); PG8_MMA(0, 1, At, B1); PG8_BAR; PG8_SCHED;
            PG8_LDA(At, 0, 1); PG8_STAGEB(PG8_SB(0, 0), b2); PG8_STAGEB(PG8_SB(0, 1), b2 + hstepB); PG8_STAGEA(PG8_SA(0, 0), a2, w00, w01);
            PG8_WAIT_V(8); PG8_WAIT_L(0); PG8_BAR; PG8_MMA(1, 0, At, B0); PG8_MMA(1, 1, At, B1); PG8_BAR; PG8_SCHED;
            PG8_LDB(B0, 1, 0); PG8_LDB(B1, 1, 1); PG8_SCHED; PG8_LDA(At, 1, 0); PG8_STAGEA(PG8_SA(0, 1), a2, w10, w11);
            PG8_WAIT_V(8); PG8_WAIT_L(0); PG8_BAR; PG8_MMA(0, 0, At, B0); PG8_MMA(0, 1, At, B1); PG8_BAR; PG8_SCHED;
            PG8_LDA(At, 1, 1); PG8_STAGEB(PG8_SB(1, 0), b3); PG8_STAGEB(PG8_SB(1, 1), b3 + hstepB); PG8_STAGEA(PG8_SA(1, 0), a3, w00, w01);
            PG8_WAIT_V(8); PG8_WAIT_L(0); PG8_BAR; PG8_MMA(1, 0, At, B0); PG8_MMA(1, 1, At, B1); PG8_BAR; PG8_SCHED;
        }
        if (wr == 0) PG8_BAR;
        E(acc, cur, wr, wc, fr, fq, lds + STAGE_BYTES, wid, lane);
        S.done(cur);
        if (!has_next) break;
#pragma unroll
        for (int a = 0; a < 2; ++a)
#pragma unroll
            for (int b = 0; b < 2; ++b)
#pragma unroll
                for (int m = 0; m < 4; ++m)
#pragma unroll
                    for (int n = 0; n < 2; ++n) acc[a][b][m][n] = (f32x4){0.f, 0.f, 0.f, 0.f};
        cur = nxt; cA = nA; cB = nB; vc00 = vn00; vc01 = vn01; vc10 = vn10; vc11 = vn11; ++ui;
        if (wr == 1) PG8_BAR;
    }
    PG8_WAIT_V(0);
    PG8_BAR;
#undef PG8_SA
#undef PG8_SB
#undef PG8_STAGEA
#undef PG8_STAGEB
#undef PG8_LDA
#undef PG8_LDB
#undef PG8_MMA
#undef PG8_WAIT_V
#undef PG8_WAIT_L
#undef PG8_BAR
#undef PG8_SCHED
}

__device__ __forceinline__ void store_tile_bf16(const f32x4 (&acc)[2][2][4][2], bf16_t* tile_base, size_t ld, int wr, int wc, int fr, int fq, float sc) {
#pragma unroll
    for (int ai = 0; ai < 2; ++ai)
#pragma unroll
        for (int m = 0; m < 4; ++m) { bf16_t* rowp = tile_base + (size_t)(ai * HALF + wr * 64 + m * 16 + fr) * ld + wc * 32 + 8 * fq;
#pragma unroll
            for (int bj = 0; bj < 2; ++bj) { const f32x4 v0 = acc[ai][bj][m][0] * sc, v1 = acc[ai][bj][m][1] * sc; u32x4 w; w.x = cvtpk(v0[0], v0[1]); w.y = cvtpk(v0[2], v0[3]); w.z = cvtpk(v1[0], v1[1]); w.w = cvtpk(v1[2], v1[3]);
                *(u32x4*)(rowp + bj * HALF) = w; } }
}
}
constexpr int NTOK = 16384, DM = 1024, SEQ = 2048, NB = 8, INW = 8744;
constexpr int NWAVES = 8, NTHREADS = 512;
constexpr float DN_ALPHA = 1.189207115002721f;
constexpr float LN_EPS = 1e-5f, RMS_EPS = 1e-6f;
constexpr size_t MiB = 1u << 20;
constexpr size_t WS_CTL = 0;
constexpr size_t WS_LG = 1 * MiB;
constexpr size_t WS_WSMALL = 3 * MiB + 512 * 1024;
constexpr size_t WS_WR = WS_WSMALL + 40 * 4096;
constexpr size_t WS_BIASP = WS_WR + 36 * 4096;
constexpr size_t WS_CMPK = 4 * MiB;
constexpr size_t WS_CMPV = 4 * MiB + 512 * 1024;
constexpr size_t WS_HID = 5 * MiB;
constexpr size_t WS_LIST = 4 * MiB;
constexpr size_t WS_LISTW = 6 * MiB;
constexpr int MOE_CAP = 16384;
constexpr int MAXPOS = 40960, MAXTILES = 160;
constexpr size_t WS_KX = 8 * MiB;
constexpr size_t WS_VT = 12 * MiB;
constexpr size_t WS_W1T = 16 * MiB;
constexpr size_t WS_W2T = 29 * MiB + 512 * 1024;
constexpr size_t WS_WC1T = 33 * MiB + 512 * 1024;
constexpr size_t WS_WC2T = 37 * MiB + 512 * 1024;
constexpr size_t WS_WOT = 38 * MiB;
constexpr size_t WS_WQT = WS_WOT + 2 * MiB;
constexpr size_t WS_WKVT = WS_WQT + 2 * MiB;
constexpr size_t WS_WXOT = WS_WKVT + 4 * MiB;
constexpr size_t WS_GQ = 48 * MiB, WS_GK = 80 * MiB, WS_GV = 112 * MiB, WS_Z = 144 * MiB;
constexpr size_t WS_KV = 176 * MiB;
constexpr size_t WS_FREE = 224 * MiB;
constexpr size_t WS_PART = 240 * MiB;
constexpr size_t WS_HALO = 228 * MiB;
constexpr size_t WS_H = 48 * MiB;
constexpr size_t WS_HB = 112 * MiB;
constexpr size_t WS_WGUT = 176 * MiB;
__host__ __device__ constexpr size_t wdt_off(int e) { return e < 22 ? 18 * MiB + 512 * 1024 + (size_t)e * 512 * 1024 : (e < 30 ? 33 * MiB + 512 * 1024 + (size_t)(e - 22) * 512 * 1024 : 42 * MiB + (size_t)(e - 30) * 512 * 1024); }
constexpr size_t WS_HG = 144 * MiB;
constexpr size_t WS_Y0 = 48 * MiB;
constexpr size_t WS_Y1 = 224 * MiB;
constexpr size_t WS_END = 256 * MiB;
constexpr size_t DO_XB = 0, DO_NQ = 32 * MiB;
constexpr int CW_QUEUE = 64;
constexpr int CW_CNT = 8192;
constexpr int CW_BAR = 1024;
constexpr int CW_CMP = 4608;
constexpr int CW_RDY = 5120;
constexpr int CW_PAN = 10240;
constexpr int CW_GRDY = 13312;
constexpr int CW_C2RDY = 14336;
constexpr int CW_LNX = 16384;
constexpr size_t WS_XBUF = WS_LG;

constexpr int LDS_BYTES = 152 * 1024;
constexpr int LDS_SCR = pg8::STAGE_BYTES;

__device__ const float INV_FREQ[64] = {
1.000000000e+00f, 8.659643531e-01f, 7.498942614e-01f, 6.493816376e-01f, 5.623413324e-01f, 4.869675338e-01f, 4.216965139e-01f, 3.651741147e-01f, 3.162277639e-01f, 2.738419771e-01f, 2.371373773e-01f, 2.053525001e-01f, 1.778279394e-01f, 1.539926529e-01f, 1.333521307e-01f, 1.154782027e-01f, 1.000000015e-01f, 8.659642935e-02f, 7.498941571e-02f, 6.493816525e-02f, 5.623413250e-02f, 4.869675264e-02f, 4.216965288e-02f, 3.651741147e-02f, 3.162277490e-02f, 2.738419734e-02f, 2.371373773e-02f, 2.053525113e-02f, 1.778279431e-02f, 1.539926510e-02f, 1.333521493e-02f, 1.154782064e-02f, 9.999999776e-03f, 8.659643121e-03f, 7.498941850e-03f, 6.493816152e-03f, 5.623413250e-03f, 4.869675264e-03f, 4.216964822e-03f, 3.651741194e-03f, 3.162277630e-03f, 2.738419687e-03f, 2.371373586e-03f, 2.053524833e-03f, 1.778279431e-03f, 1.539926510e-03f, 1.333521446e-03f, 1.154781901e-03f, 1.000000047e-03f, 8.659643354e-04f, 7.498942432e-04f, 6.493816618e-04f, 5.623413017e-04f, 4.869675322e-04f, 4.216965172e-04f, 3.651741426e-04f, 3.162277571e-04f, 2.738419571e-04f, 2.371373703e-04f, 2.053525095e-04f, 1.778279402e-04f, 1.539926452e-04f, 1.333521504e-04f, 1.154782003e-04f
};
constexpr double TWO_PI_D = 6.283185307179586476925287, INV_2PI_D = 0.159154943091895335768884;

struct Params {
    const float* in[29];
    const int* positions;
    float* out;
    unsigned char* ws;
    int ph_lo, ph_hi;
};

struct Ctx { int wave, gw, ngw; LAS unsigned char* lds;
    __device__ __forceinline__ int lane() const { return lane_id(); }
    __device__ __forceinline__ int tid() const { return wave * 64 + lane_id(); } };

template <bool ROPEPERM = false> __device__ __forceinline__ void transpose_seg(const Ctx& C, const float* W, int K, int Nsrc, int col0, int cnt, bf16_t* WT, int drow0, int ldd) {
    LAS float* scr = (LAS float*)(C.lds + C.wave * 16384);
    const int nblk = cnt / 32, nitems = (K / 64) * nblk, lane = C.lane();
    for (int item = C.gw; item < nitems; item += C.ngw) {
        const int kb = item / nblk, nb = item % nblk, k0 = 64 * kb, n0 = col0 + 32 * nb;
#pragma unroll 8
        for (int i = 0; i < 32; ++i) { const int kk = 2 * i + (lane >> 5); scr[kk * 33 + (lane & 31)] = W[(size_t)(k0 + kk) * Nsrc + n0 + (lane & 31)]; }
        LDS_WAIT(); asm volatile("" ::: "memory");
        const int c = lane & 7;
#pragma unroll
        for (int j = 0; j < 4; ++j) { const int n = (lane >> 3) + 8 * j; const LAS float* s = scr + (8 * c) * 33 + n;
            u32x4 o; o.x = cvtpk(s[0 * 33], s[1 * 33]); o.y = cvtpk(s[2 * 33], s[3 * 33]); o.z = cvtpk(s[4 * 33], s[5 * 33]); o.w = cvtpk(s[6 * 33], s[7 * 33]);
            int dr = 32 * nb + n; if (ROPEPERM) { const int hc = dr & 127; dr = (dr & ~127) + (hc < 64 ? 2 * hc : 2 * (hc - 64) + 1); }
            *(u32x4*)(WT + (size_t)(drow0 + dr) * ldd + k0 + 8 * c) = o; }
        LDS_WAIT(); asm volatile("" ::: "memory");
    }
}
__device__ __forceinline__ void cvt_rows(const Ctx& C, const float* src, bf16_t* dst, size_t n) {
    const size_t nv = n / 8;
    for (size_t i = (size_t)C.gw * 64 + C.lane(); i < nv; i += (size_t)C.ngw * 64) {
        const f32x4 a = *(const f32x4*)(src + i * 8), b = *(const f32x4*)(src + i * 8 + 4);
        u32x4 o; o.x = cvtpk(a[0], a[1]); o.y = cvtpk(a[2], a[3]); o.z = cvtpk(b[0], b[1]); o.w = cvtpk(b[2], b[3]);
        *(u32x4*)(dst + i * 8) = o;
    }
}
__device__ __forceinline__ void extract_cols_f32(const Ctx& C, const float* W, int K, int Nsrc, int col0, int cnt, float* WT, int drow0) {
    const int total = K * cnt;
    for (int i = C.gw * 64 + C.lane(); i < total; i += C.ngw * 64) { const int k = i / cnt, j = i % cnt; WT[(size_t)(drow0 + j) * K + k] = W[(size_t)k * Nsrc + col0 + j]; }
}
struct ProbDense {
    static constexpr bool UNIT_DEP = false;
    const char* A; const char* Bt; int lda, ldb, K; int gsh; size_t as1, as2, bs1, bs2;
    __device__ __forceinline__ const char* a_base(const pg8::Unit& u) const { return A + (size_t)(u.g >> gsh) * as1 + (size_t)(u.g & ((1 << gsh) - 1)) * as2 + (size_t)u.pm * 256 * lda; }
    __device__ __forceinline__ unsigned a_rowoff(const pg8::Unit&, int r) const { return (unsigned)(r * lda); }
    __device__ __forceinline__ size_t a_koff(int t) const { return (size_t)t * 128; }
    __device__ __forceinline__ const char* b_base(const pg8::Unit& u) const { return Bt + (size_t)(u.g >> gsh) * bs1 + (size_t)(u.g & ((1 << gsh) - 1)) * bs2 + (size_t)u.pn * 256 * ldb; }
};
__device__ __forceinline__ ProbDense mk_dense(const void* A, const void* Bt, int lda_el, int ldb_el, int K) { ProbDense p; p.A = (const char*)A; p.Bt = (const char*)Bt; p.lda = lda_el * 2; p.ldb = ldb_el * 2; p.K = K; p.gsh = 0; p.as1 = p.as2 = p.bs1 = p.bs2 = 0; return p; }

struct ProbBatchB {
    static constexpr bool UNIT_DEP = false;
    const char* A; const char* Bt; int lda, ldb, K; size_t bstride;
    __device__ __forceinline__ const char* a_base(const pg8::Unit& u) const { return A + (size_t)u.pm * 256 * lda; }
    __device__ __forceinline__ unsigned a_rowoff(const pg8::Unit&, int r) const { return (unsigned)(r * lda); }
    __device__ __forceinline__ size_t a_koff(int t) const { return (size_t)t * 128; }
    __device__ __forceinline__ const char* b_base(const pg8::Unit& u) const { return Bt + (size_t)(u.pm >> 3) * bstride + (size_t)u.pn * 256 * ldb; }
};
struct ProbCompress {
    static constexpr bool UNIT_DEP = false;
    const char* KV; const char* W; int ldb, K;
    __device__ __forceinline__ const char* a_base(const pg8::Unit& u) const { return KV + (size_t)(u.g >> 3) * 8 * MiB + (size_t)(u.g & 7) * 4 * 512 + (size_t)u.pm * 2048 * 512; }
    __device__ __forceinline__ unsigned a_rowoff(const pg8::Unit&, int r) const { int n = r & 127; n = n > 126 ? 126 : n; return (unsigned)(n * 16 * 512 + (r >> 7) * 256); }
    __device__ __forceinline__ size_t a_koff(int t) const { return (size_t)(t >> 1) * 512 + (size_t)(t & 1) * 128; }
    __device__ __forceinline__ const char* b_base(const pg8::Unit& u) const { return W + (size_t)(u.g >> 3) * 256 * 4096 * 2 + (size_t)(u.g & 7) * 512 * 2; }
};
__device__ __forceinline__ int moe_entry(const int* list, const LAS int* tinfo, const pg8::Unit& u, int r) {
    const int sl = (u.pm - tinfo[u.g]) * 256 + r; return sl < tinfo[33 + u.g] ? list[u.g * MOE_CAP + sl] : -1;
}
struct ProbGather {
    static constexpr bool UNIT_DEP = true;
    const char* A; const int* list; const LAS int* tinfo; const char* W; int lda, ldb, K; size_t bstride;
    __device__ __forceinline__ const char* a_base(const pg8::Unit&) const { return A; }
    __device__ __forceinline__ unsigned a_rowoff(const pg8::Unit& u, int r) const { int t = moe_entry(list, tinfo, u, r); t = t < 0 ? 0 : (t >> 1); return (unsigned)(t * lda); }
    __device__ __forceinline__ size_t a_koff(int t) const { return (size_t)t * 128; }
    __device__ __forceinline__ const char* b_base(const pg8::Unit& u) const { return W + (size_t)u.g * bstride + (size_t)u.pn * 256 * ldb; }
};
struct ProbExpertDense {
    static constexpr bool UNIT_DEP = false;
    const char* A; const char* W; int lda, ldb, K; size_t bstride;
    __device__ __forceinline__ const char* a_base(const pg8::Unit& u) const { return A + (size_t)u.pm * 256 * lda; }
    __device__ __forceinline__ unsigned a_rowoff(const pg8::Unit&, int r) const { return (unsigned)(r * lda); }
    __device__ __forceinline__ size_t a_koff(int t) const { return (size_t)t * 128; }
    __device__ __forceinline__ const char* b_base(const pg8::Unit& u) const { return W + wdt_off(u.g) + (size_t)u.pn * 256 * ldb; }
};
struct MoeUpOrder {
    const LAS int* tileE; int G, c; unsigned* ready; int wave;
    __device__ bool next(int i, pg8::Unit& u) const {
        const int L = i * G + c, tt = L >> 1; if (tt >= tileE[255]) return false;
        u.pm = tt; u.pn = L & 1; u.g = tileE[tt]; return true;
    }
    __device__ __forceinline__ void a_ready(const pg8::Unit&) const {}
    __device__ __forceinline__ void done(const pg8::Unit& u) const {
        asm volatile("s_waitcnt vmcnt(0)" ::: "memory"); __builtin_amdgcn_s_barrier(); asm volatile("" ::: "memory");
        if (wave == 0 && lane_id() == 0) __hip_atomic_fetch_add(ready + 16 * u.pm, 1u, __ATOMIC_RELAXED, __HIP_MEMORY_SCOPE_AGENT);
    }
};
#ifndef MOE_SLOTS
#define MOE_SLOTS 3
#endif
struct MoeDownOrder {
    const LAS int* tileE; int G, c; const unsigned* ready; int wave;
    __device__ __forceinline__ int cmin(int s, int U1) const { int v = U1 - G * (s / MOE_SLOTS); v = v < 0 ? 0 : v; return v > G ? G : v; }
    __device__ bool next(int i, pg8::Unit& u) const {
        const int T = tileE[255], U1 = 2 * T; const int n1 = c < U1 ? (U1 - c + G - 1) / G : 0; const int s = MOE_SLOTS * n1 + i;
        int k = c - cmin(s, U1);
#pragma unroll 1
        for (int q = 0; q < s; ++q) k += G - cmin(q, U1);
        if (k >= 4 * T) return false;
        u.pm = k >> 2; u.pn = k & 3; u.g = tileE[u.pm]; return true;
    }
    __device__ __forceinline__ void a_ready(const pg8::Unit& u) const {
        if (wave == 0) {
            unsigned sp = 0;
            while ((unsigned)__builtin_amdgcn_readfirstlane(__hip_atomic_load(ready + 16 * u.pm, __ATOMIC_RELAXED, __HIP_MEMORY_SCOPE_AGENT)) < 2u) { __builtin_amdgcn_s_sleep(2); if (++sp > (1u << 22)) break; }
            __builtin_amdgcn_fence(__ATOMIC_ACQUIRE, "agent");
            asm volatile("s_waitcnt vmcnt(0)" ::: "memory");
        }
        asm volatile("" ::: "memory"); __builtin_amdgcn_s_barrier(); asm volatile("" ::: "memory");
    }
    __device__ __forceinline__ void done(const pg8::Unit&) const {}
};

__device__ __forceinline__ void panel_wait(const unsigned* w, int wave) {
    if (wave == 0) { unsigned sp = 0;
        while ((unsigned)__builtin_amdgcn_readfirstlane(__hip_atomic_load(w, __ATOMIC_RELAXED, __HIP_MEMORY_SCOPE_AGENT)) < 4u) { __builtin_amdgcn_s_sleep(2); if (++sp > (1u << 22)) break; }
        __builtin_amdgcn_fence(__ATOMIC_ACQUIRE, "agent");
        asm volatile("s_waitcnt vmcnt(0)" ::: "memory"); }
    asm volatile("" ::: "memory"); __builtin_amdgcn_s_barrier(); asm volatile("" ::: "memory");
}
__device__ __forceinline__ void panel_count(unsigned* p, int wave) {
    asm volatile("s_waitcnt vmcnt(0)" ::: "memory"); __builtin_amdgcn_s_barrier(); asm volatile("" ::: "memory");
    if (wave == 0 && lane_id() == 0) __hip_atomic_fetch_add(p, 1u, __ATOMIC_RELAXED, __HIP_MEMORY_SCOPE_AGENT);
}
struct PanelStatic : pg8::StaticOrder { const unsigned* wait; unsigned* pub; int wave;
    __device__ __forceinline__ void a_ready(const pg8::Unit& u) const { if (wait) panel_wait(wait + 16 * u.pm, wave); }
    __device__ __forceinline__ void done(const pg8::Unit& u) const { if (pub) panel_count(pub + 16 * u.pm, wave); }
};
struct PanelScore { int c; const unsigned* wait; unsigned* pub; int wave;
    __device__ bool next(int i, pg8::Unit& u) const { if (i > 0 || c < 0 || c >= 256) return false; u.g = (c & 7) * 4 + (c >> 6); u.pm = (c >> 3) & 7; u.pn = 0; return true; }
    __device__ __forceinline__ void a_ready(const pg8::Unit& u) const { panel_wait(wait + 16 * ((u.g >> 2) * 8 + u.pm), wave); }
    __device__ __forceinline__ void done(const pg8::Unit& u) const { panel_count(pub + 16 * ((u.g >> 2) * 8 + u.pm), wave); }
};
struct PanelGroup : pg8::GroupOrder { const unsigned* wait; unsigned* pub; int wave;
    __device__ __forceinline__ void a_ready(const pg8::Unit& u) const { if (wait) panel_wait(wait + 16 * ((u.g >> 2) * 8 + u.pm), wave); }
    __device__ __forceinline__ void done(const pg8::Unit& u) const { if (pub) panel_count(pub + 16 * ((u.g >> 2) * 8 + u.pm), wave); }
};

#define EPI_ARGS f32x4 (&acc)[2][2][4][2], const pg8::Unit& u, int wr, int wc, int fr, int fq, LAS unsigned char* scr, int wid, int lane
struct EpiSmall { static constexpr bool PERM = true; float* lg;
    __device__ __forceinline__ void operator()(EPI_ARGS) const {
        if (wc == 0 || (wc == 1 && fq == 0)) {
#pragma unroll
            for (int ai = 0; ai < 2; ++ai)
#pragma unroll
                for (int m = 0; m < 4; ++m) { float* rowp = lg + ((size_t)u.pm * 256 + ai * 128 + wr * 64 + m * 16 + fr) * 40 + wc * 32 + 8 * fq;
                    *(f32x4*)rowp = acc[ai][0][m][0]; *(f32x4*)(rowp + 4) = acc[ai][0][m][1]; } }
    } };
struct EpiProj1 { static constexpr bool PERM = true; unsigned char* ws; unsigned char* dout; const int* pos;
    __device__ __forceinline__ void operator()(EPI_ARGS) const {
        bf16_t* base; size_t ld; int col0;
        if (u.pn < 16) { base = (bf16_t*)(ws + WS_GQ + (size_t)(u.pn >> 2) * 32 * MiB); ld = 1024; col0 = (u.pn & 3) * 256; }
        else if (u.pn < 20) { base = (bf16_t*)(dout + DO_NQ); ld = 1024; col0 = (u.pn - 16) * 256; }
        else { base = (bf16_t*)(ws + WS_KV + (size_t)(u.pn - 20) * 8 * MiB); ld = 256; col0 = 0; }
        const bool roped = (u.pn >= 16 && u.pn < 20) || u.pn == 20 || u.pn == 22 || u.pn == 24;
        if (!roped) { pg8::store_tile_bf16(acc, base + (size_t)u.pm * 256 * ld + col0, ld, wr, wc, fr, fq, 1.f);
            if (u.pn < 12 && fr >= 13) {
                bf16_t* hb = (bf16_t*)(ws + WS_HALO) + (size_t)(fr - 13) * 3072 + u.pn * 256 + wc * 32 + 8 * fq;
#pragma unroll
                for (int ai = 0; ai < 2; ++ai) { bf16_t* rowp = hb + (size_t)(u.pm * 4 + 2 * ai + wr) * 3 * 3072;
#pragma unroll
                    for (int bj = 0; bj < 2; ++bj) { const f32x4 v0 = acc[ai][bj][3][0], v1 = acc[ai][bj][3][1]; u32x4 w; w.x = cvtpk(v0[0], v0[1]); w.y = cvtpk(v0[2], v0[3]); w.z = cvtpk(v1[0], v1[1]); w.w = cvtpk(v1[2], v1[3]);
                        *(u32x4*)(rowp + bj * 128) = w; } } }
            return; }
        const int i0 = 16 * wc + 4 * fq;
#pragma unroll
        for (int ai = 0; ai < 2; ++ai)
#pragma unroll
            for (int m = 0; m < 4; ++m) { const int row = u.pm * 256 + ai * 128 + wr * 64 + m * 16 + fr; const float pf = (float)pos[row];
                float cs[4], sn[4];
#pragma unroll
                for (int q = 0; q < 4; ++q) { const float rv = (pf * INV_FREQ[i0 + q]) * 0.15915494309189535f; const float fr_ = rv - floorf(rv); cs[q] = __builtin_amdgcn_cosf(fr_); sn[q] = __builtin_amdgcn_sinf(fr_); }
                bf16_t* rowp = base + (size_t)row * ld + col0 + i0;
#pragma unroll
                for (int bj = 0; bj < 2; ++bj) { float y1[4], y2[4];
#pragma unroll
                    for (int q = 0; q < 4; ++q) { const float x1 = acc[ai][bj][m][q >> 1][(q & 1) * 2], x2 = acc[ai][bj][m][q >> 1][(q & 1) * 2 + 1]; y1[q] = x1 * cs[q] - x2 * sn[q]; y2[q] = x2 * cs[q] + x1 * sn[q]; }
                    u32x2 w1; w1.x = cvtpk(y1[0], y1[1]); w1.y = cvtpk(y1[2], y1[3]); u32x2 w2; w2.x = cvtpk(y2[0], y2[1]); w2.y = cvtpk(y2[2], y2[3]);
                    *(u32x2*)(rowp + bj * 128) = w1; *(u32x2*)(rowp + bj * 128 + 64) = w2; } }
    } };
struct EpiStoreBf16 { static constexpr bool PERM = true; bf16_t* O; size_t ld; int gsh; size_t s1, s2; float sc;
    __device__ __forceinline__ void operator()(EPI_ARGS) const {
        pg8::store_tile_bf16(acc, O + (size_t)(u.g >> gsh) * s1 + (size_t)(u.g & ((1 << gsh) - 1)) * s2 + (size_t)u.pm * 256 * ld + (size_t)u.pn * 256, ld, wr, wc, fr, fq, sc);
    } };
struct EpiKvx { static constexpr bool PERM = true; bf16_t* Kx; bf16_t* Vx;
    __device__ __forceinline__ void operator()(EPI_ARGS) const {
        pg8::store_tile_bf16(acc, (u.pn < 4 ? Kx : Vx) + (size_t)u.pm * 256 * 1024 + (u.pn & 3) * 256, 1024, wr, wc, fr, fq, 1.f);
    } };
struct EpiPart { static constexpr bool PERM = true; bf16_t* part;
    __device__ __forceinline__ void operator()(EPI_ARGS) const {
        const __amdgpu_buffer_rsrc_t rs = __builtin_amdgcn_make_buffer_rsrc(part, 0, 16 * 2048 * 256 * 2, 0x00020000);
        const unsigned base = (unsigned)((((u.g & 7) * 2 + (u.g >> 3)) * 2048 + u.pm * 256) * 256 * 2);
#pragma unroll
        for (int ai = 0; ai < 2; ++ai)
#pragma unroll
            for (int m = 0; m < 4; ++m) { const unsigned ro = base + (unsigned)(((ai * 128 + wr * 64 + m * 16 + fr) * 256 + wc * 32 + 8 * fq) * 2);
#pragma unroll
                for (int bj = 0; bj < 2; ++bj) { const f32x4 v0 = acc[ai][bj][m][0], v1 = acc[ai][bj][m][1]; u32x4 w; w.x = cvtpk(v0[0], v0[1]); w.y = cvtpk(v0[2], v0[3]); w.z = cvtpk(v1[0], v1[1]); w.w = cvtpk(v1[2], v1[3]);
                    __builtin_amdgcn_raw_buffer_store_b128(w, rs, ro + bj * 256, 0, 16); } }
    } };
struct CmpOrder : pg8::GroupOrder { unsigned* ready; int wave;
    __device__ __forceinline__ void done(const pg8::Unit& u) const { panel_count(ready + 16 * ((u.g >> 3) * 8 + u.pm), wave); }
};
struct EpiCmp2 { static constexpr bool PERM = true; bf16_t* out;
    __device__ __forceinline__ void operator()(EPI_ARGS) const {
        const __amdgpu_buffer_rsrc_t rs = __builtin_amdgcn_make_buffer_rsrc(out, 0, 2 * 2048 * 128 * 2, 0x00020000);
        const unsigned base = (unsigned)((u.g * (2048 * 128) + u.pm * 256 * 128) * 2);
#pragma unroll
        for (int ai = 0; ai < 2; ++ai)
#pragma unroll
            for (int m = 0; m < 4; ++m) { const unsigned ro = base + (unsigned)(((ai * 128 + wr * 64 + m * 16 + fr) * 128 + wc * 32 + 8 * fq) * 2);
                const f32x4 v0 = acc[ai][0][m][0], v1 = acc[ai][0][m][1]; u32x4 w; w.x = cvtpk(v0[0], v0[1]); w.y = cvtpk(v0[2], v0[3]); w.z = cvtpk(v1[0], v1[1]); w.w = cvtpk(v1[2], v1[3]);
                __builtin_amdgcn_raw_buffer_store_b128(w, rs, ro, 0, 16); }
    } };
struct Cmp2Order : pg8::GroupOrder { unsigned* ready; int wave;
    __device__ __forceinline__ void done(const pg8::Unit& u) const { panel_count(ready + 16 * u.pm, wave); }
};
struct EpiMerge { static constexpr bool PERM = true; const bf16_t* ya; const bf16_t* yb; bf16_t* merged; const float* ss;
    __device__ __forceinline__ void operator()(EPI_ARGS) const {
#pragma unroll
        for (int ai = 0; ai < 2; ++ai)
#pragma unroll
            for (int m = 0; m < 4; ++m) { const size_t off = (size_t)(u.pm * 256 + ai * 128 + wr * 64 + m * 16 + fr) * 1024 + u.pn * 128 + wc * 32 + 8 * fq;
                const u32x4 a = *(const u32x4*)(ya + off), b = *(const u32x4*)(yb + off); u32x4 w;
                const float rstd = 1.f;
#pragma unroll
                for (int q = 0; q < 4; ++q) { const int n = q >> 1, j = (q & 1) * 2;
                    const float lo = sigmoidf_(acc[ai][0][m][n][j]) * (bflo(a[q]) * rstd) + sigmoidf_(acc[ai][1][m][n][j]) * bflo(b[q]);
                    const float hi = sigmoidf_(acc[ai][0][m][n][j + 1]) * (bfhi(a[q]) * rstd) + sigmoidf_(acc[ai][1][m][n][j + 1]) * bfhi(b[q]);
                    w[q] = cvtpk(lo, hi); }
                *(u32x4*)(merged + off) = w; }
    } };
struct EpiResF32 { static constexpr bool PERM = false; const float* res; float* out; float alpha;
    __device__ __forceinline__ void operator()(EPI_ARGS) const {
#pragma unroll
        for (int ai = 0; ai < 2; ++ai)
#pragma unroll
            for (int m = 0; m < 4; ++m) { const size_t off = (size_t)(u.pm * 256 + ai * 128 + wr * 64 + m * 16 + fr) * 1024 + u.pn * 256 + wc * 32 + 4 * fq;
#pragma unroll
                for (int bj = 0; bj < 2; ++bj)
#pragma unroll
                    for (int n = 0; n < 2; ++n) { const f32x4 r = *(const f32x4*)(res + off + bj * 128 + n * 16); *(f32x4*)(out + off + bj * 128 + n * 16) = r * alpha + acc[ai][bj][m][n]; } }
    } };

struct EpiLnFused { static constexpr bool PERM = true;
    const float* res; const bf16_t* resb; float alpha; const float* g; const float* b; bf16_t* outb; unsigned long long* xbuf; unsigned* cnt;
    __device__ __forceinline__ void operator()(EPI_ARGS) const {
        LAS f32x2* P = (LAS f32x2*)scr;
        LAS f32x2* S = (LAS f32x2*)(scr + 8192);
#pragma unroll
        for (int ai = 0; ai < 2; ++ai)
#pragma unroll
            for (int m = 0; m < 4; ++m) { const size_t off = (size_t)(u.pm * 256 + ai * 128 + wr * 64 + m * 16 + fr) * 1024 + u.pn * 256 + wc * 32 + 8 * fq; float s = 0.f;
#pragma unroll
                for (int bj = 0; bj < 2; ++bj) { const u32x4 rb = *(const u32x4*)(resb + off + bj * 128);
                    const f32x4 r0 = (f32x4){bflo(rb.x), bfhi(rb.x), bflo(rb.y), bfhi(rb.y)}, r1 = (f32x4){bflo(rb.z), bfhi(rb.z), bflo(rb.w), bfhi(rb.w)};
                    const f32x4 x0 = r0 * alpha + acc[ai][bj][m][0], x1 = r1 * alpha + acc[ai][bj][m][1]; acc[ai][bj][m][0] = x0; acc[ai][bj][m][1] = x1;
                    s += ((x0[0] + x0[1]) + (x0[2] + x0[3])) + ((x1[0] + x1[1]) + (x1[2] + x1[3])); }
                s = xor32_sum(xor16_sum(s));
                const float mw = s * (1.0f / 64.0f); float q = 0.f;
#pragma unroll
                for (int bj = 0; bj < 2; ++bj)
#pragma unroll
                    for (int n = 0; n < 2; ++n) { const f32x4 d = acc[ai][bj][m][n] - mw; q += (d[0] * d[0] + d[1] * d[1]) + (d[2] * d[2] + d[3] * d[3]); }
                q = xor32_sum(xor16_sum(q));
                if (fq == 0) P[(ai * 128 + wr * 64 + m * 16 + fr) * 4 + wc] = (f32x2){mw, q}; }
        RAW_BAR();
        const int row = wid * 32 + (lane & 31);
        if (lane < 32) {
            const f32x2 a = P[row * 4 + 0], b2 = P[row * 4 + 1], c2 = P[row * 4 + 2], d = P[row * 4 + 3];
            const float mt = (a[0] + b2[0] + c2[0] + d[0]) * 0.25f;
            const float da = a[0] - mt, db = b2[0] - mt, dc = c2[0] - mt, dd = d[0] - mt;
            const float m2 = (a[1] + b2[1]) + (c2[1] + d[1]) + 64.0f * ((da * da + db * db) + (dc * dc + dd * dd));
            unsigned long long* slot = xbuf + ((size_t)(u.pm * 256 + row) * 4 + u.pn);
            __hip_atomic_store(slot, ((unsigned long long)__float_as_uint(m2) << 32) | __float_as_uint(mt), __ATOMIC_RELAXED, __HIP_MEMORY_SCOPE_AGENT);
        }
        asm volatile("s_waitcnt vmcnt(0)" ::: "memory"); __builtin_amdgcn_s_barrier(); asm volatile("" ::: "memory");
        if (wid == 0) {
            if (lane == 0) __hip_atomic_fetch_add(cnt + 64 * u.pm, 1u, __ATOMIC_RELAXED, __HIP_MEMORY_SCOPE_AGENT);
            unsigned sp = 0;
            while ((unsigned)__builtin_amdgcn_readfirstlane(__hip_atomic_load(cnt + 64 * u.pm, __ATOMIC_RELAXED, __HIP_MEMORY_SCOPE_AGENT)) < 4u) { __builtin_amdgcn_s_sleep(2); if (++sp > (1u << 22)) break; }
            __builtin_amdgcn_fence(__ATOMIC_ACQUIRE, "agent");
        }
        asm volatile("s_waitcnt vmcnt(0) lgkmcnt(0)" ::: "memory"); __builtin_amdgcn_s_barrier(); asm volatile("" ::: "memory");
        if (lane < 32) {
            const unsigned long long* slot = xbuf + (size_t)(u.pm * 256 + row) * 4; float mt[4], m2[4]; float ms = 0.f;
#pragma unroll
            for (int t = 0; t < 4; ++t) { const unsigned long long w = __hip_atomic_load(slot + t, __ATOMIC_RELAXED, __HIP_MEMORY_SCOPE_AGENT); mt[t] = __uint_as_float((unsigned)w); m2[t] = __uint_as_float((unsigned)(w >> 32)); ms += mt[t]; }
            const float mean = ms * 0.25f; float q = 0.f;
#pragma unroll
            for (int t = 0; t < 4; ++t) { const float dm = mt[t] - mean; q += m2[t] + 256.0f * dm * dm; }
            S[row] = (f32x2){mean, 1.0f / sqrtf(q * (1.0f / 1024.0f) + LN_EPS)};
        }
        RAW_BAR();
        const __amdgpu_buffer_rsrc_t ors = __builtin_amdgcn_make_buffer_rsrc(outb, 0, NTOK * 1024 * 2, 0x00020000);
#pragma unroll
        for (int ai = 0; ai < 2; ++ai)
#pragma unroll
            for (int m = 0; m < 4; ++m) { const int r = ai * 128 + wr * 64 + m * 16 + fr; const f32x2 sr = S[r]; const size_t off = (size_t)(u.pm * 256 + r) * 1024 + u.pn * 256 + wc * 32 + 8 * fq;
#pragma unroll
                for (int bj = 0; bj < 2; ++bj) { const int cc = u.pn * 256 + wc * 32 + 8 * fq + bj * 128;
                    const f32x4 g0 = *(const f32x4*)(g + cc), g1 = *(const f32x4*)(g + cc + 4), b0 = *(const f32x4*)(b + cc), b1 = *(const f32x4*)(b + cc + 4);
                    const f32x4 y0 = (acc[ai][bj][m][0] - sr[0]) * sr[1] * g0 + b0, y1 = (acc[ai][bj][m][1] - sr[0]) * sr[1] * g1 + b1;
                    u32x4 w; w.x = cvtpk(y0[0], y0[1]); w.y = cvtpk(y0[2], y0[3]); w.z = cvtpk(y1[0], y1[1]); w.w = cvtpk(y1[2], y1[3]);
                    __builtin_amdgcn_raw_buffer_store_b128(w, ors, (unsigned)((off + bj * 128) * 2), 0, 16); } }
    } };
struct EpiSoftmax { static constexpr bool PERM = true; bf16_t* Pm;
    __device__ __forceinline__ void operator()(EPI_ARGS) const {
        LAS float* X = (LAS float*)scr;
        LAS float* Y = X + 1024;
#pragma unroll
        for (int ai = 0; ai < 2; ++ai)
#pragma unroll
            for (int m = 0; m < 4; ++m) { float v = -3.0e38f;
#pragma unroll
                for (int bj = 0; bj < 2; ++bj)
#pragma unroll
                    for (int n = 0; n < 2; ++n)
#pragma unroll
                        for (int j = 0; j < 4; ++j) v = fmaxf(v, acc[ai][bj][m][n][j]);
                v = xor32_max(xor16_max(v));
                if (fq == 0) X[(ai * 128 + wr * 64 + m * 16 + fr) * 4 + wc] = v; }
        RAW_BAR();
#pragma unroll
        for (int ai = 0; ai < 2; ++ai)
#pragma unroll
            for (int m = 0; m < 4; ++m) { const int row = ai * 128 + wr * 64 + m * 16 + fr; const f32x4 t = *(const LAS f32x4*)(X + row * 4);
                const float mm = fmaxf(fmaxf(t[0], t[1]), fmaxf(t[2], t[3])); float s = 0.f;
#pragma unroll
                for (int bj = 0; bj < 2; ++bj)
#pragma unroll
                    for (int n = 0; n < 2; ++n) { f32x4 x = acc[ai][bj][m][n];
#pragma unroll
                        for (int j = 0; j < 4; ++j) { x[j] = __expf(x[j] - mm); s += x[j]; }
                        acc[ai][bj][m][n] = x; }
                s = xor32_sum(xor16_sum(s));
                if (fq == 0) Y[row * 4 + wc] = s; }
        RAW_BAR();
        const __amdgpu_buffer_rsrc_t prs = __builtin_amdgcn_make_buffer_rsrc(Pm, 0, NTOK * 1024 * 2, 0x00020000);
        const unsigned bo = (unsigned)((((u.g >> 2) * 2048 + u.pm * 256) * 1024 + (u.g & 3) * 256) * 2);
#pragma unroll
        for (int ai = 0; ai < 2; ++ai)
#pragma unroll
            for (int m = 0; m < 4; ++m) { const int row = ai * 128 + wr * 64 + m * 16 + fr; const f32x4 t = *(const LAS f32x4*)(Y + row * 4);
                const float inv = 1.f / ((t[0] + t[1]) + (t[2] + t[3])); const unsigned ro = bo + (unsigned)((row * 1024 + wc * 32 + 8 * fq) * 2);
#pragma unroll
                for (int bj = 0; bj < 2; ++bj) { const f32x4 v0 = acc[ai][bj][m][0] * inv, v1 = acc[ai][bj][m][1] * inv; u32x4 w; w.x = cvtpk(v0[0], v0[1]); w.y = cvtpk(v0[2], v0[3]); w.z = cvtpk(v1[0], v1[1]); w.w = cvtpk(v1[2], v1[3]);
                    __builtin_amdgcn_raw_buffer_store_b128(w, prs, ro + bj * 256, 0, 16); } }
    } };
struct EpiGateUp { static constexpr bool PERM = true; bf16_t* hg;
    __device__ __forceinline__ void operator()(EPI_ARGS) const {
        const __amdgpu_buffer_rsrc_t rs = __builtin_amdgcn_make_buffer_rsrc(hg, 0, MAXPOS * 256 * 2, 0x00020000);
#pragma unroll
        for (int ai = 0; ai < 2; ++ai)
#pragma unroll
            for (int m = 0; m < 4; ++m) { const unsigned off = (unsigned)(((u.pm * 256 + ai * 128 + wr * 64 + m * 16 + fr) * 256 + u.pn * 128 + wc * 32 + 8 * fq) * 2); u32x4 w;
#pragma unroll
                for (int q = 0; q < 4; ++q) { const int n = q >> 1, j = (q & 1) * 2;
                    w[q] = cvtpk(siluf_(acc[ai][0][m][n][j]) * acc[ai][1][m][n][j], siluf_(acc[ai][0][m][n][j + 1]) * acc[ai][1][m][n][j + 1]); }
                __builtin_amdgcn_raw_buffer_store_b128(w, rs, off, 0, 16); }
    } };
struct EpiDown { static constexpr bool PERM = true; const int* list; const float* listw; const LAS int* tinfo; bf16_t* Y0; bf16_t* Y1;
    __device__ __forceinline__ void operator()(EPI_ARGS) const {
        int tk[2][4]; float w[2][4];
        const int sl0 = (u.pm - tinfo[u.g]) * 256, nv = tinfo[33 + u.g] - sl0; const int* lp = list + u.g * MOE_CAP + sl0; const float* lw = listw + u.g * MOE_CAP + sl0;
#pragma unroll
        for (int ai = 0; ai < 2; ++ai)
#pragma unroll
            for (int m = 0; m < 4; ++m) { const int r = ai * 128 + wr * 64 + m * 16 + fr; const int t_ = lp[r]; const float w_ = lw[r]; tk[ai][m] = r < nv ? t_ : -1; w[ai][m] = w_; }
#pragma unroll
        for (int ai = 0; ai < 2; ++ai)
#pragma unroll
            for (int m = 0; m < 4; ++m) {
                if (tk[ai][m] >= 0) { bf16_t* rowp = ((tk[ai][m] & 1) ? Y1 : Y0) + (size_t)(tk[ai][m] >> 1) * 1024 + u.pn * 256 + wc * 32 + 8 * fq; const float ww = w[ai][m];
#pragma unroll
                    for (int bj = 0; bj < 2; ++bj) { const f32x4 v0 = acc[ai][bj][m][0] * ww, v1 = acc[ai][bj][m][1] * ww; u32x4 o; o.x = cvtpk(v0[0], v0[1]); o.y = cvtpk(v0[2], v0[3]); o.z = cvtpk(v1[0], v1[1]); o.w = cvtpk(v1[2], v1[3]);
                        *(u32x4*)(rowp + bj * 128) = o; } } }
    } };

template <bool ROPEPERM = false> __device__ __forceinline__ void seg_rot(const Ctx& C, int& rot, const float* W, int K, int Nsrc, int col0, int cnt, bf16_t* WT, int drow0, int ldd) {
    Ctx D = C; D.gw = (C.gw + C.ngw - (rot % C.ngw)) % C.ngw;
    transpose_seg<ROPEPERM>(D, W, K, Nsrc, col0, cnt, WT, drow0, ldd);
    rot += (K / 64) * (cnt / 32);
}

__device__ __forceinline__ void phase0(const Params& p, const Ctx& C) {
    unsigned char* ws = p.ws; int rot = 0;
    const float* w_in = p.in[3];
    bf16_t* W1T = (bf16_t*)(ws + WS_W1T); bf16_t* W2T = (bf16_t*)(ws + WS_W2T);
    seg_rot(C, rot, w_in, 1024, INW, 0, 4096, W1T, 0, 1024);
    seg_rot<true>(C, rot, w_in, 1024, INW, 4112, 1024, W1T, 4096, 1024);
    for (int sgi = 0; sgi < 6; ++sgi) { if (sgi & 1) seg_rot<false>(C, rot, w_in, 1024, INW, 5136 + 256 * sgi, 256, W1T, 5120 + 256 * sgi, 1024); else seg_rot<true>(C, rot, w_in, 1024, INW, 5136 + 256 * sgi, 256, W1T, 5120 + 256 * sgi, 1024); }
    for (int pn = 0; pn < 8; ++pn) { seg_rot(C, rot, w_in, 1024, INW, 6696 + 128 * pn, 128, W2T, 256 * pn, 1024); seg_rot(C, rot, w_in, 1024, INW, 7720 + 128 * pn, 128, W2T, 256 * pn + 128, 1024); }
    for (int j = 0; j < 2; ++j) seg_rot(C, rot, p.in[9] + (size_t)j * 4096 * 256, 4096, 256, 0, 256, (bf16_t*)(ws + WS_WC1T) + (size_t)j * 256 * 4096, 0, 4096);
    for (int j = 0; j < 2; ++j) seg_rot(C, rot, p.in[11] + (size_t)j * 256 * 128, 256, 128, 0, 128, (bf16_t*)(ws + WS_WC2T) + (size_t)j * 65536, 0, 256);
    seg_rot(C, rot, p.in[12], 1024, 1024, 0, 1024, (bf16_t*)(ws + WS_WOT), 0, 1024);
    cvt_rows(C, p.in[15], (bf16_t*)(ws + WS_WQT), (size_t)1024 * 1024);
    seg_rot(C, rot, p.in[16], 1024, 2048, 0, 2048, (bf16_t*)(ws + WS_WKVT), 0, 1024);
    seg_rot(C, rot, p.in[17], 1024, 1024, 0, 1024, (bf16_t*)(ws + WS_WXOT), 0, 1024);
    { const int gt = C.gw * 64 + C.lane(), ngt = C.ngw * 64;
      for (int i = gt; i < 2 * 128 * 256 / 8; i += ngt) { const int j = i / (128 * 32), r = i % (128 * 32); *(u32x4*)((bf16_t*)(ws + WS_WC2T) + (size_t)j * 65536 + 128 * 256 + r * 8) = (u32x4){0u, 0u, 0u, 0u}; } }
    cvt_rows(C, p.in[0], (bf16_t*)((unsigned char*)p.out + DO_XB), (size_t)NTOK * DM);
    cvt_rows(C, p.in[1], (bf16_t*)(ws + WS_FREE), (size_t)2048 * DM);
    { const int gt = C.gw * 64 + C.lane(), ngt = C.ngw * 64;
      for (int i = gt; i < 256 * 1024 / 8; i += ngt) { const int j = i >> 7, k0 = (i & 127) * 8; u32x4 o = (u32x4){0u, 0u, 0u, 0u};
          if (j < 40) { const float* srcp = w_in + (size_t)k0 * INW + (j < 16 ? 4096 + j : 6672 + (j - 16));
#pragma unroll
              for (int q = 0; q < 4; ++q) o[q] = cvtpk(srcp[(size_t)(2 * q) * INW], srcp[(size_t)(2 * q + 1) * INW]); }
          *(u32x4*)(W1T + (size_t)(6656 + j) * 1024 + k0) = o; } }
    extract_cols_f32(C, p.in[20], 1024, 4, 0, 4, (float*)(ws + WS_WR), 0);
    extract_cols_f32(C, p.in[22], 1024, 32, 0, 32, (float*)(ws + WS_WR), 4);
    if (blockIdx.x < 32) { const int j = blockIdx.x >> 4, kc = blockIdx.x & 15, lane = C.lane(), w = C.wave;
        const float* pe = p.in[8] + (size_t)j * 4096 + kc * 256 + w * 32; const float* w1 = p.in[9] + ((size_t)j * 4096 + kc * 256 + w * 32) * 256 + 4 * lane;
        f32x4 s = (f32x4){0.f, 0.f, 0.f, 0.f};
#pragma unroll 8
        for (int k = 0; k < 32; ++k) s += *(const f32x4*)(w1 + (size_t)k * 256) * pe[k];
        __syncthreads();
        LAS f32x4* red = (LAS f32x4*)C.lds; red[w * 64 + lane] = s;
        __syncthreads();
        if (w == 0) { f32x4 t = red[lane];
#pragma unroll
            for (int q = 1; q < 8; ++q) t += red[q * 64 + lane];
            *(f32x4*)((float*)(ws + WS_BIASP) + (j * 16 + kc) * 256 + 4 * lane) = t; }
        __syncthreads(); }
}

__device__ __forceinline__ void phase_moe_weights(const Params& p, const Ctx& C) {
    int rot = 0;
    for (int e = 0; e < 32; ++e) {
        bf16_t* gu = (bf16_t*)(p.ws + WS_WGUT) + (size_t)e * 512 * 1024;
        const float* wg = p.in[24] + (size_t)e * 1024 * 256; const float* wu = p.in[25] + (size_t)e * 1024 * 256;
        for (int pn = 0; pn < 2; ++pn) { seg_rot(C, rot, wg, 1024, 256, 128 * pn, 128, gu, 256 * pn, 1024); seg_rot(C, rot, wu, 1024, 256, 128 * pn, 128, gu, 256 * pn + 128, 1024); }
    }
}

__device__ __forceinline__ void rope_pair(bf16_t* ptr, int lane, float c, float s) {
    const float x1 = bf2f(ptr[lane]), x2 = bf2f(ptr[64 + lane]);
    ptr[lane] = f2bf(x1 * c - x2 * s); ptr[64 + lane] = f2bf(x2 * c + x1 * s);
}
__device__ __forceinline__ void conv_pass(const Params& p, const Ctx& C, int cw, int ncw, int nitems, bool do_store = true) {
    const int lane = C.lane(), hf = lane >> 5, l32 = lane & 31;
    const int nsteps = 4 * nitems;
    u32x4 rows[11], nxt[8], hn[3]; f32x4 wa[4], wb[4], wn[8];
    auto request = [&](int s) {
        const int item = cw + ncw * (s >> 2), grp = s & 3, j = item % 12, g = item / 12, ch = 256 * j + 8 * l32;
        const bf16_t* base = (const bf16_t*)(p.ws + WS_GQ + (size_t)(j >> 2) * 32 * MiB) + (ch & 1023) + ((size_t)g * 64 + 32 * hf) * 1024;
#pragma unroll
        for (int t = 0; t < 8; ++t) nxt[t] = *(const u32x4*)(base + (size_t)(grp * 8 + t) * 1024);
        if (grp == 0) {
            const bf16_t* hp = hf ? base - 3 * 1024 : (const bf16_t*)(p.ws + WS_HALO) + (size_t)(g > 0 ? g - 1 : 0) * 3 * 3072 + ch; const size_t hs = hf ? 1024 : 3072;
#pragma unroll
            for (int i = 0; i < 3; ++i) hn[i] = *(const u32x4*)(hp + i * hs);
            const float* wp = p.in[4] + ch;
#pragma unroll
            for (int k = 0; k < 4; ++k) { wn[2 * k] = *(const f32x4*)(wp + (size_t)k * 3072); wn[2 * k + 1] = *(const f32x4*)(wp + (size_t)k * 3072 + 4); }
        }
    };
    if (nsteps > 0) request(0);
#pragma unroll 1
    for (int s = 0; s < nsteps; ++s) {
        const int item = cw + ncw * (s >> 2), grp = s & 3, j = item % 12, g = item / 12, ch = 256 * j + 8 * l32;
        bf16_t* gb = (bf16_t*)(p.ws + WS_GQ + (size_t)(j >> 2) * 32 * MiB) + (ch & 1023) + ((size_t)g * 64 + 32 * hf + 8 * grp) * 1024;
        if (grp == 0) { const bool zero = hf == 0 && (g & 31) == 0;
#pragma unroll
            for (int i = 0; i < 3; ++i) rows[i] = zero ? (u32x4){0u, 0u, 0u, 0u} : hn[i];
#pragma unroll
            for (int k = 0; k < 4; ++k) { wa[k] = wn[2 * k]; wb[k] = wn[2 * k + 1]; } }
#pragma unroll
        for (int t = 0; t < 8; ++t) rows[3 + t] = nxt[t];
        if (s + 1 < nsteps) request(s + 1);
#pragma unroll
        for (int t = 0; t < 8; ++t) { f32x2 o[4];
#pragma unroll
            for (int k = 0; k < 4; ++k) { const u32x4 rw = rows[t + k];
#pragma unroll
                for (int q = 0; q < 4; ++q) { const f32x2 x = {bflo(rw[q]), bfhi(rw[q])}; const f32x2 w = q < 2 ? (f32x2){wa[k][2 * q], wa[k][2 * q + 1]} : (f32x2){wb[k][2 * q - 4], wb[k][2 * q - 3]};
                    o[q] = k == 0 ? w * x : __builtin_elementwise_fma(w, x, o[q]); } }
            f32x2 ss2 = {0.f, 0.f};
#pragma unroll
            for (int q = 0; q < 4; ++q) { const f32x2 tt = o[q] * -1.4426950408889634f; f32x2 e; e.x = __builtin_amdgcn_exp2f(tt.x); e.y = __builtin_amdgcn_exp2f(tt.y); e = e + 1.f;
                f32x2 r; r.x = __builtin_amdgcn_rcpf(e.x); r.y = __builtin_amdgcn_rcpf(e.y); o[q] = o[q] * r; ss2 = __builtin_elementwise_fma(o[q], o[q], ss2); }
            if (j < 8) { const float f = rsqrtf(sum16(ss2.x + ss2.y) + RMS_EPS) * (j < 4 ? 0.08838834764831845f : 1.f);
#pragma unroll
                for (int q = 0; q < 4; ++q) o[q] = o[q] * f; }
            u32x4 v; v.x = cvtpk(o[0].x, o[0].y); v.y = cvtpk(o[1].x, o[1].y); v.z = cvtpk(o[2].x, o[2].y); v.w = cvtpk(o[3].x, o[3].y);
            if (do_store) *(u32x4*)(gb + (size_t)t * 1024) = v; else asm volatile("" :: "v"(v)); }
        rows[0] = rows[8]; rows[1] = rows[9]; rows[2] = rows[10];
    }
}

__device__ __forceinline__ void combine_rows(const Params& p, const Ctx& C, int j, int row0, int nrows) {
    const bf16_t* part = (const bf16_t*)(p.ws + WS_PART); const float* bp = (const float*)(p.ws + WS_BIASP); bf16_t* hid = (bf16_t*)(p.ws + WS_HID);
    for (int i = C.tid(); i < nrows * 32; i += NTHREADS) {
        const int c8 = i & 31, r = row0 + (i >> 5);
        u32x4 pr[8];
#pragma unroll
        for (int s = 0; s < 8; ++s) pr[s] = *(const u32x4*)(part + ((size_t)(s * 2 + j) * 2048 + r) * 256 + c8 * 8);
        f32x4 v0 = *(const f32x4*)(p.in[10] + j * 256 + c8 * 8), v1 = *(const f32x4*)(p.in[10] + j * 256 + c8 * 8 + 4);
#pragma unroll
        for (int kc = 0; kc < 16; ++kc) { v0 += *(const f32x4*)(bp + (j * 16 + kc) * 256 + c8 * 8); v1 += *(const f32x4*)(bp + (j * 16 + kc) * 256 + c8 * 8 + 4); }
#pragma unroll
        for (int s = 0; s < 8; ++s) { v0[0] += bflo(pr[s].x); v0[1] += bfhi(pr[s].x); v0[2] += bflo(pr[s].y); v0[3] += bfhi(pr[s].y); v1[0] += bflo(pr[s].z); v1[1] += bfhi(pr[s].z); v1[2] += bflo(pr[s].w); v1[3] += bfhi(pr[s].w); }
        float o[8];
#pragma unroll
        for (int q = 0; q < 8; ++q) { const float x = q < 4 ? v0[q] : v1[q - 4]; const float t = 0.7978845608028654f * (x + 0.044715f * x * x * x); const float e = __expf(2.f * t); const float th = 1.f - 2.f / (e + 1.f); o[q] = 0.5f * x * (1.f + th); }
        u32x4 w; w.x = cvtpk(o[0], o[1]); w.y = cvtpk(o[2], o[3]); w.z = cvtpk(o[4], o[5]); w.w = cvtpk(o[6], o[7]);
        *(u32x4*)(hid + ((size_t)j * 2048 + r) * 256 + c8 * 8) = w;
    }
}
__device__ __forceinline__ void wg_wait_count(const unsigned* cnt, unsigned target, int wave) {
    if (wave == 0) { unsigned sp = 0;
        while ((unsigned)__builtin_amdgcn_readfirstlane(__hip_atomic_load(cnt, __ATOMIC_RELAXED, __HIP_MEMORY_SCOPE_AGENT)) < target) { __builtin_amdgcn_s_sleep(2); if (++sp > (1u << 22)) break; }
        __builtin_amdgcn_fence(__ATOMIC_ACQUIRE, "agent");
        asm volatile("s_waitcnt vmcnt(0)" ::: "memory"); }
    __syncthreads();
}

__device__ __forceinline__ void ln_row(f32x4 (&v)[4], const float* g, const float* b, int lane) {
    float s = 0.f;
#pragma unroll
    for (int j = 0; j < 4; ++j) s += (v[j][0] + v[j][1]) + (v[j][2] + v[j][3]);
    const float mean = wave_sum(s) * (1.f / 1024.f); float s2 = 0.f;
#pragma unroll
    for (int j = 0; j < 4; ++j) { v[j] = v[j] - mean; s2 += (v[j][0] * v[j][0] + v[j][1] * v[j][1]) + (v[j][2] * v[j][2] + v[j][3] * v[j][3]); }
    const float rstd = 1.f / sqrtf(wave_sum(s2) * (1.f / 1024.f) + LN_EPS);
#pragma unroll
    for (int j = 0; j < 4; ++j) { const f32x4 gg = *(const f32x4*)(g + 4 * lane + 256 * j), bb = *(const f32x4*)(b + 4 * lane + 256 * j); v[j] = v[j] * rstd * gg + bb; }
}
__device__ __forceinline__ void phase_ln1(const Params& p, const Ctx& C) {
    float* H = (float*)(p.ws + WS_H); bf16_t* HB = (bf16_t*)(p.ws + WS_HB); const int lane = C.lane();
    for (int m = C.gw; m < NTOK; m += C.ngw) {
        float* row = H + (size_t)m * 1024 + 4 * lane; f32x4 v[4];
#pragma unroll
        for (int j = 0; j < 4; ++j) v[j] = *(const f32x4*)(row + 256 * j);
        ln_row(v, p.in[13], p.in[14], lane);
#pragma unroll
        for (int j = 0; j < 4; ++j) { *(f32x4*)(row + 256 * j) = v[j]; u32x2 w; w.x = cvtpk(v[j][0], v[j][1]); w.y = cvtpk(v[j][2], v[j][3]); *(u32x2*)(HB + (size_t)m * 1024 + 4 * lane + 256 * j) = w; }
    }
}
__device__ __forceinline__ float dot_row(const f32x4 (&v)[4], const float* w, int lane) {
    float d = 0.f;
#pragma unroll
    for (int j = 0; j < 4; ++j) { const f32x4 x = *(const f32x4*)(w + 4 * lane + 256 * j); d += v[j][0] * x[0] + v[j][1] * x[1] + v[j][2] * x[2] + v[j][3] * x[3]; }
    return wave_sum(d);
}
__device__ __forceinline__ void phase_ln2_router(const Params& p, const Ctx& C, bool do_assign = true) {
    const bf16_t* HB = (const bf16_t*)(p.ws + WS_HB); const int lane = C.lane();
    const float* Wr = (const float*)(p.ws + WS_WR); unsigned* cnt = (unsigned*)(p.ws + WS_CTL) + CW_CNT;
    int* list = (int*)(p.ws + WS_LIST); float* listw = (float*)(p.ws + WS_LISTW);
    const float bias = lane < 4 ? p.in[21][lane] : (lane < 36 ? p.in[23][lane - 4] : 0.f);
#define RSTAMP(k) do {} while (0)
    RSTAMP(0);
    for (int m0 = 8 * C.gw; m0 < NTOK; m0 += 8 * C.ngw) {
        const int w = C.wave, mb0 = m0 - 8 * w, l15 = lane & 15, lq = lane >> 4;
        LAS float* PL = (LAS float*)(C.lds + 1024);
        bf16x8 xf[4][4];
#pragma unroll
        for (int nt = 0; nt < 4; ++nt)
#pragma unroll
            for (int ks = 0; ks < 4; ++ks) xf[nt][ks] = *(const bf16x8*)(HB + (size_t)(mb0 + 16 * nt + l15) * 1024 + 128 * w + 32 * ks + 8 * lq);
        f32x4 acc[4][3];
#pragma unroll
        for (int nt = 0; nt < 4; ++nt)
#pragma unroll
            for (int mt = 0; mt < 3; ++mt) acc[nt][mt] = (f32x4){0.f, 0.f, 0.f, 0.f};
#pragma unroll
        for (int mt = 0; mt < 3; ++mt) { const int row = 16 * mt + l15; const bool live = row < 36;
            const float* wp = Wr + (size_t)(live ? row : 0) * 1024 + 128 * w + 8 * lq;
#pragma unroll
            for (int ks = 0; ks < 4; ++ks) { f32x4 fa = *(const f32x4*)(wp + 32 * ks), fb = *(const f32x4*)(wp + 32 * ks + 4);
                if (!live) { fa = (f32x4){0.f, 0.f, 0.f, 0.f}; fb = fa; }
                u32x4 h; h.x = cvtpk(fa[0], fa[1]); h.y = cvtpk(fa[2], fa[3]); h.z = cvtpk(fb[0], fb[1]); h.w = cvtpk(fb[2], fb[3]);
                u32x4 lo; lo.x = cvtpk(fa[0] - bflo(h.x), fa[1] - bfhi(h.x)); lo.y = cvtpk(fa[2] - bflo(h.y), fa[3] - bfhi(h.y)); lo.z = cvtpk(fb[0] - bflo(h.z), fb[1] - bfhi(h.z)); lo.w = cvtpk(fb[2] - bflo(h.w), fb[3] - bfhi(h.w));
                const bf16x8 wh = __builtin_bit_cast(bf16x8, h), wl = __builtin_bit_cast(bf16x8, lo);
#pragma unroll
                for (int nt = 0; nt < 4; ++nt) { acc[nt][mt] = __builtin_amdgcn_mfma_f32_16x16x32_bf16(wh, xf[nt][ks], acc[nt][mt], 0, 0, 0); acc[nt][mt] = __builtin_amdgcn_mfma_f32_16x16x32_bf16(wl, xf[nt][ks], acc[nt][mt], 0, 0, 0); } } }
#pragma unroll
        for (int nt = 0; nt < 4; ++nt)
#pragma unroll
            for (int mt = 0; mt < 3; ++mt) *(LAS f32x4*)(PL + (size_t)(w * 64 + 16 * nt + l15) * 52 + 16 * mt + 4 * lq) = acc[nt][mt];
        __syncthreads();
        RSTAMP(1);
        float lg[8];
#pragma unroll
        for (int i = 0; i < 8; ++i) { float s = bias;
            if (lane < 48) {
#pragma unroll
                for (int ww = 0; ww < 8; ++ww) s += PL[(size_t)(ww * 64 + 8 * w + i) * 52 + lane]; }
            lg[i] = s; }
        __syncthreads();
        RSTAMP(2);
        int myid = 0; float myw = 0.f;
        {
            LAS float* LGw = PL + w * 512;
#pragma unroll
            for (int i = 0; i < 8; ++i) if (lane < 36) LGw[i * 40 + lane] = lg[i];
            const int ti = lane >> 3, e = lane & 7;
            const f32x4 g4 = *(const LAS f32x4*)(LGw + ti * 40);
            int gs = 0; float gm = g4[0];
#pragma unroll
            for (int gi = 1; gi < 4; ++gi) if (g4[gi] > gm) { gm = g4[gi]; gs = gi; }
            float gsum = 0.f;
#pragma unroll
            for (int gi = 0; gi < 4; ++gi) gsum += __expf(g4[gi] - gm);
            const float p_top = 1.f / gsum;
            const float x = LGw[ti * 40 + 4 + 8 * gs + e];
            auto max8 = [](float v) { v = fmaxf(v, dpp_f<0xB1>(v)); v = fmaxf(v, dpp_f<0x4E>(v)); v = fmaxf(v, dpp_f<0x141>(v)); return v; };
            auto min8 = [](int v) { v = min(v, __builtin_amdgcn_update_dpp(0, v, 0xB1, 0xF, 0xF, true)); v = min(v, __builtin_amdgcn_update_dpp(0, v, 0x4E, 0xF, 0xF, true)); v = min(v, __builtin_amdgcn_update_dpp(0, v, 0x141, 0xF, 0xF, true)); return v; };
            const float m0v = max8(x);
            const int e0 = min8(x == m0v ? e : 8);
            const float m1 = max8(e == e0 ? -3.0e38f : x);
            const int e1r = min8((e != e0 && x == m1 && m1 > -3.0e38f) ? e : 8), e1 = e1r == 8 ? -1 : e1r;
            const float q1 = __expf(m1 - m0v); const float w0 = p_top / (1.f + q1), w1 = p_top * q1 / (1.f + q1);
            const int idl = gs * 8 + (e == 0 ? e0 : e1); const float wl = e == 0 ? w0 : w1;
            const int src = 8 * (lane >> 1) + (lane & 1);
            myid = __shfl(idl, src & 63); myw = __shfl(wl, src & 63);
        }
        RSTAMP(3);
        if (!do_assign) continue;
        LAS unsigned* cl = (LAS unsigned*)C.lds; LAS unsigned* bl = cl + 32;
        const int tid_ = C.wave * 64 + lane;
        if (tid_ < 32) cl[tid_] = 0u;
        __syncthreads();
        unsigned loc = 0u;
        if (lane < 16) loc = __hip_atomic_fetch_add(cl + myid, 1u, __ATOMIC_RELAXED, __HIP_MEMORY_SCOPE_WORKGROUP);
        __syncthreads();
        if (tid_ < 32) bl[tid_] = atomicAdd(cnt + 64 * tid_, cl[tid_]);
        __syncthreads();
        if (lane < 16) { const int sl = myid * MOE_CAP + (int)(bl[myid] + loc); list[sl] = 2 * m0 + lane; listw[sl] = myw; }
        RSTAMP(4);
    }
}
__device__ __forceinline__ void moe_tables(const Params& p, const Ctx& C, LAS int* tileE, LAS int* tinfo) {
    const unsigned* cnt = (const unsigned*)(p.ws + WS_CTL) + CW_CNT; const int t_ = C.tid();
    if (t_ < 64) {
        const int l = t_ & 31; const int c = (int)__hip_atomic_load(cnt + 64 * l, __ATOMIC_RELAXED, __HIP_MEMORY_SCOPE_AGENT); const int tl = (c + 255) >> 8;
        int sc = tl;
#pragma unroll
        for (int o = 1; o < 32; o <<= 1) { const int n = __shfl_up(sc, o, 32); if (l >= o) sc += n; }
        if (t_ < 32) { tinfo[33 + l] = c; tinfo[l] = sc - tl; if (l == 31) tinfo[32] = sc; }
    }
    __syncthreads();
    if (t_ < 256) { int e = 0;
#pragma unroll
        for (int q = 1; q < 32; ++q) e += (tinfo[q] <= t_) ? 1 : 0;
        tileE[t_] = t_ == 255 ? tinfo[32] : e; }
    __syncthreads();
}
__device__ __forceinline__ void phase_final(const Params& p, const Ctx& C) {
    const bf16_t* HB = (const bf16_t*)(p.ws + WS_HB); const bf16_t* Y0 = (const bf16_t*)(p.ws + WS_Y0); const bf16_t* Y1 = (const bf16_t*)(p.ws + WS_Y1); const int lane = C.lane();
    for (int m = C.gw; m < NTOK; m += C.ngw) {
        f32x4 v[4];
#pragma unroll
        for (int j = 0; j < 4; ++j) { const size_t off = (size_t)m * 1024 + 4 * lane + 256 * j; { const u32x2 hb = __builtin_nontemporal_load((const u32x2*)(HB + off)); v[j] = (f32x4){bflo(hb.x), bfhi(hb.x), bflo(hb.y), bfhi(hb.y)} * DN_ALPHA; }
            const u32x2 a = __builtin_nontemporal_load((const u32x2*)(Y0 + off)), b = __builtin_nontemporal_load((const u32x2*)(Y1 + off));
            v[j][0] += bflo(a.x) + bflo(b.x); v[j][1] += bfhi(a.x) + bfhi(b.x); v[j][2] += bflo(a.y) + bflo(b.y); v[j][3] += bfhi(a.y) + bfhi(b.y); }
        ln_row(v, p.in[27], p.in[28], lane);
#pragma unroll
        for (int j = 0; j < 4; ++j) __builtin_nontemporal_store(v[j], (f32x4*)(p.out + (size_t)m * 1024 + 4 * lane + 256 * j));
    }
}
constexpr int KSTR = 272;
constexpr int VSTR = 320;
constexpr int NL_KC = 0, NL_VC = 128 * KSTR, NL_KS = NL_VC + 128 * VSTR, NL_VS = NL_KS + 64 * KSTR, NL_IMP = NL_KS  , NL_SELM = NL_VS + 64 * VSTR  ;
constexpr int NL_KS2 = NL_SELM + 512, NL_VS2 = NL_KS2 + 64 * KSTR;
constexpr int NL_END = NL_VS2 + 64 * VSTR;
static_assert(4 * 64 * 33 * 4 <= 64 * KSTR + 64 * VSTR, "imp overlay fits in KS|VS");
static_assert(NL_END <= 151 * 1024, "attention LDS map");
constexpr int MIX_ITEM_OFF = 151 * 1024;
constexpr size_t WS_SS = WS_HID;

__device__ __forceinline__ int crow(int r, int hi) { return (r & 3) + 8 * (r >> 2) + 4 * hi; }
__device__ __forceinline__ bf16x8 pack8(const f32x16& v, int s) {
    u32x4 w; w.x = cvtpk(v[8 * s + 0], v[8 * s + 1]); w.y = cvtpk(v[8 * s + 2], v[8 * s + 3]); w.z = cvtpk(v[8 * s + 4], v[8 * s + 5]); w.w = cvtpk(v[8 * s + 6], v[8 * s + 7]);
    return __builtin_bit_cast(bf16x8, w);
}
typedef short v4i16_t __attribute__((ext_vector_type(4)));
__device__ __forceinline__ bf16x8 vfrag(const LAS unsigned char* vbase  ) {
    const v4i16_t lo = __builtin_amdgcn_ds_read_tr16_b64_v4i16((LAS v4i16_t*)vbase);
    const v4i16_t hi = __builtin_amdgcn_ds_read_tr16_b64_v4i16((LAS v4i16_t*)(vbase + 8 * VSTR));
    return (bf16x8){lo[0], lo[1], lo[2], lo[3], hi[0], hi[1], hi[2], hi[3]};
}
template <int ROWS, int STR> __device__ __forceinline__ void stage_tile(LAS unsigned char* dst, const bf16_t* src, size_t ldg, int tid) {
#pragma unroll
    for (int i = 0; i < ROWS * 16 / NTHREADS; ++i) { const int idx = tid + NTHREADS * i, row = idx >> 4, ch = idx & 15;
        const u32x4 v = *(const u32x4*)(src + (size_t)row * ldg + ch * 8); *(LAS u32x4*)(dst + row * STR + ch * 16) = v; }
}
struct TileRegs { u32x4 k[2], v[2]; };
__device__ __forceinline__ void tile_fetch(TileRegs& R, const bf16_t* ksrc, const bf16_t* vsrc, int tid) {
#pragma unroll
    for (int i = 0; i < 2; ++i) { const int idx = tid + NTHREADS * i, row = idx >> 4, ch = idx & 15; R.k[i] = *(const u32x4*)(ksrc + (size_t)row * 256 + ch * 8); R.v[i] = *(const u32x4*)(vsrc + (size_t)row * 256 + ch * 8); }
}
__device__ __forceinline__ void tile_commit(const TileRegs& R, LAS unsigned char* kd, LAS unsigned char* vd, int tid) {
#pragma unroll
    for (int i = 0; i < 2; ++i) { const int idx = tid + NTHREADS * i, row = idx >> 4, ch = idx & 15; *(LAS u32x4*)(kd + row * KSTR + ch * 16) = R.k[i]; *(LAS u32x4*)(vd + row * VSTR + ch * 16) = R.v[i]; }
}
template <int MODE> __device__ __forceinline__ void attn_tile(const LAS unsigned char* KSb, const LAS unsigned char* VSb, const bf16x8 (&qf)[8], int t, int kpos0, bool selq, bool full,
                                                               float& m_run, float& l_run, f32x16 (&os)[4], int lane) {
    const int r32 = lane & 31, hi = lane >> 5;
    f32x16 st[2]; st[0] = (f32x16){}; st[1] = (f32x16){};
    {
        const LAS unsigned char* k0 = KSb + r32 * KSTR + 16 * hi; const LAS unsigned char* k1 = k0 + 32 * KSTR;
        bf16x8 ca[2][2], na[2][2];
#pragma unroll
        for (int q = 0; q < 2; ++q) { ca[0][q] = *(const LAS bf16x8*)(k0 + 32 * q); ca[1][q] = *(const LAS bf16x8*)(k1 + 32 * q); }
#pragma unroll
        for (int g = 0; g < 4; ++g) {
            if (g < 3) {
#pragma unroll
                for (int q = 0; q < 2; ++q) { na[0][q] = *(const LAS bf16x8*)(k0 + 32 * (2 * g + 2 + q)); na[1][q] = *(const LAS bf16x8*)(k1 + 32 * (2 * g + 2 + q)); } }
            __builtin_amdgcn_sched_barrier(0);
#pragma unroll
            for (int q = 0; q < 2; ++q) { st[0] = __builtin_amdgcn_mfma_f32_32x32x16_bf16(ca[0][q], qf[2 * g + q], st[0], 0, 0, 0); st[1] = __builtin_amdgcn_mfma_f32_32x32x16_bf16(ca[1][q], qf[2 * g + q], st[1], 0, 0, 0); }
            __builtin_amdgcn_sched_barrier(0);
            if (g < 3) {
#pragma unroll
                for (int q = 0; q < 2; ++q) { ca[0][q] = na[0][q]; ca[1][q] = na[1][q]; } }
        }
    }
    const int vlane = ((lane & 15) >> 2) * VSTR + (16 * ((lane >> 4) & 1) + 4 * (lane & 3)) * 2;
    const LAS unsigned char* vb0 = VSb + (4 * hi) * VSTR + vlane;
    bf16x8 cv[4], nv[4];
#pragma unroll
    for (int dt = 0; dt < 4; ++dt) cv[dt] = vfrag(vb0 + 64 * dt);
    __builtin_amdgcn_sched_barrier(0);
    const float C2 = 0.08838834764831845f * 1.4426950408889634f;
    if (!full) {
        const int thr = (MODE == 0 && !selq) ? -1 : (t - kpos0 - 4 * hi);
#pragma unroll
        for (int sub = 0; sub < 2; ++sub)
#pragma unroll
            for (int r = 0; r < 16; ++r) { const int off = 32 * sub + (r & 3) + 8 * (r >> 2);
                const bool valid = MODE == 0 ? (off <= thr) : ((unsigned)(thr - off) < 256u);
                st[sub][r] = valid ? st[sub][r] : -3.0e38f; }
    }
    float tmax = -3.0e38f;
#pragma unroll
    for (int sub = 0; sub < 2; ++sub)
#pragma unroll
        for (int r = 0; r < 16; r += 2) tmax = __builtin_fmaxf(__builtin_fmaxf(tmax, st[sub][r]), st[sub][r + 1]);
    const bool rowoff = MODE == 0 && full && !selq;
    tmax = rowoff ? -3.0e38f : tmax;
    tmax = fmaxf(xor32_max(tmax) * C2, -3.0e38f);
    const float m_new = fmaxf(m_run, tmax);
    const float m_eff = fmaxf(m_new, -1.0e30f);
    const float resc = __builtin_amdgcn_exp2f(fmaxf(m_run, -1.0e30f) - m_eff);
    const float shift = rowoff ? -3.0e38f : -m_eff;
    f32x2 ps2 = {0.f, 0.f}; const f32x2 c2v = {C2, C2}, nm = {shift, shift};
#pragma unroll
    for (int sub = 0; sub < 2; ++sub)
#pragma unroll
        for (int r = 0; r < 16; r += 2) { const f32x2 sv = {st[sub][r], st[sub][r + 1]}; const f32x2 a = __builtin_elementwise_fma(sv, c2v, nm);
            f32x2 ev; ev.x = __builtin_amdgcn_exp2f(a.x); ev.y = __builtin_amdgcn_exp2f(a.y); st[sub][r] = ev.x; st[sub][r + 1] = ev.y; ps2 = ps2 + ev; }
    const float psum = xor32_sum(ps2.x + ps2.y);
    l_run = l_run * resc + psum;
    if (__any(m_new != m_run)) {
#pragma unroll
        for (int dt = 0; dt < 4; ++dt) os[dt] = os[dt] * resc;
    }
    m_run = m_new;
    {
#pragma unroll
        for (int g = 0; g < 4; ++g) {
            if (g < 3) {
#pragma unroll
                for (int dt = 0; dt < 4; ++dt) nv[dt] = vfrag(vb0 + (16 * (g + 1)) * VSTR + 64 * dt); }
            const bf16x8 pf = pack8(st[g >> 1], g & 1);
            __builtin_amdgcn_sched_barrier(0);
#pragma unroll
            for (int dt = 0; dt < 4; ++dt) os[dt] = __builtin_amdgcn_mfma_f32_32x32x16_bf16(cv[dt], pf, os[dt], 0, 0, 0);
            __builtin_amdgcn_sched_barrier(0);
            if (g < 3) {
#pragma unroll
                for (int dt = 0; dt < 4; ++dt) cv[dt] = nv[dt]; }
        }
    }
}

template <int STEP> __device__ __forceinline__ void emit_branch(bf16_t* yq, LAS unsigned char* accw, const f32x16 (&o)[4], float f, int hi, int lane) {
#pragma unroll
    for (int dt = 0; dt < 4; ++dt)
#pragma unroll
        for (int q4 = 0; q4 < 4; ++q4) { LAS u32x2* slot = (LAS u32x2*)(accw + ((dt * 4 + q4) * 64 + lane) * 8);
            float v0 = o[dt][4 * q4] * f, v1 = o[dt][4 * q4 + 1] * f, v2 = o[dt][4 * q4 + 2] * f, v3 = o[dt][4 * q4 + 3] * f;
            if (STEP > 0) { const u32x2 old = *slot; v0 += bflo(old.x); v1 += bfhi(old.x); v2 += bflo(old.y); v3 += bfhi(old.y); }
            u32x2 w; w.x = cvtpk(v0, v1); w.y = cvtpk(v2, v3);
            if (STEP < 2) *slot = w; else *(u32x2*)(yq + 32 * dt + 8 * q4 + 4 * hi) = w; }
}

__device__ __forceinline__ void nsa_item(const Params& p, const Ctx& C, int b, int g, int qb) {
    int tid_ = C.tid(), lane_ = C.lane(); asm volatile("" : "+v"(tid_), "+v"(lane_));
    const int tid = tid_, lane = lane_, w = C.wave, r32 = lane & 31, hi = lane >> 5;
    const int hh = w >> 1, qh = w & 1, head = g * 4 + hh;
    const int t = qb * 64 + qh * 32 + r32;
    const size_t m = (size_t)b * SEQ + t;
    LAS unsigned char* L = C.lds;
    unsigned char* ws = p.ws;
    const int bg = b * 2 + g;
#define NSTAMP(k) do {} while (0)
    NSTAMP(0);
    stage_tile<128, KSTR>(L + NL_KC, (const bf16_t*)(ws + WS_CMPK) + (size_t)bg * 128 * 128, 128, tid);
    stage_tile<128, VSTR>(L + NL_VC, (const bf16_t*)(ws + WS_CMPV) + (size_t)bg * 128 * 128, 128, tid);
    bf16_t* yq = (bf16_t*)((unsigned char*)p.out + DO_NQ) + m * 1024 + head * 128;
    bf16x8 qf[8];
#pragma unroll
    for (int s = 0; s < 8; ++s) qf[s] = *(const bf16x8*)(yq + 16 * s + 8 * hi);
    if (tid == 0) *(LAS unsigned*)(L + NL_SELM + 256) = 0u;
    const float* gates = (const float*)(ws + WS_LG) + m * 40 + 16 + head * 3;
    const float gc = sigmoidf_(gates[0]), gs_ = sigmoidf_(gates[1]), gw_ = sigmoidf_(gates[2]);
    __syncthreads();
    const float SCALE = 0.08838834764831845f;
    {
        f32x16 sc[4]; f32x16 tot[4];
#pragma unroll
        for (int kt = 0; kt < 4; ++kt) sc[kt] = (f32x16){};
        {
            const LAS unsigned char* kc = L + NL_KC + r32 * KSTR + 16 * hi;
            bf16x8 ca[4], na[4];
#pragma unroll
            for (int kt = 0; kt < 4; ++kt) ca[kt] = *(const LAS bf16x8*)(kc + 32 * kt * KSTR);
#pragma unroll
            for (int s = 0; s < 8; ++s) {
                if (s < 7) {
#pragma unroll
                    for (int kt = 0; kt < 4; ++kt) na[kt] = *(const LAS bf16x8*)(kc + 32 * kt * KSTR + 32 * (s + 1)); }
                __builtin_amdgcn_sched_barrier(0);
#pragma unroll
                for (int kt = 0; kt < 4; ++kt) sc[kt] = __builtin_amdgcn_mfma_f32_32x32x16_bf16(ca[kt], qf[s], sc[kt], 0, 0, 0);
                __builtin_amdgcn_sched_barrier(0);
                if (s < 7) {
#pragma unroll
                    for (int kt = 0; kt < 4; ++kt) ca[kt] = na[kt]; } } }
        const int nmax = (t >= 31) ? ((t - 31) >> 4) : -1;
        const float C2c = SCALE * 1.4426950408889634f;
        float mx = -3.0e38f;
#pragma unroll
        for (int kt = 0; kt < 4; ++kt)
#pragma unroll
            for (int r = 0; r < 16; ++r) { const int n = 32 * kt + crow(r, hi); sc[kt][r] = (n <= nmax) ? sc[kt][r] : -3.0e38f; }
#pragma unroll
        for (int kt = 0; kt < 4; ++kt)
#pragma unroll
            for (int r = 0; r < 16; r += 2) mx = __builtin_fmaxf(__builtin_fmaxf(mx, sc[kt][r]), sc[kt][r + 1]);
        mx = fmaxf(xor32_max(mx) * C2c, -1.0e30f);
        f32x2 sm2 = {0.f, 0.f}; const f32x2 c2v = {C2c, C2c}, nmv = {-mx, -mx};
#pragma unroll
        for (int kt = 0; kt < 4; ++kt)
#pragma unroll
            for (int r = 0; r < 16; r += 2) { const f32x2 sv = {sc[kt][r], sc[kt][r + 1]}; const f32x2 av = __builtin_elementwise_fma(sv, c2v, nmv);
                f32x2 ev; ev.x = __builtin_amdgcn_exp2f(av.x); ev.y = __builtin_amdgcn_exp2f(av.y); sc[kt][r] = ev.x; sc[kt][r + 1] = ev.y; sm2 = sm2 + ev; }
        float sum = xor32_sum(sm2.x + sm2.y);
        const float inv = sum > 0.f ? 1.f / sum : 0.f;
#pragma unroll
        for (int kt = 0; kt < 4; ++kt) sc[kt] = sc[kt] * inv;
        LAS float* imp = (LAS float*)(L + NL_IMP) + (hh * 64 + qh * 32 + r32) * 33;
        float prev_carry = 0.f;
#pragma unroll
        for (int kt = 0; kt < 4; ++kt)
#pragma unroll
            for (int q4 = 0; q4 < 4; ++q4) {
                const float p3 = 0.5f * sc[kt][4 * q4 + 3];
                const float mainv = sc[kt][4 * q4] + sc[kt][4 * q4 + 1] + sc[kt][4 * q4 + 2] + p3;
                const float rc = xor32_get(p3, hi);
                const float add = hi ? rc : prev_carry;
                imp[8 * kt + 2 * q4 + hi] = mainv + add;
                prev_carry = rc;
            }
#pragma unroll
        for (int dt = 0; dt < 4; ++dt) tot[dt] = (f32x16){};
        const int vlane = ((lane & 15) >> 2) * VSTR + (16 * ((lane >> 4) & 1) + 4 * (lane & 3)) * 2;
        {
            const LAS unsigned char* vb0 = L + NL_VC + (4 * hi) * VSTR + vlane;
            bf16x8 cv[4], nv[4];
#pragma unroll
            for (int dt = 0; dt < 4; ++dt) cv[dt] = vfrag(vb0 + 64 * dt);
#pragma unroll
            for (int g8 = 0; g8 < 8; ++g8) {
                if (g8 < 7) {
#pragma unroll
                    for (int dt = 0; dt < 4; ++dt) nv[dt] = vfrag(vb0 + (16 * (g8 + 1)) * VSTR + 64 * dt); }
                const bf16x8 pf = pack8(sc[g8 >> 1], g8 & 1);
                __builtin_amdgcn_sched_barrier(0);
#pragma unroll
                for (int dt = 0; dt < 4; ++dt) tot[dt] = __builtin_amdgcn_mfma_f32_32x32x16_bf16(cv[dt], pf, tot[dt], 0, 0, 0);
                __builtin_amdgcn_sched_barrier(0);
                if (g8 < 7) {
#pragma unroll
                    for (int dt = 0; dt < 4; ++dt) cv[dt] = nv[dt]; } } }
        __syncthreads();
        emit_branch<0>(yq, L + NL_KC + w * 8192, tot, gc, hi, lane);
    }
    const bf16_t* kvb = (const bf16_t*)(ws + WS_KV) + (size_t)b * SEQ * 256 + g * 128;
    TileRegs R;
    tile_fetch(R, kvb + (size_t)2 * 4194304, kvb + (size_t)3 * 4194304, tid);
    LAS unsigned* selm = (LAS unsigned*)(L + NL_SELM);
    {
        const LAS float* I0 = (const LAS float*)(L + NL_IMP);
        const int cur = qb, jb = lane & 31, qsel = lane >> 5;
        const unsigned forced = 1u | (1u << cur) | (cur >= 1 ? (1u << (cur - 1)) : 0u);
        const int nsel = 8 - __popc(forced);
        const bool cand = jb >= 1 && jb + 2 <= cur;
        unsigned uacc = 0u;
#pragma unroll
        for (int pr = 0; pr < 4; ++pr) { const int qi = 8 * w + 2 * pr + qsel;
            const float v = (I0[(0 * 64 + qi) * 33 + jb] + I0[(1 * 64 + qi) * 33 + jb]) + (I0[(2 * 64 + qi) * 33 + jb] + I0[(3 * 64 + qi) * 33 + jb]);
            unsigned key = cand ? ((__float_as_uint(v) & 0xFFFFFFE0u) | (unsigned)(31 - jb)) : 0u;
            LAS unsigned* kw = (LAS unsigned*)(L + NL_KS2) + w * 64;
            kw[lane] = key;
            const LAS u32x4* kr4 = (const LAS u32x4*)(kw + 32 * qsel);
            int rank = 0;
#pragma unroll
            for (int q4 = 0; q4 < 8; ++q4) { const u32x4 kk = kr4[q4]; rank += (kk.x > key) + (kk.y > key) + (kk.z > key) + (kk.w > key); }
            const unsigned long long bal = __ballot(key != 0u && rank < nsel);
            const unsigned mask = forced | (qsel ? (unsigned)(bal >> 32) : (unsigned)bal);
            if (jb == 0) selm[qi] = mask;
            uacc |= mask; }
        uacc |= (unsigned)__shfl_xor((int)uacc, 32);
        if (lane == 0) __hip_atomic_fetch_or(selm + 64, uacc, __ATOMIC_RELAXED, __HIP_MEMORY_SCOPE_WORKGROUP);
    }
    __syncthreads();
    NSTAMP(1);
    const unsigned mymask = selm[qh * 32 + r32], uni = selm[64];
    const int jw0 = qb >= 4 ? qb - 4 : 0;
    {
        float m_run = -3.0e38f, l_run = 0.f; f32x16 os[4];
#ifdef NSA_DBL_SEL
        for (int rep_ = 0; rep_ < 2; ++rep_) {
        m_run = -3.0e38f; l_run = 0.f; __syncthreads();
#endif
#pragma unroll
        for (int dt = 0; dt < 4; ++dt) os[dt] = (f32x16){};
        unsigned todo = uni & (qb >= 31 ? 0xffffffffu : ((2u << qb) - 1u));
        int cur = 0;
        int j = __builtin_ctz(todo);
        if (j != 0) tile_fetch(R, kvb + (size_t)2 * 4194304 + (size_t)j * 64 * 256, kvb + (size_t)3 * 4194304 + (size_t)j * 64 * 256, tid);
        while (todo) {
            todo &= todo - 1u;
            LAS unsigned char* Kb = L + (cur ? NL_KS2 : NL_KS); LAS unsigned char* Vb = L + (cur ? NL_VS2 : NL_VS);
            tile_commit(R, Kb, Vb, tid);
            __syncthreads();
            const int jn = todo ? __builtin_ctz(todo) : j;
            if (todo) tile_fetch(R, kvb + (size_t)2 * 4194304 + (size_t)jn * 64 * 256, kvb + (size_t)3 * 4194304 + (size_t)jn * 64 * 256, tid);
            else tile_fetch(R, kvb + (size_t)4 * 4194304 + (size_t)jw0 * 64 * 256, kvb + (size_t)5 * 4194304 + (size_t)jw0 * 64 * 256, tid);
            const bool selq = (mymask >> j) & 1u;
            if (__any(selq)) attn_tile<0>(Kb, Vb, qf, t, j * 64, selq, j < qb, m_run, l_run, os, lane);
            j = jn; cur ^= 1;
        }
#ifdef NSA_DBL_SEL
        }
#endif
        const float f = l_run > 0.f ? gs_ / l_run : 0.f;
        emit_branch<1>(yq, L + NL_KC + w * 8192, os, f, hi, lane);
    }
    NSTAMP(2);
    {
        float m_run = -3.0e38f, l_run = 0.f; f32x16 os[4];
#pragma unroll
        for (int dt = 0; dt < 4; ++dt) os[dt] = (f32x16){};
#ifdef NSA_DBL_WIN
        for (int rep_ = 0; rep_ < 2; ++rep_) {
        m_run = -3.0e38f; l_run = 0.f;
#pragma unroll
        for (int dt = 0; dt < 4; ++dt) os[dt] = (f32x16){};
#endif
        int cur = 0;
        const int j0 = jw0;
        __syncthreads();
        for (int j = j0; j <= qb; ++j) {
            LAS unsigned char* Kb = L + (cur ? NL_KS2 : NL_KS); LAS unsigned char* Vb = L + (cur ? NL_VS2 : NL_VS);
            tile_commit(R, Kb, Vb, tid);
            __syncthreads();
            if (j < qb) tile_fetch(R, kvb + (size_t)4 * 4194304 + (size_t)(j + 1) * 64 * 256, kvb + (size_t)5 * 4194304 + (size_t)(j + 1) * 64 * 256, tid);
            attn_tile<1>(Kb, Vb, qf, t, j * 64, true, j < qb && j + 4 > qb, m_run, l_run, os, lane);
            cur ^= 1;
        }
#ifdef NSA_DBL_WIN
        }
#endif
        const float f = l_run > 0.f ? gw_ / l_run : 0.f;
        emit_branch<2>(yq, L + NL_KC + w * 8192, os, f, hi, lane);
    }
    NSTAMP(3);
    __syncthreads();
}

constexpr int S136 = 272, S72 = 144, S264 = 528;
constexpr int GD_QN = 0, GD_KN = 17408, GD_T = 34816, GD_QK = 44032, GD_X = 53248  , GD_WN = 88064, GD_Y = 105472  , GD_SC = 123904;
constexpr int GD_WT = GD_SC + 1024;
constexpr int GD_END = GD_WT + 6144;
template <int STR> __device__ __forceinline__ bf16x8 trfrag_nat(const LAS unsigned char* base, int krow0, int col0, int lane) {
    const LAS unsigned char* p = base + (krow0 + 8 * (lane >> 5) + ((lane & 15) >> 2)) * STR + (col0 + 16 * ((lane >> 4) & 1) + 4 * (lane & 3)) * 2;
    const v4i16_t lo = __builtin_amdgcn_ds_read_tr16_b64_v4i16((LAS v4i16_t*)p);
    const v4i16_t hi = __builtin_amdgcn_ds_read_tr16_b64_v4i16((LAS v4i16_t*)(p + 4 * STR));
    return (bf16x8){lo[0], lo[1], lo[2], lo[3], hi[0], hi[1], hi[2], hi[3]};
}
__device__ __forceinline__ bf16x8 ld_perm(const LAS unsigned char* rowp  ) {
    const u32x2 a = *(const LAS u32x2*)rowp, b = *(const LAS u32x2*)(rowp + 16);
    u32x4 w; w.x = a.x; w.y = a.y; w.z = b.x; w.w = b.y; return __builtin_bit_cast(bf16x8, w);
}
template <int STR> __device__ __forceinline__ bf16x8 trfrag_perm(const LAS unsigned char* base, int krow0, int col0, int lane) {
    const LAS unsigned char* p = base + (krow0 + 4 * (lane >> 5) + ((lane & 15) >> 2)) * STR + (col0 + 16 * ((lane >> 4) & 1) + 4 * (lane & 3)) * 2;
    const v4i16_t lo = __builtin_amdgcn_ds_read_tr16_b64_v4i16((LAS v4i16_t*)p);
    const v4i16_t hi = __builtin_amdgcn_ds_read_tr16_b64_v4i16((LAS v4i16_t*)(p + 8 * STR));
    return (bf16x8){lo[0], lo[1], lo[2], lo[3], hi[0], hi[1], hi[2], hi[3]};
}
constexpr size_t WS_TINV = WS_FREE;
constexpr size_t WS_QKG = WS_FREE + 16 * MiB;
constexpr size_t WS_SCG = WS_W1T;
constexpr size_t WS_EGL = WS_W1T + 2 * MiB;
constexpr int TP_STRIDE = 17920;
constexpr int TP_T = 6400, TP_GC = 15616;
__device__ __forceinline__ void phase_tprep(const Params& p, const Ctx& C) {
    int lane0 = C.lane(); asm volatile("" : "+v"(lane0));
    for (int ch = C.gw; ch < 2048; ch += C.ngw) {
        int lane_ = lane0; asm volatile("" : "+v"(lane_));
        const int lane = lane_, r32 = lane & 31, hi = lane >> 5;
        LAS unsigned char* Wb = C.lds + C.wave * TP_STRIDE;
        LAS float* Adg = (LAS float*)Wb; LAS unsigned char* Tb = Wb + TP_T; LAS float* GCs = (LAS float*)(Wb + TP_GC); LAS float* BTs = GCs + 64;
        const int b = ch >> 8, h = (ch >> 5) & 7, t0 = 64 * (ch & 31);
        const bf16_t* kn = (const bf16_t*)(p.ws + WS_GK) + ((size_t)b * SEQ + t0) * 1024 + h * 128 + 8 * hi;
        const bf16_t* qn = (const bf16_t*)(p.ws + WS_GQ) + ((size_t)b * SEQ + t0) * 1024 + h * 128 + 8 * hi;
        bf16x8 kf[2][8], qf[2][8];
#pragma unroll
        for (int rt = 0; rt < 2; ++rt)
#pragma unroll
            for (int s = 0; s < 8; ++s) kf[rt][s] = *(const bf16x8*)(kn + (size_t)(32 * rt + r32) * 1024 + 16 * s);
#pragma unroll
        for (int rt = 0; rt < 2; ++rt)
#pragma unroll
            for (int s = 0; s < 8; ++s) qf[rt][s] = *(const bf16x8*)(qn + (size_t)(32 * rt + r32) * 1024 + 16 * s);
        const float* ab = (const float*)(p.ws + WS_LG) + ((size_t)b * SEQ + t0 + lane) * 40;
        float gcv; const float beta = sigmoidf_(ab[h]);
        { const float z = ab[8 + h] + p.in[6][h]; gcv = -__expf(p.in[5][h]) * (fmaxf(z, 0.f) + log1pf(__expf(-fabsf(z)))); }
#pragma unroll
        for (int o = 1; o < 64; o <<= 1) { const float n = __shfl_up(gcv, o); if (lane >= o) gcv += n; }
        GCs[lane] = gcv; BTs[lane] = beta;
        { const float gl = __shfl(gcv, 63); const float eg = __expf(gcv);
          const f32x4 sq = (f32x4){beta * eg, beta, eg, __expf(gl - gcv)};
          __builtin_amdgcn_raw_buffer_store_b128(__builtin_bit_cast(u32x4, sq), __builtin_amdgcn_make_buffer_rsrc(p.ws + WS_SCG, 0, 2 * 1024 * 1024, 0x00020000), (unsigned)(((((b * SEQ + t0 + lane) * 8 + h) * 4)) * 4), 0, 16);
          if (lane == 0) __builtin_amdgcn_raw_buffer_store_b32(__float_as_uint(__expf(gl)), __builtin_amdgcn_make_buffer_rsrc(p.ws + WS_EGL, 0, 8192, 0x00020000), (unsigned)(ch * 4), 0, 16); }
        LDS_WAIT();
        float gL[2]; gL[0] = GCs[r32]; gL[1] = GCs[32 + r32];
        bf16x8 PD[2], PA[2];
#pragma unroll
        for (int tsel = 0; tsel < 3; ++tsel) { const int ti = tsel >= 1 ? 1 : 0, tj = tsel == 2 ? 1 : 0;
            f32x16 acc = (f32x16){};
#pragma unroll
            for (int s = 0; s < 8; ++s) acc = __builtin_amdgcn_mfma_f32_32x32x16_bf16(kf[ti][s], kf[tj][s], acc, 0, 0, 0);
#pragma unroll
            for (int g = 0; g < 4; ++g) { const f32x4 bq = *(const LAS f32x4*)(BTs + 32 * ti + 8 * g + 4 * hi), gq = *(const LAS f32x4*)(GCs + 32 * ti + 8 * g + 4 * hi);
#pragma unroll
                for (int e = 0; e < 4; ++e) acc[4 * g + e] *= __expf(gq[e] - gL[tj]) * bq[e]; }
            if (tsel == 1) { PA[0] = pack8(acc, 0); PA[1] = pack8(acc, 1); }
            else {
                const bool up = r32 >= 16; const int col = r32 & 15;
                LAS float* ad = Adg + (2 * ti + (r32 >> 4)) * 400 + col;
#pragma unroll
                for (int r8 = 0; r8 < 8; ++r8) { const int row = crow(r8, hi); const float dv = up ? acc[8 + r8] : acc[r8]; ad[row * 24] = (row > col) ? dv : 0.f; }
#pragma unroll
                for (int r8 = 0; r8 < 8; ++r8) acc[8 + r8] = up ? 0.f : acc[8 + r8];
                PD[ti] = pack8(acc, 1);
            }
            __builtin_amdgcn_sched_barrier(0); }
        {
            const __amdgpu_buffer_rsrc_t qrs = __builtin_amdgcn_make_buffer_rsrc(p.ws + WS_QKG, 0, 16 * 1024 * 1024, 0x00020000);
            unsigned qko = (unsigned)((ch * 4096 + r32 * 64 + 4 * hi) * 2); asm volatile("" : "+v"(qko));
#pragma unroll
            for (int tsel = 0; tsel < 3; ++tsel) { const int ti = tsel >= 1 ? 1 : 0, tj = tsel == 2 ? 1 : 0;
                f32x16 acc = (f32x16){};
#pragma unroll
                for (int s = 0; s < 8; ++s) acc = __builtin_amdgcn_mfma_f32_32x32x16_bf16(kf[tj][s], qf[ti][s], acc, 0, 0, 0);
                const int i = 32 * ti + r32;
#pragma unroll
                for (int g = 0; g < 4; ++g) { float v[4]; const f32x4 gq = *(const LAS f32x4*)(GCs + 32 * tj + 8 * g + 4 * hi);
#pragma unroll
                    for (int e = 0; e < 4; ++e) { const int j = 32 * tj + 8 * g + 4 * hi + e; const float x = acc[4 * g + e] * __expf(gL[ti] - gq[e]); v[e] = (i >= j) ? x : 0.f; }
                    __builtin_amdgcn_raw_buffer_store_b64((u32x2){cvtpk(v[0], v[1]), cvtpk(v[2], v[3])}, qrs, qko + (unsigned)(((32 * ti) * 64 + 32 * tj + 8 * g) * 2), 0, 16); }
                __builtin_amdgcn_sched_barrier(0); }
        }
        LDS_WAIT();
        {
            const int d = lane >> 4, c = lane & 15;
            const LAS float* Ad = Adg + d * 400; asm volatile("" : "+v"(Ad));
            float t[16];
#pragma unroll
            for (int i = 0; i < 16; ++i) { float a = (c == i) ? 1.f : 0.f;
#pragma unroll
                for (int q = 0; q < (i + 3) / 4; ++q) { const f32x4 rr = *(const LAS f32x4*)(Ad + i * 24 + 4 * q);
#pragma unroll
                    for (int e = 0; e < 4; ++e) if (4 * q + e < i) a -= rr[e] * t[4 * q + e]; }
                t[i] = a; }
            LAS bf16_t* tw = (LAS bf16_t*)Tb + (16 * d) * 72 + 16 * d + c; LAS bf16_t* tz = (LAS bf16_t*)Tb + (16 * d) * 72 + 16 * (d ^ 1) + c;
#pragma unroll
            for (int i = 0; i < 16; ++i) { tw[i * 72] = f2bf(t[i]); tz[i * 72] = (bf16_t)0; }
            LAS unsigned char* z = Tb + (lane >> 1) * S72 + 64 + 32 * (lane & 1);
            *(LAS u32x4*)z = (u32x4){0u, 0u, 0u, 0u}; *(LAS u32x4*)(z + 16) = (u32x4){0u, 0u, 0u, 0u};
        }
#pragma unroll
        for (int pb = 0; pb < 2; ++pb) {
            const f32x16 W = __builtin_amdgcn_mfma_f32_32x32x16_bf16(PD[pb], ld_perm(Tb + (32 * pb + r32) * S72 + (32 * pb + 16) * 2 + 8 * hi), (f32x16){}, 0, 0, 0);
            const f32x16 R = __builtin_amdgcn_mfma_f32_32x32x16_bf16(trfrag_perm<S72>(Tb, 32 * pb, 32 * pb, lane), pack8(W, 0), (f32x16){}, 0, 0, 0);
            if (r32 >= 16) { LAS unsigned char* o = Tb + (32 * pb + r32) * S72 + (32 * pb + 4 * hi) * 2;
                *(LAS u32x2*)o = (u32x2){cvtpk(-R[0], -R[1]), cvtpk(-R[2], -R[3])}; *(LAS u32x2*)(o + 16) = (u32x2){cvtpk(-R[4], -R[5]), cvtpk(-R[6], -R[7])}; }
        }
        {
            f32x16 W = __builtin_amdgcn_mfma_f32_32x32x16_bf16(PA[0], ld_perm(Tb + (32 + r32) * S72 + 64 + 8 * hi), (f32x16){}, 0, 0, 0);
            W = __builtin_amdgcn_mfma_f32_32x32x16_bf16(PA[1], ld_perm(Tb + (32 + r32) * S72 + 96 + 8 * hi), W, 0, 0, 0);
            f32x16 R = __builtin_amdgcn_mfma_f32_32x32x16_bf16(trfrag_perm<S72>(Tb, 0, 0, lane), pack8(W, 0), (f32x16){}, 0, 0, 0);
            R = __builtin_amdgcn_mfma_f32_32x32x16_bf16(trfrag_perm<S72>(Tb, 16, 0, lane), pack8(W, 1), R, 0, 0, 0);
            LAS unsigned char* o = Tb + (32 + r32) * S72 + 8 * hi;
#pragma unroll
            for (int g = 0; g < 4; ++g) *(LAS u32x2*)(o + 16 * g) = (u32x2){cvtpk(-R[4 * g], -R[4 * g + 1]), cvtpk(-R[4 * g + 2], -R[4 * g + 3])};
        }
        {
            const __amdgpu_buffer_rsrc_t trs = __builtin_amdgcn_make_buffer_rsrc(p.ws + WS_TINV, 0, 16 * 1024 * 1024, 0x00020000);
            const unsigned to = (unsigned)((ch * 4096 + (lane >> 3) * 64 + 8 * (lane & 7)) * 2);
            const LAS unsigned char* tr = Tb + (lane >> 3) * S72 + 16 * (lane & 7);
#pragma unroll
            for (int it = 0; it < 8; ++it) __builtin_amdgcn_raw_buffer_store_b128(*(const LAS u32x4*)(tr + it * 8 * S72), trs, to + it * 1024, 0, 16);
        }
        asm volatile("s_waitcnt vmcnt(0)" ::: "memory");
        LDS_WAIT();
    }
}
constexpr int G2_KN = 0, G2_QN = 17408, G2_V = 34816, G2_QK = 52224, G2_T = 61440, G2_O0 = 70656, G2_O1 = 88064, G2_SC = 105472;
__device__ __forceinline__ void gdn_item(const Params& p, const Ctx& C, int b, int h, bool store_out = true) {
    int lane0 = C.lane(); asm volatile("" : "+v"(lane0));
    const int w = C.wave; const bool chain = w < 4;
    LAS unsigned char* L = C.lds; unsigned char* ws = p.ws;
    LAS float* SC = (LAS float*)(L + G2_SC);
    const bf16_t* Tsrc = (const bf16_t*)(ws + WS_TINV) + (size_t)((b * 8 + h) * 32) * 4096;
    const bf16_t* Qsrc = (const bf16_t*)(ws + WS_QKG) + (size_t)((b * 8 + h) * 32) * 4096;
    const float* scg = (const float*)(ws + WS_SCG) + ((size_t)b * SEQ * 8 + h) * 4;
    const float* eglp = (const float*)(ws + WS_EGL) + (b * 8 + h) * 32;
    bf16_t* zrow = (bf16_t*)(ws + WS_Z) + (size_t)b * SEQ * 1024 + h * 128;
    wg_wait_count((const unsigned*)(ws + WS_CTL) + CW_GRDY + 16 * (b * 8 + h), 4u, w);
    f32x16 S[4]; S[0] = (f32x16){}; S[1] = (f32x16){}; S[2] = (f32x16){}; S[3] = (f32x16){};
    u32x4 raw[12], rqk[2], rt_[2]; f32x4 rsc = (f32x4){0.f, 0.f, 0.f, 0.f}; float regl = 0.f;
    auto fetch = [&](int c0, int t4) {
#pragma unroll
        for (int i = 0; i < 12; ++i) { const int idx = t4 + 256 * i, c = idx / 48, oct = idx % 48;
            raw[i] = *(const u32x4*)((const bf16_t*)(ws + WS_GQ + (size_t)(oct >> 4) * 32 * MiB) + ((size_t)b * SEQ + c0 * 64 + c) * 1024 + h * 128 + 8 * (oct & 15)); }
#pragma unroll
        for (int i = 0; i < 2; ++i) { rqk[i] = *(const u32x4*)(Qsrc + (size_t)c0 * 4096 + (size_t)(t4 + 256 * i) * 8); rt_[i] = *(const u32x4*)(Tsrc + (size_t)c0 * 4096 + (size_t)(t4 + 256 * i) * 8); }
        if (t4 < 64) rsc = *(const f32x4*)(scg + (size_t)(c0 * 64 + t4) * 32);
        regl = eglp[c0];
    };
    auto commit = [&](int t4) {
#pragma unroll
        for (int i = 0; i < 12; ++i) { const int idx = t4 + 256 * i, c = idx / 48, oct = idx % 48, sg = oct >> 4, chl = 8 * (oct & 15);
            *(LAS u32x4*)(L + (sg == 0 ? G2_QN : (sg == 1 ? G2_KN : G2_V)) + c * S136 + chl * 2) = raw[i]; }
#pragma unroll
        for (int i = 0; i < 2; ++i) { const int idx = t4 + 256 * i; *(LAS u32x4*)(L + G2_QK + (idx >> 3) * S72 + (idx & 7) * 16) = rqk[i]; *(LAS u32x4*)(L + G2_T + (idx >> 3) * S72 + (idx & 7) * 16) = rt_[i]; }
        if (t4 < 64) { SC[t4] = rsc[1]; SC[64 + t4] = rsc[2]; SC[128 + t4] = rsc[3]; }
        if (t4 == 0) SC[192] = regl;
    };
    if (chain) {
        __syncthreads();
        for (int c0 = 0; c0 < SEQ / 64; ++c0) {
            int lane_ = lane0; asm volatile("" : "+v"(lane_));
            const int lane = lane_, r32 = lane & 31, hi = lane >> 5;
            const int e0 = 32 * w;
            f32x16 M[2], Y[2];
            M[0] = (f32x16){}; M[1] = (f32x16){}; Y[0] = (f32x16){}; Y[1] = (f32x16){};
            { const LAS unsigned char* kr = L + G2_KN + r32 * S136 + 8 * hi; const LAS unsigned char* qr = L + G2_QN + r32 * S136 + 8 * hi;
              bf16x8 cf[4], nf[4];
              cf[0] = ld_perm(kr); cf[1] = ld_perm(kr + 32 * S136); cf[2] = ld_perm(qr); cf[3] = ld_perm(qr + 32 * S136);
#pragma unroll
              for (int s = 0; s < 8; ++s) {
                  if (s < 7) { nf[0] = ld_perm(kr + 32 * (s + 1)); nf[1] = ld_perm(kr + 32 * S136 + 32 * (s + 1)); nf[2] = ld_perm(qr + 32 * (s + 1)); nf[3] = ld_perm(qr + 32 * S136 + 32 * (s + 1)); }
                  const bf16x8 sb = pack8(S[s >> 1], s & 1);
                  __builtin_amdgcn_sched_barrier(0);
                  M[0] = __builtin_amdgcn_mfma_f32_32x32x16_bf16(cf[0], sb, M[0], 0, 0, 0); M[1] = __builtin_amdgcn_mfma_f32_32x32x16_bf16(cf[1], sb, M[1], 0, 0, 0);
                  Y[0] = __builtin_amdgcn_mfma_f32_32x32x16_bf16(cf[2], sb, Y[0], 0, 0, 0); Y[1] = __builtin_amdgcn_mfma_f32_32x32x16_bf16(cf[3], sb, Y[1], 0, 0, 0);
                  __builtin_amdgcn_sched_barrier(0);
                  if (s < 7) { cf[0] = nf[0]; cf[1] = nf[1]; cf[2] = nf[2]; cf[3] = nf[3]; } } }
            bf16x8 vfr[2][2];
#pragma unroll
            for (int rt = 0; rt < 2; ++rt)
#pragma unroll
                for (int s2 = 0; s2 < 2; ++s2) vfr[rt][s2] = trfrag_perm<S136>(L + G2_V, 32 * rt + 16 * s2, e0, lane);
#pragma unroll
            for (int rt = 0; rt < 2; ++rt)
#pragma unroll
                for (int r = 0; r < 16; ++r) { const int c = 32 * rt + crow(r, hi); const float eg = SC[64 + c];
                    const float v = bf2f((bf16_t)vfr[rt][r >> 3][r & 7]);
                    M[rt][r] = SC[c] * (v - eg * M[rt][r]); Y[rt][r] *= eg; }
            f32x16 Vn[2];
            { const bf16x8 m0 = pack8(M[0], 0), m1 = pack8(M[0], 1), m2 = pack8(M[1], 0), m3 = pack8(M[1], 1);
              const LAS unsigned char* t0 = L + G2_T + r32 * S72 + 8 * hi; const LAS unsigned char* t1 = L + G2_T + (32 + r32) * S72 + 8 * hi;
              Vn[0] = __builtin_amdgcn_mfma_f32_32x32x16_bf16(ld_perm(t0), m0, (f32x16){}, 0, 0, 0); Vn[0] = __builtin_amdgcn_mfma_f32_32x32x16_bf16(ld_perm(t0 + 32), m1, Vn[0], 0, 0, 0);
              Vn[1] = __builtin_amdgcn_mfma_f32_32x32x16_bf16(ld_perm(t1), m0, (f32x16){}, 0, 0, 0); Vn[1] = __builtin_amdgcn_mfma_f32_32x32x16_bf16(ld_perm(t1 + 32), m1, Vn[1], 0, 0, 0);
              Vn[1] = __builtin_amdgcn_mfma_f32_32x32x16_bf16(ld_perm(t1 + 64), m2, Vn[1], 0, 0, 0); Vn[1] = __builtin_amdgcn_mfma_f32_32x32x16_bf16(ld_perm(t1 + 96), m3, Vn[1], 0, 0, 0); }
            { const bf16x8 v0 = pack8(Vn[0], 0), v1 = pack8(Vn[0], 1), v2 = pack8(Vn[1], 0), v3 = pack8(Vn[1], 1);
              const LAS unsigned char* q0 = L + G2_QK + r32 * S72 + 8 * hi; const LAS unsigned char* q1 = L + G2_QK + (32 + r32) * S72 + 8 * hi;
              Y[0] = __builtin_amdgcn_mfma_f32_32x32x16_bf16(ld_perm(q0), v0, Y[0], 0, 0, 0); Y[0] = __builtin_amdgcn_mfma_f32_32x32x16_bf16(ld_perm(q0 + 32), v1, Y[0], 0, 0, 0);
              Y[1] = __builtin_amdgcn_mfma_f32_32x32x16_bf16(ld_perm(q1), v0, Y[1], 0, 0, 0); Y[1] = __builtin_amdgcn_mfma_f32_32x32x16_bf16(ld_perm(q1 + 32), v1, Y[1], 0, 0, 0);
              Y[1] = __builtin_amdgcn_mfma_f32_32x32x16_bf16(ld_perm(q1 + 64), v2, Y[1], 0, 0, 0); Y[1] = __builtin_amdgcn_mfma_f32_32x32x16_bf16(ld_perm(q1 + 96), v3, Y[1], 0, 0, 0); }
#pragma unroll
            for (int rt = 0; rt < 2; ++rt)
#pragma unroll
                for (int r = 0; r < 16; ++r) Vn[rt][r] *= SC[128 + 32 * rt + crow(r, hi)];
            { const bf16x8 v0 = pack8(Vn[0], 0), v1 = pack8(Vn[0], 1), v2 = pack8(Vn[1], 0), v3 = pack8(Vn[1], 1); const float egl = SC[192];
#pragma unroll
              for (int dt = 0; dt < 4; ++dt) { S[dt] = S[dt] * egl;
                  S[dt] = __builtin_amdgcn_mfma_f32_32x32x16_bf16(trfrag_perm<S136>(L + G2_KN, 0, 32 * dt, lane), v0, S[dt], 0, 0, 0); S[dt] = __builtin_amdgcn_mfma_f32_32x32x16_bf16(trfrag_perm<S136>(L + G2_KN, 16, 32 * dt, lane), v1, S[dt], 0, 0, 0);
                  S[dt] = __builtin_amdgcn_mfma_f32_32x32x16_bf16(trfrag_perm<S136>(L + G2_KN, 32, 32 * dt, lane), v2, S[dt], 0, 0, 0); S[dt] = __builtin_amdgcn_mfma_f32_32x32x16_bf16(trfrag_perm<S136>(L + G2_KN, 48, 32 * dt, lane), v3, S[dt], 0, 0, 0);
                  if (dt & 1) __builtin_amdgcn_sched_barrier(0); } }
            { LAS unsigned char* Ob = L + ((c0 & 1) ? G2_O1 : G2_O0) + (e0 + r32) * 2;
#pragma unroll
              for (int rt = 0; rt < 2; ++rt)
#pragma unroll
                  for (int r = 0; r < 16; ++r) *(LAS bf16_t*)(Ob + (32 * rt + crow(r, hi)) * S136) = f2bf(Y[rt][r]); }
            __syncthreads();
            __syncthreads();
        }
    } else {
        const int t4 = (w - 4) * 64 + lane0;
        const f32x4 nwa = *(const f32x4*)(p.in[7] + 8 * (lane0 & 15)), nwb = *(const f32x4*)(p.in[7] + 8 * (lane0 & 15) + 4);
        float tv[16]; LAS float* cscr = (LAS float*)(L + G2_SC + 1024 + (w - 4) * 4224);
        const int cbase = ((b * 8 + h) * 4 + (w - 4)) * 32;
        auto conv_finish = [&](int si, int lane) {
            const int ex = si >> 8, k0 = ((si & 255) >> 5) * 32, n0 = (si & 31) * 32;
#pragma unroll
            for (int i = 0; i < 16; ++i) cscr[(2 * i + (lane >> 5)) * 33 + (lane & 31)] = tv[i];
            bf16_t* wt = (bf16_t*)(ws + wdt_off(ex));
#pragma unroll
            for (int jj = 0; jj < 2; ++jj) { const int idx = lane + 64 * jj, n = idx >> 2, cq = idx & 3; const LAS float* s = cscr + (8 * cq) * 33 + n;
                u32x4 o; o.x = cvtpk(s[0 * 33], s[1 * 33]); o.y = cvtpk(s[2 * 33], s[3 * 33]); o.z = cvtpk(s[4 * 33], s[5 * 33]); o.w = cvtpk(s[6 * 33], s[7 * 33]);
                if (store_out) *(u32x4*)(wt + (size_t)(n0 + n) * 256 + k0 + 8 * cq) = o; else asm volatile("" :: "v"(o)); } };
        u32x4 zq[4];
        fetch(0, t4); commit(t4); if (SEQ / 64 > 1) fetch(1, t4);
        __syncthreads();
        for (int c0 = 0; c0 <= SEQ / 64; ++c0) {
            int lane_ = lane0; asm volatile("" : "+v"(lane_));
            const int lane = lane_, tq = lane >> 4, cl = lane & 15;
            if (c0 > 0) { const LAS unsigned char* Ob = L + (((c0 - 1) & 1) ? G2_O1 : G2_O0); const int t0p = (c0 - 1) * 64;
#pragma unroll
                for (int it = 0; it < 4; ++it) { const int tl = (w - 4) * 16 + 4 * it + tq;
                    const u32x4 ov = *(const LAS u32x4*)(Ob + tl * S136 + 16 * cl); const u32x4 zv = zq[it];
                    float o[8] = {bflo(ov.x), bfhi(ov.x), bflo(ov.y), bfhi(ov.y), bflo(ov.z), bfhi(ov.z), bflo(ov.w), bfhi(ov.w)};
                    const float z[8] = {bflo(zv.x), bfhi(zv.x), bflo(zv.y), bfhi(zv.y), bflo(zv.z), bfhi(zv.z), bflo(zv.w), bfhi(zv.w)};
                    float ss = 0.f;
#pragma unroll
                    for (int q = 0; q < 8; ++q) ss += o[q] * o[q];
                    const float rstd = rsqrtf(sum16(ss) * (1.f / 128.f) + RMS_EPS);
                    float y[8];
#pragma unroll
                    for (int q = 0; q < 8; ++q) y[q] = o[q] * rstd * (q < 4 ? nwa[q] : nwb[q - 4]) * siluf_(z[q]);
                    u32x4 yo; yo.x = cvtpk(y[0], y[1]); yo.y = cvtpk(y[2], y[3]); yo.z = cvtpk(y[4], y[5]); yo.w = cvtpk(y[6], y[7]);
                    if (store_out) *(u32x4*)(zrow + (size_t)(t0p + tl) * 1024 + 8 * cl) = yo; else asm volatile("" :: "v"(yo)); } }
            if (c0 == SEQ / 64) break;
#pragma unroll
            for (int it = 0; it < 4; ++it) zq[it] = *(const u32x4*)(zrow + (size_t)(c0 * 64 + (w - 4) * 16 + 4 * it + tq) * 1024 + 8 * cl);
            __syncthreads();
            if (c0 + 1 < SEQ / 64) commit(t4);
            __syncthreads();
            if (c0 + 2 < SEQ / 64) fetch(c0 + 2, t4);
            if (c0 > 0) conv_finish(cbase + c0 - 1, lane);
            { const int si = cbase + c0, ex = si >> 8, k0 = ((si & 255) >> 5) * 32, n0 = (si & 31) * 32;
              const float* wsrc = p.in[26] + (size_t)ex * 256 * 1024 + (size_t)k0 * 1024 + n0 + (lane & 31) + (size_t)(lane >> 5) * 1024;
#pragma unroll
              for (int i = 0; i < 16; ++i) tv[i] = wsrc[(size_t)(2 * i) * 1024]; }
        }
        conv_finish(cbase + SEQ / 64 - 1, lane0);
    }
    __syncthreads();
}

__device__ __forceinline__ void phase_mixer(const Params& p, const Ctx& C) {
    unsigned* q = (unsigned*)(p.ws + WS_CTL) + CW_QUEUE;
    LAS int* itemw = (LAS int*)(C.lds + MIX_ITEM_OFF);
#if !defined(NO_GDN) && !defined(GDN_LAST)
#ifdef GDN_TWICE
    if (blockIdx.x < 64) { const int item = blockIdx.x; gdn_item(p, C, item >> 3, item & 7, false); }
#endif
    if (blockIdx.x < 64) { const int item = blockIdx.x; gdn_item(p, C, item >> 3, item & 7); }
#endif
    {
        if (C.wave == 0) { const int l = C.lane(); const unsigned* cr = (const unsigned*)(p.ws + WS_CTL) + CW_C2RDY; unsigned sp = 0;
            for (;;) { const unsigned v = l < 8 ? __hip_atomic_load(cr + 16 * l, __ATOMIC_RELAXED, __HIP_MEMORY_SCOPE_AGENT) : 2u; if (__all(v >= 2u)) break; __builtin_amdgcn_s_sleep(2); if (++sp > (1u << 22)) break; }
            __builtin_amdgcn_fence(__ATOMIC_ACQUIRE, "agent"); asm volatile("s_waitcnt vmcnt(0)" ::: "memory"); }
        __syncthreads(); }
    for (int it = 0;; ++it) {
        if (C.tid() == 0) *itemw = (int)atomicAdd(q, 1u);
        __syncthreads();
        const int k = *itemw;
        __syncthreads();
        if (k >= 512) break;
#ifndef NO_NSA
        nsa_item(p, C, (k & 15) >> 1, k & 1, 31 - (k >> 4));
#endif
    }
#ifdef GDN_LAST
    if (blockIdx.x < 64) { const int item = blockIdx.x; gdn_item(p, C, item >> 3, item & 7); }
#endif
}
#ifndef MK_N_LAUNCHES
#define MK_N_LAUNCHES 1
#endif
constexpr int N_PHASES = 19;
constexpr int LDS_TILEE = LDS_SCR + 16 * 1024;

#define XB_TMO      128
#define XB_XCNT(j)  (256  + 64 * (j))
#define XB_XSUB(j)  (1280 + 64 * (j))
#define XB_XGEN(j)  (2304 + 64 * (j))
#define XB_TOP      3328
#define XB_TOPGEN   3392
#define XCD_BAR_WORDS 3456
#define XB_SPIN_CAP (1u << 20)
__device__ __forceinline__ unsigned xb_ld(unsigned* p)              { return __hip_atomic_load(p, __ATOMIC_RELAXED, __HIP_MEMORY_SCOPE_AGENT); }
__device__ __forceinline__ unsigned xb_add(unsigned* p, unsigned v) { return __hip_atomic_fetch_add(p, v, __ATOMIC_RELAXED, __HIP_MEMORY_SCOPE_AGENT); }
__device__ __forceinline__ unsigned xb_xcc_id() { return (unsigned)__builtin_amdgcn_s_getreg((3 << 11) | 20) & 0xFu; }
#define XB_SPIN(cond, bar) do { unsigned _sp = 0; while (cond) { __builtin_amdgcn_s_sleep(1); \
    if ((++_sp & 255u) == 0u) { if (xb_ld(&(bar)[XB_TMO])) break; if (_sp > XB_SPIN_CAP) { atomicAdd(&(bar)[XB_TMO], 1u); break; } } } } while (0)
struct XcdBarrier { unsigned* bar; unsigned x; volatile LAS unsigned* st; };
__device__ __forceinline__ XcdBarrier xcd_barrier_post(unsigned* bar, volatile LAS unsigned* st, int tid) {
    XcdBarrier b; b.bar = bar; b.x = xb_xcc_id(); b.st = st;
    if (tid == 0) (void)xb_add(&bar[XB_XCNT(b.x)], 1u);
    return b;
}
__device__ __forceinline__ void xcd_barrier_complete(unsigned* bar, unsigned x, unsigned& nloc, unsigned& nx) {
    const unsigned G = gridDim.x;
    unsigned sum, cnt, mine, sp = 0u;
    for (;;) {
        sum = 0u; cnt = 0u; mine = 0u;
#pragma unroll
        for (unsigned j = 0; j < 16; ++j) { const unsigned c = xb_ld(&bar[XB_XCNT(j)]); sum += c; cnt += (c > 0u) ? 1u : 0u; mine = (j == x) ? c : mine; }
        if (sum == G) break;
        __builtin_amdgcn_s_sleep(1);
        if ((++sp & 255u) == 0u) { if (xb_ld(&bar[XB_TMO])) break; if (sp > XB_SPIN_CAP) { atomicAdd(&bar[XB_TMO], 1u); break; } }
    }
    nloc = mine > 0u ? mine : 1u; nx = cnt > 0u ? cnt : 1u;
}
__device__ __forceinline__ void xcd_barrier(const XcdBarrier& b, int tid) {
    asm volatile("s_waitcnt vmcnt(0)" ::: "memory");
    __syncthreads();
    if (tid == 0) {
        unsigned* bar = b.bar;
        __builtin_amdgcn_s_waitcnt(0);
        unsigned nloc = b.st[0], nx = b.st[1];
        if (nloc == 0u) { xcd_barrier_complete(bar, b.x, nloc, nx); b.st[0] = nloc; b.st[1] = nx; }
        const unsigned old = xb_add(&bar[XB_XSUB(b.x)], 1u);
        const unsigned gen = old / nloc;
        if (old + 1u == (gen + 1u) * nloc) {
            __builtin_amdgcn_fence(__ATOMIC_RELEASE, "agent");
            asm volatile("s_waitcnt vmcnt(0)" ::: "memory");
            const unsigned og = xb_add(&bar[XB_TOP], 1u);
            const unsigned tg = og / nx;
            if (og + 1u == (tg + 1u) * nx) xb_add(&bar[XB_TOPGEN], 1u);
            else XB_SPIN(xb_ld(&bar[XB_TOPGEN]) == tg, bar);
            __builtin_amdgcn_fence(__ATOMIC_ACQUIRE, "agent");
            xb_add(&bar[XB_XGEN(b.x)], 1u);
            asm volatile("s_waitcnt vmcnt(0)" ::: "memory");
        } else {
            XB_SPIN(xb_ld(&bar[XB_XGEN(b.x)]) == gen, bar);
            __builtin_amdgcn_fence(__ATOMIC_ACQUIRE, "agent");
            asm volatile("s_waitcnt vmcnt(0)" ::: "memory");
        }
    }
    __syncthreads();
}
constexpr int LDS_MISC = LDS_BYTES - 256;

__global__ void __launch_bounds__(NTHREADS, 2) mega_fwd(Params p) {
    extern __shared__ __attribute__((aligned(16))) unsigned char lds_raw[];
    Ctx C; C.wave = __builtin_amdgcn_readfirstlane((int)threadIdx.x >> 6); C.gw = blockIdx.x * NWAVES + C.wave; C.ngw = gridDim.x * NWAVES; C.lds = (LAS unsigned char*)lds_raw;
    const int G = gridDim.x, bx = blockIdx.x;
    const __attribute__((address_space(4))) Params* kp = (const __attribute__((address_space(4))) Params*)__builtin_amdgcn_kernarg_segment_ptr();
#define PP() (*({ const __attribute__((address_space(4))) Params* q_ = kp; asm volatile("" : "+s"(q_)); (const Params*)q_; }))
    unsigned char* ws = PP().ws; unsigned char* dout = (unsigned char*)PP().out;
    LAS unsigned char* lds = C.lds;
#ifndef DOUBLE_PHASE
#define DOUBLE_PHASE -1
#endif
#define REP(k) for (int rep_ = 0; rep_ < ((k) == DOUBLE_PHASE ? 2 : 1); ++rep_)
#ifdef ONLY_PHASE
#define IN(k) ((k) == ONLY_PHASE)
#else
#define IN(k) (p.ph_lo <= (k) && (k) < p.ph_hi)
#endif
#ifdef DOUBLE_BARRIER
#define SEAM(k) do { if (IN(k) && IN((k) + 1)) { xcd_barrier(bar, C.tid()); xcd_barrier(bar, C.tid()); } } while (0)
#else
#define SEAM(k) do { if (IN(k) && IN((k) + 1)) xcd_barrier(bar, C.tid()); } while (0)
#endif
    volatile LAS unsigned* misc = (volatile LAS unsigned*)(lds + LDS_MISC);
    { const int t_ = C.tid(); if (t_ < 64) misc[t_] = 0u; }
    __syncthreads();
    XcdBarrier bar; bar.bar = (unsigned*)(ws + WS_CTL) + CW_BAR; bar.x = 0; bar.st = misc;
    if (p.ph_hi - p.ph_lo > 1) bar = xcd_barrier_post((unsigned*)(ws + WS_CTL) + CW_BAR, misc, C.tid());

    if (IN(0)) REP(0) phase0(PP(), C);
    SEAM(0);
    if (IN(1)) REP(1) {
        { ProbDense P = mk_dense(dout + DO_XB, ws + WS_W1T, 1024, 1024, 1024); pg8::StaticOrder S; S.init(NTOK, 6656, G, bx); EpiProj1 E{ws, dout, PP().positions}; pg8::gemm_phase(lds, C.wave, P, S, E); }
        { ProbDense P = mk_dense(ws + WS_FREE, ws + WS_WKVT, 1024, 1024, 1024); pg8::StaticOrder S; S.init(2048, 2048, 64, (bx >= 128 && bx < 192) ? bx - 128 : -1);
          EpiKvx E{(bf16_t*)(ws + WS_KX), (bf16_t*)(ws + WS_VT)}; pg8::gemm_phase(lds, C.wave, P, S, E); }
        { ProbDense P = mk_dense(dout + DO_XB, ws + WS_W1T + (size_t)6656 * 2048, 1024, 1024, 1024); pg8::StaticOrder S; S.init(NTOK, 256, 64, bx >= 192 ? bx - 192 : -1);
          EpiSmall E{(float*)(ws + WS_LG)}; pg8::gemm_phase(lds, C.wave, P, S, E); }
    }
    SEAM(1);
    if (IN(3)) {
        if (DOUBLE_PHASE == 33 && bx >= 128) conv_pass(PP(), C, (bx - 128) * 8 + C.wave, 1024, 2, false);
        if (bx >= 128) conv_pass(PP(), C, (bx - 128) * 8 + C.wave, 1024, 2); }
    if (IN(3)) {
        unsigned* crdy = (unsigned*)(ws + WS_CTL) + CW_CMP;
        { ProbCompress P; P.KV = (const char*)(ws + WS_KV); P.W = (const char*)(ws + WS_WC1T); P.ldb = 4096 * 2; P.K = 512;
          CmpOrder S; S.init(16, 8, 1, 128, bx < 128 ? bx : -1); S.ready = crdy; S.wave = C.wave; EpiPart E{(bf16_t*)(ws + WS_PART)}; pg8::gemm_phase(lds, C.wave, P, S, E); }
        if (bx < 128) conv_pass(PP(), C, 2048 + bx * 8 + C.wave, 1024, 1);
        else { const int q = bx - 128, cj = q >> 6, cpm = (q >> 3) & 7;
            wg_wait_count(crdy + 16 * (cj * 8 + cpm), 8u, C.wave); combine_rows(PP(), C, cj, 256 * cpm + 32 * (q & 7), 32); }
    }
    SEAM(3);
    if (IN(5)) {
        { ProbDense P = mk_dense(ws + WS_HID, ws + WS_WC2T, 256, 256, 256); P.as1 = (size_t)2048 * 256 * 2; P.bs1 = (size_t)65536 * 2;
          Cmp2Order S; S.init(2, 8, 1, G, bx); S.ready = (unsigned*)(ws + WS_CTL) + CW_C2RDY; S.wave = C.wave; EpiCmp2 E{(bf16_t*)(ws + WS_CMPK)}; pg8::gemm_phase(lds, C.wave, P, S, E); }
        __syncthreads();
        phase_tprep(PP(), C); __syncthreads();
        if (C.tid() == 0) __hip_atomic_fetch_add((unsigned*)(ws + WS_CTL) + CW_GRDY + 16 * (bx >> 2), 1u, __ATOMIC_RELAXED, __HIP_MEMORY_SCOPE_AGENT); }
    if (IN(6)) phase_mixer(PP(), C);
    SEAM(6);
    if (IN(7)) REP(7) {
        phase_moe_weights(PP(), C);
        __syncthreads();
        ProbDense P = mk_dense(dout + DO_XB, ws + WS_W2T, 1024, 1024, 1024); pg8::StaticOrder S; S.init(NTOK, 2048, G, bx);
        EpiMerge E{(const bf16_t*)(ws + WS_Z), (const bf16_t*)(dout + DO_NQ), (bf16_t*)(ws + WS_FREE), (const float*)(ws + WS_SS)}; pg8::gemm_phase(lds, C.wave, P, S, E);
    }
    if (IN(7)) {
        { ProbDense P = mk_dense(ws + WS_KX, ws + WS_WQT, 1024, 1024, 256); P.gsh = 2; P.as1 = (size_t)256 * 2048; P.as2 = 512; P.bs1 = 0; P.bs2 = 512;
          pg8::GroupOrder S; S.init(32, 1, 4, 128, bx < 128 ? bx : -1); EpiStoreBf16 E{(bf16_t*)(ws + WS_H), 1024, 0, (size_t)256 * 1024, 0, 0.0625f}; pg8::gemm_phase(lds, C.wave, P, S, E); }
        { ProbDense P = mk_dense(ws + WS_WXOT, ws + WS_VT, 1024, 1024, 256); P.gsh = 2; P.as1 = 0; P.as2 = 512; P.bs1 = (size_t)256 * 2048; P.bs2 = 512;
          pg8::GroupOrder S; S.init(32, 4, 1, 128, bx >= 128 ? bx - 128 : -1); EpiStoreBf16 E{(bf16_t*)(ws + WS_H) + (size_t)8 * 1024 * 1024, 1024, 2, (size_t)1024 * 1024, 256, 1.f}; pg8::gemm_phase(lds, C.wave, P, S, E); }
    }
    SEAM(7);
    if (IN(8) && DOUBLE_PHASE == 80) { ProbDense P = mk_dense(ws + WS_FREE, ws + WS_WOT, 1024, 1024, 1024); pg8::StaticOrder S; S.init(NTOK, 1024, G, bx);
        EpiStoreBf16 E{(bf16_t*)(ws + WS_Z), 1024, 0, 0, 0, 1.f}; pg8::gemm_phase(lds, C.wave, P, S, E); xcd_barrier(bar, C.tid()); }
    unsigned* pan = (unsigned*)(ws + WS_CTL) + CW_PAN;
    if (IN(8)) REP(8) { ProbDense P = mk_dense(ws + WS_FREE, ws + WS_WOT, 1024, 1024, 1024); PanelStatic S; S.init(NTOK, 1024, G, bx); S.wait = nullptr; S.pub = pan; S.wave = C.wave;
        EpiLnFused E{nullptr, (const bf16_t*)(dout + DO_XB), DN_ALPHA, PP().in[13], PP().in[14], (bf16_t*)(ws + WS_HB), (unsigned long long*)(ws + WS_XBUF), (unsigned*)(ws + WS_CTL) + CW_LNX + 8192 * rep_}; pg8::gemm_phase(lds, C.wave, P, S, E); }
    if (IN(10)) REP(10) {
        ProbDense P = mk_dense(ws + WS_HB, ws + WS_H, 1024, 1024, 1024); P.gsh = 2; P.as1 = (size_t)2048 * 2048; P.as2 = 0; P.bs1 = (size_t)4 * 256 * 2048; P.bs2 = (size_t)256 * 2048;
        PanelScore S{bx, pan, pan + 1024, C.wave}; EpiSoftmax E{(bf16_t*)(dout + DO_NQ)}; pg8::gemm_phase(lds, C.wave, P, S, E); }
    if (IN(13)) REP(13) { ProbBatchB P; P.A = (const char*)(dout + DO_NQ); P.Bt = (const char*)(ws + WS_H) + (size_t)16 * MiB; P.lda = 2048; P.ldb = 2048; P.K = 1024; P.bstride = (size_t)1024 * 2048;
        PanelStatic S; S.init(NTOK, 1024, G, bx); S.wait = pan + 1024; S.pub = pan + 2048; S.wave = C.wave;
        EpiLnFused E{nullptr, (const bf16_t*)(ws + WS_HB), DN_ALPHA, PP().in[18], PP().in[19], (bf16_t*)(ws + WS_HB), (unsigned long long*)(ws + WS_XBUF) + (size_t)NTOK * 4, (unsigned*)(ws + WS_CTL) + CW_LNX + 4096 + 8192 * rep_}; pg8::gemm_phase(lds, C.wave, P, S, E); }
    if (IN(14)) { const int tb = 32 * (bx & 7) + (bx >> 3);
        Ctx D = C; D.gw = tb * NWAVES + C.wave; wg_wait_count(pan + 2048 + 16 * (tb >> 2), 4u, C.wave); phase_ln2_router(PP(), D, true); }
    SEAM(14);
    LAS int* tinfo = (LAS int*)(lds + LDS_TILEE + 1024);
    if (IN(16)) moe_tables(PP(), C, (LAS int*)(lds + LDS_TILEE), tinfo);
    if (IN(16)) {
        unsigned* rdy = (unsigned*)(ws + WS_CTL) + CW_RDY;
        { ProbGather P; P.A = (const char*)(ws + WS_HB); P.list = (const int*)(ws + WS_LIST); P.tinfo = tinfo; P.W = (const char*)(ws + WS_WGUT); P.lda = 2048; P.ldb = 2048; P.K = 1024; P.bstride = (size_t)512 * 1024 * 2;
          MoeUpOrder S{(const LAS int*)(lds + LDS_TILEE), G, (bx & 7) * 32 + (bx >> 3), rdy, C.wave};
          EpiGateUp E{(bf16_t*)(ws + WS_HG)}; pg8::gemm_phase(lds, C.wave, P, S, E); }
        { ProbExpertDense P; P.A = (const char*)(ws + WS_HG); P.W = (const char*)ws; P.lda = 512; P.ldb = 512; P.K = 256; P.bstride = (size_t)1024 * 256 * 2;
          MoeDownOrder S{(const LAS int*)(lds + LDS_TILEE), G, (bx & 7) * 32 + (bx >> 3), rdy, C.wave}; EpiDown E{(const int*)(ws + WS_LIST), (const float*)(ws + WS_LISTW), tinfo, (bf16_t*)(ws + WS_Y0), (bf16_t*)(ws + WS_Y1)}; pg8::gemm_phase(lds, C.wave, P, S, E); }
    }
    SEAM(17);
    if (IN(18)) REP(18) phase_final(PP(), C);
#undef IN
#undef SEAM
}

extern "C" void kernel_launch(void* const* d_in, const int* in_sizes, int n_in, void* d_out, int out_size, void* d_ws, size_t ws_size, hipStream_t stream) {
    static int grid = 0;
    if (grid == 0) {
        if (n_in != 29 || out_size != NTOK * DM || ws_size < WS_END) { fprintf(stderr, "kernel_launch: unexpected shapes (n_in %d out %d ws %zu)\n", n_in, out_size, ws_size); grid = -1; return; }
        int dev = 0, cus = 0, per_cu = 0;
        hipGetDevice(&dev); hipDeviceGetAttribute(&cus, hipDeviceAttributeMultiprocessorCount, dev);
        if (hipFuncSetAttribute((const void*)mega_fwd, hipFuncAttributeMaxDynamicSharedMemorySize, LDS_BYTES) != hipSuccess) { fprintf(stderr, "kernel_launch: hipFuncSetAttribute failed\n"); }
        if (hipOccupancyMaxActiveBlocksPerMultiprocessor(&per_cu, (const void*)mega_fwd, NTHREADS, LDS_BYTES) != hipSuccess || per_cu < 1) { fprintf(stderr, "kernel_launch: occupancy query says %d\n", per_cu); per_cu = 1; }
        (void)hipGetLastError();
        grid = cus;
    }
    if (grid < 0) return;
    (void)hipMemsetAsync((char*)d_ws + WS_CTL, 0, 128 * 1024, stream);
    Params p{};
    for (int i = 0; i < 29; ++i) p.in[i] = (const float*)d_in[i];
    p.positions = (const int*)d_in[2]; p.out = (float*)d_out; p.ws = (unsigned char*)d_ws;
    for (int li = 0; li < MK_N_LAUNCHES; ++li) {
        p.ph_lo = (MK_N_LAUNCHES == 1) ? 0 : li; p.ph_hi = (MK_N_LAUNCHES == 1) ? N_PHASES : li + 1;
        void* args[] = {&p};
        hipError_t e = hipLaunchCooperativeKernel((const void*)mega_fwd, dim3(grid), dim3(NTHREADS), args, LDS_BYTES, stream);
        if (e != hipSuccess) { fprintf(stderr, "kernel_launch: cooperative launch %d failed: %s (grid %d)\n", li, hipGetErrorString(e), grid); break; }
    }
}
```
